# Optimizing an MI355X kernel written in HIP

```python
import jax, jax.numpy as jnp
from jax import lax
import numpy as np


D_MODEL = 1024
BATCH = 32
SEQ = 256
DEPTH = 1
DEC_BATCH = 4
DEC_SEQ = 2048
PAST_LEN = 512

GRID_W = 64
BLOCK = 128
WINDOW = 128
A_HEADS = 8
A_KV_HEADS = 2
A_GROUP = A_HEADS // A_KV_HEADS
A_HEAD_DIM = 64
A_Q_W = A_HEADS * A_HEAD_DIM
A_KV_W = A_KV_HEADS * A_HEAD_DIM
B_HEADS = 8
B_NOPE_DIM = 64
B_ROPE_DIM = 32
B_V_DIM = 64
B_QK_DIM = B_NOPE_DIM + B_ROPE_DIM
B_OUT_W = B_HEADS * B_V_DIM
Q_LORA = 256
KV_LORA = 256
D_FF = 2816
N_MOD = 9
ROPE_THETA = 10000.0
EPS = 1e-6
NEG = -1e30
A_SCALE = A_HEAD_DIM ** -0.5
B_SCALE = B_QK_DIM ** -0.5
IN_SIZES = (A_Q_W, A_KV_W, A_KV_W, Q_LORA, KV_LORA, B_ROPE_DIM, D_MODEL, D_MODEL)
IN_WIDTH = A_Q_W + 2 * A_KV_W + Q_LORA + KV_LORA + B_ROPE_DIM + 2 * D_MODEL

kernel_name = 'hybrid_dit_prefix_windowed_gqa_mla_macaron'


def rms_norm(x, g):
    xf = x.astype(jnp.float32)
    y = xf * lax.rsqrt(jnp.mean(xf * xf, axis=-1, keepdims=True) + EPS)
    return (y * g.astype(jnp.float32)).astype(x.dtype)


def modulate(h, shift, scale):
    return h * (1 + scale[:, None, :]) + shift[:, None, :]


def swiglu(h, w_gu, w_down):
    a, u = jnp.split(h @ w_gu, 2, axis=-1)
    return (jax.nn.silu(a) * u) @ w_down


def ada_mods(cvec, ada_w, ada_b):
    m = jax.nn.silu(cvec) @ ada_w + ada_b
    return [m[:, i * D_MODEL:(i + 1) * D_MODEL] for i in range(N_MOD)]


def split_in(z):
    offs = []
    acc = 0
    for s in IN_SIZES[:-1]:
        acc += s
        offs.append(acc)
    return jnp.split(z, offs, axis=-1)


def axial_rope(n, d_rot):
    rows = n // GRID_W
    t_row = jnp.repeat(jnp.arange(rows, dtype=jnp.float32), GRID_W)
    t_col = jnp.tile(jnp.arange(GRID_W, dtype=jnp.float32), rows)
    d_half = d_rot // 2
    inv = 1.0 / (ROPE_THETA ** (jnp.arange(0, d_half, 2, dtype=jnp.float32) / d_half))
    ar = t_row[:, None] * inv[None, :]
    ac = t_col[:, None] * inv[None, :]
    ang = jnp.concatenate([ar, ar, ac, ac], axis=-1)
    return jnp.cos(ang), jnp.sin(ang)


def apply_rope(x, cos, sin):
    shp = (x.shape[1],) + (1,) * (x.ndim - 3) + (x.shape[-1],)
    c = cos.reshape(shp)
    s = sin.reshape(shp)
    xf = x.astype(jnp.float32)
    x1, x2, x3, x4 = jnp.split(xf, 4, axis=-1)
    rot = jnp.concatenate([-x2, x1, -x4, x3], axis=-1)
    return (xf * c + rot * s).astype(x.dtype)


def block_sweep_attention(q, k, v, scale, sink):
    bq, n = q.shape[0], q.shape[1]
    nb = n // BLOCK
    qb = q.astype(jnp.float32).reshape((bq, nb, BLOCK) + q.shape[2:]).swapaxes(0, 1)
    kf = k.astype(jnp.float32)
    vf = v.astype(jnp.float32)

    def one_block(qblk):
        s = jnp.einsum('bqkgd,bskd->bkgqs', qblk, kf) * scale
        if sink is not None:
            col = jnp.broadcast_to(sink.astype(jnp.float32)[None, :, :, None, None], s.shape[:-1] + (1,))
            s = jnp.concatenate([s, col], axis=-1)
        p = jax.nn.softmax(s, axis=-1)
        if sink is not None:
            p = p[..., :-1]
        return jnp.einsum('bkgqs,bskd->bqkgd', p, vf)

    o = lax.map(one_block, qb)
    return o.swapaxes(0, 1).reshape(bq, n, -1).astype(q.dtype)


def windowed_attention(q, k, v, k_ctx, v_ctx, sink, scale):
    b, n = q.shape[0], q.shape[1]
    nb = n // BLOCK
    pad = ((0, 0), (BLOCK, BLOCK), (0, 0), (0, 0))
    kp = jnp.pad(k.astype(jnp.float32), pad).reshape(b, nb + 2, BLOCK, A_KV_HEADS, -1)
    vp = jnp.pad(v.astype(jnp.float32), pad).reshape(b, nb + 2, BLOCK, A_KV_HEADS, -1)
    kband = jnp.concatenate([kp[:, :-2], kp[:, 1:-1], kp[:, 2:]], axis=2)
    vband = jnp.concatenate([vp[:, :-2], vp[:, 1:-1], vp[:, 2:]], axis=2)
    qb = q.astype(jnp.float32).reshape(b, nb, BLOCK, A_KV_HEADS, A_GROUP, -1)
    s_band = jnp.einsum('bnqkgd,bnskd->bnkgqs', qb, kband) * scale
    qi = jnp.arange(BLOCK)
    kj = jnp.arange(3 * BLOCK)
    blk = jnp.arange(nb)
    rel = kj[None, :] - BLOCK - qi[:, None]
    kpos = blk[:, None] * BLOCK - BLOCK + kj[None, :]
    valid = (jnp.abs(rel) <= WINDOW)[None] & ((kpos >= 0) & (kpos < n))[:, None, :]
    s_band = jnp.where(valid[None, :, None, None], s_band, NEG)
    kc = k_ctx.astype(jnp.float32)
    vc = v_ctx.astype(jnp.float32)
    s_ctx = jnp.einsum('bnqkgd,bckd->bnkgqc', qb, kc) * scale
    col = jnp.broadcast_to(sink.astype(jnp.float32)[None, None, :, :, None, None], s_band.shape[:-1] + (1,))
    p = jax.nn.softmax(jnp.concatenate([s_band, s_ctx, col], axis=-1), axis=-1)
    lb = 3 * BLOCK
    lc = k_ctx.shape[1]
    o = (jnp.einsum('bnkgqs,bnskd->bnqkgd', p[..., :lb], vband)
         + jnp.einsum('bnkgqc,bckd->bnqkgd', p[..., lb:lb + lc], vc))
    return o.reshape(b, n, -1).astype(q.dtype)


def mla_queries(q_lat, q_lat_norm, w_uq):
    b, n = q_lat.shape[0], q_lat.shape[1]
    return (rms_norm(q_lat, q_lat_norm) @ w_uq).reshape(b, n, B_HEADS, B_QK_DIM)


def mla_keys(ckv_n, krope, w_ukv):
    b, l = ckv_n.shape[0], ckv_n.shape[1]
    kv = (ckv_n @ w_ukv).reshape(b, l, B_HEADS, B_NOPE_DIM + B_V_DIM)
    k_nope, v = kv[..., :B_NOPE_DIM], kv[..., B_NOPE_DIM:]
    k = jnp.concatenate([k_nope, jnp.broadcast_to(krope[:, :, None, :], (b, l, B_HEADS, B_ROPE_DIM))], axis=-1)
    return k, v


def merge_branches(o_a, o_b, gate_a, gate_b, w_o_a, w_o_b, w_out):
    m = jax.nn.sigmoid(gate_a) * (o_a @ w_o_a) + jax.nn.sigmoid(gate_b) * (o_b @ w_o_b)
    return m @ w_out


def setup_inputs(seed: int = 0) -> dict:
    key = jax.random.key(seed)
    ks = jax.random.split(key, 32)

    def nrm(k, shape, scale=1.0):
        return jax.random.normal(k, shape, jnp.float32) * scale

    def gain(k, shape):
        return 1.0 + nrm(k, shape, 0.05)

    return {
        'x_prompt': nrm(ks[0], (BATCH, SEQ, D_MODEL)),
        'x_sample': nrm(ks[1], (DEC_BATCH, DEC_SEQ, D_MODEL)),
        'cache_attn_k': nrm(ks[2], (DEC_BATCH, DEPTH, PAST_LEN, A_KV_HEADS, A_HEAD_DIM)),
        'cache_attn_v': nrm(ks[3], (DEC_BATCH, DEPTH, PAST_LEN, A_KV_HEADS, A_HEAD_DIM)),
        'cache_mla_ckv': nrm(ks[4], (DEC_BATCH, DEPTH, PAST_LEN, KV_LORA)),
        'cache_mla_krope': nrm(ks[5], (DEC_BATCH, DEPTH, PAST_LEN, B_ROPE_DIM)),
        'c': nrm(ks[6], (DEC_BATCH, D_MODEL)),
        'c_ctx': nrm(ks[7], (D_MODEL,)),
        'ada_w': nrm(ks[8], (DEPTH, D_MODEL, N_MOD * D_MODEL), 0.5 * D_MODEL ** -0.5),
        'ada_b': nrm(ks[9], (DEPTH, N_MOD * D_MODEL), 0.01),
        'ffn1_norm': gain(ks[10], (DEPTH, D_MODEL)),
        'ffn1_w_gu': nrm(ks[11], (DEPTH, D_MODEL, 2 * D_FF), D_MODEL ** -0.5),
        'ffn1_w_down': nrm(ks[12], (DEPTH, D_FF, D_MODEL), D_FF ** -0.5),
        'mix_norm': gain(ks[13], (DEPTH, D_MODEL)),
        'w_in': nrm(ks[14], (DEPTH, D_MODEL, IN_WIDTH), D_MODEL ** -0.5),
        'attn_sink': nrm(ks[15], (DEPTH, A_HEADS), 0.5),
        'q_lat_norm': gain(ks[16], (DEPTH, Q_LORA)),
        'kv_lat_norm': gain(ks[17], (DEPTH, KV_LORA)),
        'w_uq': nrm(ks[18], (DEPTH, Q_LORA, B_HEADS * B_QK_DIM), Q_LORA ** -0.5),
        'w_ukv': nrm(ks[19], (DEPTH, KV_LORA, B_HEADS * (B_NOPE_DIM + B_V_DIM)), KV_LORA ** -0.5),
        'w_o_a': nrm(ks[20], (DEPTH, A_Q_W, D_MODEL), A_Q_W ** -0.5),
        'w_o_b': nrm(ks[21], (DEPTH, B_OUT_W, D_MODEL), B_OUT_W ** -0.5),
        'w_out': nrm(ks[22], (DEPTH, D_MODEL, D_MODEL), D_MODEL ** -0.5),
        'ffn2_norm': gain(ks[23], (DEPTH, D_MODEL)),
        'ffn2_w_gu': nrm(ks[24], (DEPTH, D_MODEL, 2 * D_FF), D_MODEL ** -0.5),
        'ffn2_w_down': nrm(ks[25], (DEPTH, D_FF, D_MODEL), D_FF ** -0.5),
        'final_norm': gain(ks[26], (D_MODEL,)),
    }


def reference(x_prompt, x_sample, cache_attn_k, cache_attn_v, cache_mla_ckv, cache_mla_krope, c, c_ctx,
              ada_w, ada_b, ffn1_norm, ffn1_w_gu, ffn1_w_down, mix_norm, w_in, attn_sink,
              q_lat_norm, kv_lat_norm, w_uq, w_ukv, w_o_a, w_o_b, w_out,
              ffn2_norm, ffn2_w_gu, ffn2_w_down, final_norm):
    xp = x_prompt
    bp, sp = x_prompt.shape[0], x_prompt.shape[1]
    ks_a, vs_a, cs_b, rs_b = [], [], [], []
    for l in range(DEPTH):
        sh1, sc1, g1, sh2, sc2, g2, sh3, sc3, g3 = ada_mods(c_ctx[None, :], ada_w[l], ada_b[l])
        xp = xp + 0.5 * g1[:, None, :] * swiglu(modulate(rms_norm(xp, ffn1_norm[l]), sh1, sc1), ffn1_w_gu[l], ffn1_w_down[l])
        h = modulate(rms_norm(xp, mix_norm[l]), sh2, sc2)
        qa, ka, va, q_lat, ckv, krope, gate_a, gate_b = split_in(h @ w_in[l])
        qa = qa.reshape(bp, sp, A_KV_HEADS, A_GROUP, A_HEAD_DIM)
        ka = ka.reshape(bp, sp, A_KV_HEADS, A_HEAD_DIM)
        va = va.reshape(bp, sp, A_KV_HEADS, A_HEAD_DIM)
        o_a = block_sweep_attention(qa, ka, va, A_SCALE, attn_sink[l].reshape(A_KV_HEADS, A_GROUP))
        q_b = mla_queries(q_lat, q_lat_norm[l], w_uq[l])
        ckv_n = rms_norm(ckv, kv_lat_norm[l])
        k_b, v_b = mla_keys(ckv_n, krope, w_ukv[l])
        o_b = block_sweep_attention(q_b[:, :, :, None, :], k_b, v_b, B_SCALE, None)
        xp = xp + g2[:, None, :] * merge_branches(o_a, o_b, gate_a, gate_b, w_o_a[l], w_o_b[l], w_out[l])
        xp = xp + 0.5 * g3[:, None, :] * swiglu(modulate(rms_norm(xp, ffn2_norm[l]), sh3, sc3), ffn2_w_gu[l], ffn2_w_down[l])
        ks_a.append(ka)
        vs_a.append(va)
        cs_b.append(ckv_n)
        rs_b.append(krope)
    y_prompt = rms_norm(xp, final_norm)
    new_attn_k = jnp.stack(ks_a, axis=1)
    new_attn_v = jnp.stack(vs_a, axis=1)
    new_mla_ckv = jnp.stack(cs_b, axis=1)
    new_mla_krope = jnp.stack(rs_b, axis=1)

    xs = x_sample
    bs, ns = x_sample.shape[0], x_sample.shape[1]
    cos_a, sin_a = axial_rope(ns, A_HEAD_DIM)
    cos_b, sin_b = axial_rope(ns, B_ROPE_DIM)
    for l in range(DEPTH):
        sh1, sc1, g1, sh2, sc2, g2, sh3, sc3, g3 = ada_mods(c, ada_w[l], ada_b[l])
        xs = xs + 0.5 * g1[:, None, :] * swiglu(modulate(rms_norm(xs, ffn1_norm[l]), sh1, sc1), ffn1_w_gu[l], ffn1_w_down[l])
        h = modulate(rms_norm(xs, mix_norm[l]), sh2, sc2)
        qa, ka, va, q_lat, ckv, krope, gate_a, gate_b = split_in(h @ w_in[l])
        qa = apply_rope(qa.reshape(bs, ns, A_KV_HEADS, A_GROUP, A_HEAD_DIM), cos_a, sin_a)
        ka = apply_rope(ka.reshape(bs, ns, A_KV_HEADS, A_HEAD_DIM), cos_a, sin_a)
        va = va.reshape(bs, ns, A_KV_HEADS, A_HEAD_DIM)
        o_a = windowed_attention(qa, ka, va, cache_attn_k[:, l], cache_attn_v[:, l],
                                 attn_sink[l].reshape(A_KV_HEADS, A_GROUP), A_SCALE)
        q_b = mla_queries(q_lat, q_lat_norm[l], w_uq[l])
        q_b = jnp.concatenate([q_b[..., :B_NOPE_DIM], apply_rope(q_b[..., B_NOPE_DIM:], cos_b, sin_b)], axis=-1)
        ckv_n = rms_norm(ckv, kv_lat_norm[l])
        k_lat, v_lat = mla_keys(ckv_n, apply_rope(krope, cos_b, sin_b), w_ukv[l])
        k_ctx, v_ctx = mla_keys(cache_mla_ckv[:, l], cache_mla_krope[:, l], w_ukv[l])
        o_b = block_sweep_attention(q_b[:, :, :, None, :], jnp.concatenate([k_ctx, k_lat], axis=1),
                                    jnp.concatenate([v_ctx, v_lat], axis=1), B_SCALE, None)
        xs = xs + g2[:, None, :] * merge_branches(o_a, o_b, gate_a, gate_b, w_o_a[l], w_o_b[l], w_out[l])
        xs = xs + 0.5 * g3[:, None, :] * swiglu(modulate(rms_norm(xs, ffn2_norm[l]), sh3, sc3), ffn2_w_gu[l], ffn2_w_down[l])
    y_sample = rms_norm(xs, final_norm)

    return (y_prompt, y_sample, new_attn_k, new_attn_v, new_mla_ckv, new_mla_krope)
```

```cpp
#include <hip/hip_runtime.h>
#include <hip/hip_cooperative_groups.h>
#include <cstdio>
#include <cstdint>
namespace cg = cooperative_groups;
namespace pg8 {
#define PG8_LAS __attribute__((address_space(3)))
typedef unsigned short bf16_t;
typedef short bf16x8 __attribute__((ext_vector_type(8)));
typedef float f32x4 __attribute__((ext_vector_type(4)));
typedef unsigned u32x4 __attribute__((ext_vector_type(4)));
constexpr int BM = 256, BK = 64, HALF = 128, HTB = HALF * BK * 2  , STAGE_BYTES = 8 * HTB, NXCD = 8, WGM = 8;

__host__ __device__ __forceinline__ int lds_byte(int r, int c) { const int st = (r >> 4) * 2 + (c >> 5), rr = r & 15, cc = c & 31, ob = rr * 64 + cc * 2; return st * 1024 + (ob ^ (((ob >> 9) & 1) << 5)); }
__host__ __device__ __forceinline__ void stage_rc(int b, int& R, int& C) { const int st = b / 1024, sb = b % 1024, swz = sb ^ (((sb >> 9) & 1) << 5); R = (st >> 1) * 16 + swz / 64; C = (st & 1) * 32 + (swz % 64) / 2; }
__host__ __device__ __forceinline__ int perm32(int rho) { const int n = rho >> 4, i = rho & 15; return 8 * (i >> 2) + 4 * n + (i & 3); }

struct Unit { int pm, pn; };
struct Gemm { const bf16_t* A; const bf16_t* Bt; int M, N, K; };

struct StaticOrder {
    int nM, nN, nwg, G, c;
    __host__ __device__ void init(int M, int N, int G_, int c_) { nM = M / BM; nN = N / BM; nwg = nM * nN; G = G_; c = c_; }
    __host__ __device__ bool next(int i, Unit& u) const {
        const long L = (long)i * G + c; if (L >= nwg) return false;
        int wgid = (int)L; { const int q = nwg / NXCD, r = nwg % NXCD, xcd = wgid % NXCD, off = wgid / NXCD; wgid = (xcd < r ? xcd * (q + 1) : r * (q + 1) + (xcd - r) * q) + off; }
        const int nig = WGM * nN, gid = wgid / nig, fm = gid * WGM, gsz = (nM - fm) < WGM ? (nM - fm) : WGM;
        u.pm = fm + ((wgid % nig) % gsz); u.pn = (wgid % nig) / gsz; return true;
    }
    __device__ __forceinline__ void a_ready(const Unit&) const {}
    __device__ __forceinline__ void done(const Unit&) const {}
};
__device__ __forceinline__ unsigned cvt_pk_bf16(float lo, float hi) { unsigned r; asm volatile("v_cvt_pk_bf16_f32 %0, %1, %2" : "=v"(r) : "v"(lo), "v"(hi)); return r; }
typedef float f32x2 __attribute__((ext_vector_type(2)));
template <class Epi, class Sched, bool ALIGN_EPI = false, bool SP2 = false>
__device__ __forceinline__ void gemm_phase(PG8_LAS unsigned char* lds, const Gemm g, const Sched& S, const Epi& E) {
    const int tid = threadIdx.x, wid = __builtin_amdgcn_readfirstlane(tid >> 6), lane = tid & 63, wr = wid >> 2, wc = wid & 3, fr = lane & 15, fq = lane >> 4;
    const int K = g.K, nt = K / BK;
    unsigned voffA[2], voffB[2];
#pragma unroll
    for (int i = 0; i < 2; ++i) { int R, C; stage_rc(tid * 16 + i * 8192, R, C); const int Rb = Epi::PERM ? ((R & ~31) + perm32(R & 31)) : R;
        voffA[i] = (unsigned)(R * K + C) * 2u; voffB[i] = (unsigned)(Rb * K + C) * 2u; }
    const size_t kstep = (size_t)(BK * 2);
    const size_t hstep = (size_t)HALF * K * 2;
    const size_t tstep = 2 * hstep;
    const unsigned ldsw = (unsigned)wid * 1024u;
    const int aoff = lds_byte(wr * 64 + fr, fq * 8), boff = lds_byte(wc * 32 + fr, fq * 8);
#define PG8_SA(b, h) (((b) * 2 + (h)) * HTB)
#define PG8_SB(b, h) ((4 + (b) * 2 + (h)) * HTB)
#define PG8_STAGE(bufoff, gbase, voff) do { _Pragma("unroll") for (int _i = 0; _i < 2; ++_i) \
        __builtin_amdgcn_global_load_lds((const unsigned*)((const char*)(gbase) + (voff)[_i]), (PG8_LAS unsigned*)(lds + (bufoff) + ldsw + _i * 8192), 16, 0, 0); } while (0)
#define PG8_LDA(dst, b, h) do { _Pragma("unroll") for (int m = 0; m < 4; ++m) _Pragma("unroll") for (int k = 0; k < 2; ++k) dst[m][k] = *(const PG8_LAS bf16x8*)(lds + PG8_SA(b, h) + aoff + m * 2048 + k * 1024); } while (0)
#define PG8_LDB(dst, b, h) do { _Pragma("unroll") for (int n = 0; n < 2; ++n) _Pragma("unroll") for (int k = 0; k < 2; ++k) dst[n][k] = *(const PG8_LAS bf16x8*)(lds + PG8_SB(b, h) + boff + n * 2048 + k * 1024); } while (0)
#define PG8_MMA(ai, bj, At, Bt) do { __builtin_amdgcn_s_setprio(1); _Pragma("unroll") for (int m = 0; m < 4; ++m) _Pragma("unroll") for (int n = 0; n < 2; ++n) _Pragma("unroll") for (int k = 0; k < 2; ++k) \
        acc[ai][bj][m][n] = __builtin_amdgcn_mfma_f32_16x16x32_bf16(Bt[n][k], At[m][k], acc[ai][bj][m][n], 0, 0, 0); __builtin_amdgcn_s_setprio(0); } while (0)
#define PG8_WAIT_V(n) asm volatile("s_waitcnt vmcnt(" #n ")" ::: "memory")
#define PG8_WAIT_L(n) asm volatile("s_waitcnt lgkmcnt(" #n ")" ::: "memory")
#define PG8_BAR __builtin_amdgcn_s_barrier()
#define PG8_SCHED __builtin_amdgcn_sched_barrier(0)
    Unit cur, nxt; int ui = 0;
    if (!S.next(0, cur)) return;
    f32x4 acc[2][2][4][2];
#pragma unroll
    for (int a = 0; a < 2; ++a)
#pragma unroll
        for (int b = 0; b < 2; ++b)
#pragma unroll
            for (int m = 0; m < 4; ++m)
#pragma unroll
                for (int n = 0; n < 2; ++n) acc[a][b][m][n] = (f32x4){0.f, 0.f, 0.f, 0.f};
    bf16x8 At[4][2], B0[2][2], B1[2][2];
    const char* cA = (const char*)g.A + (size_t)cur.pm * tstep; const char* cB = (const char*)g.Bt + (size_t)cur.pn * tstep;
    S.a_ready(cur);
    if constexpr (SP2) {
        PG8_STAGE(PG8_SB(0, 0), cB, voffB); PG8_STAGE(PG8_SB(0, 1), cB + hstep, voffB); PG8_STAGE(PG8_SA(0, 0), cA, voffA); PG8_STAGE(PG8_SA(0, 1), cA + hstep, voffA);
        if (wr == 1) PG8_BAR;
        PG8_WAIT_V(2); PG8_BAR;
        PG8_STAGE(PG8_SB(1, 0), cB + kstep, voffB); PG8_STAGE(PG8_SA(1, 0), cA + kstep, voffA); PG8_STAGE(PG8_SB(1, 1), cB + hstep + kstep, voffB);
        PG8_WAIT_V(6); PG8_BAR;
    } else {
        PG8_STAGE(PG8_SB(0, 0), cB, voffB); PG8_STAGE(PG8_SA(0, 0), cA, voffA); PG8_STAGE(PG8_SB(0, 1), cB + hstep, voffB); PG8_STAGE(PG8_SA(0, 1), cA + hstep, voffA);
        if (wr == 1) PG8_BAR;
        PG8_WAIT_V(4); PG8_BAR;
        PG8_STAGE(PG8_SB(1, 0), cB + kstep, voffB); PG8_STAGE(PG8_SA(1, 0), cA + kstep, voffA); PG8_STAGE(PG8_SB(1, 1), cB + hstep + kstep, voffB);
        PG8_WAIT_V(6); PG8_BAR;
    }
    for (;;) {
        const bool has_next = S.next(ui + 1, nxt);
        const char* nA = has_next ? (const char*)g.A + (size_t)nxt.pm * tstep : cA; const char* nB = has_next ? (const char*)g.Bt + (size_t)nxt.pn * tstep : cB;
        for (int t = 0; t < nt; t += 2) {
            const bool last = (t == nt - 2);
            const char* a1 = cA + (size_t)(t + 1) * kstep;
            const char* a2 = last ? nA : cA + (size_t)(t + 2) * kstep; const char* b2 = last ? nB : cB + (size_t)(t + 2) * kstep;
            const char* a3 = a2 + kstep; const char* b3 = b2 + kstep;
            if (last && has_next) S.a_ready(nxt);
            if constexpr (SP2) {
            PG8_LDB(B0, 0, 0); PG8_LDB(B1, 0, 1); PG8_SCHED; PG8_LDA(At, 0, 0); PG8_STAGE(PG8_SA(1, 1), a1 + hstep, voffA);
            PG8_WAIT_V(8); PG8_WAIT_L(0); PG8_BAR; PG8_MMA(0, 0, At, B0); PG8_MMA(0, 1, At, B1); PG8_BAR; PG8_SCHED;
            PG8_LDA(At, 0, 1); PG8_STAGE(PG8_SB(0, 0), b2, voffB); PG8_STAGE(PG8_SB(0, 1), b2 + hstep, voffB); PG8_STAGE(PG8_SA(0, 0), a2, voffA);
            PG8_WAIT_V(8); PG8_WAIT_L(0); PG8_BAR; PG8_MMA(1, 0, At, B0); PG8_MMA(1, 1, At, B1); PG8_BAR; PG8_SCHED;
            PG8_LDB(B0, 1, 0); PG8_LDB(B1, 1, 1); PG8_SCHED; PG8_LDA(At, 1, 0); PG8_STAGE(PG8_SA(0, 1), a2 + hstep, voffA);
            PG8_WAIT_V(8); PG8_WAIT_L(0); PG8_BAR; PG8_MMA(0, 0, At, B0); PG8_MMA(0, 1, At, B1); PG8_BAR; PG8_SCHED;
            PG8_LDA(At, 1, 1); PG8_STAGE(PG8_SB(1, 0), b3, voffB); PG8_STAGE(PG8_SB(1, 1), b3 + hstep, voffB); PG8_STAGE(PG8_SA(1, 0), a3, voffA);
            PG8_WAIT_V(8); PG8_WAIT_L(0); PG8_BAR; PG8_MMA(1, 0, At, B0); PG8_MMA(1, 1, At, B1); PG8_BAR; PG8_SCHED;
            } else {
            PG8_LDB(B0, 0, 0); PG8_SCHED; PG8_LDA(At, 0, 0); PG8_STAGE(PG8_SA(1, 1), a1 + hstep, voffA);
            PG8_WAIT_L(8); PG8_BAR; PG8_WAIT_L(0); PG8_MMA(0, 0, At, B0); PG8_BAR; PG8_SCHED;
            PG8_LDB(B1, 0, 1); PG8_STAGE(PG8_SB(0, 0), b2, voffB);
            PG8_BAR; PG8_WAIT_L(0); PG8_MMA(0, 1, At, B1); PG8_BAR;
            PG8_LDA(At, 0, 1); PG8_STAGE(PG8_SA(0, 0), a2, voffA);
            PG8_BAR; PG8_WAIT_L(0); PG8_MMA(1, 0, At, B0); PG8_BAR; PG8_SCHED;
            PG8_STAGE(PG8_SB(0, 1), b2 + hstep, voffB);
            PG8_WAIT_V(6); PG8_BAR; PG8_MMA(1, 1, At, B1); PG8_BAR;
            PG8_LDB(B0, 1, 0); PG8_SCHED; PG8_LDA(At, 1, 0); PG8_STAGE(PG8_SA(0, 1), a2 + hstep, voffA);
            PG8_WAIT_L(8); PG8_BAR; PG8_WAIT_L(0); PG8_MMA(0, 0, At, B0); PG8_BAR; PG8_SCHED;
            PG8_LDB(B1, 1, 1); PG8_STAGE(PG8_SB(1, 0), b3, voffB);
            PG8_BAR; PG8_WAIT_L(0); PG8_MMA(0, 1, At, B1); PG8_BAR;
            PG8_LDA(At, 1, 1); PG8_STAGE(PG8_SA(1, 0), a3, voffA);
            PG8_BAR; PG8_WAIT_L(0); PG8_MMA(1, 0, At, B0); PG8_BAR; PG8_SCHED;
            PG8_STAGE(PG8_SB(1, 1), b3 + hstep, voffB);
            PG8_WAIT_V(6); PG8_BAR; PG8_MMA(1, 1, At, B1); PG8_BAR;
            }
        }
        if constexpr (ALIGN_EPI) { if (wr == 0) PG8_BAR; }
        if constexpr (!Epi::AFTER_DRAIN) { E(acc, cur, wr, wc, fr, fq); S.done(cur); }
        if (!has_next) break;
#pragma unroll
        for (int a = 0; a < 2; ++a)
#pragma unroll
            for (int b = 0; b < 2; ++b)
#pragma unroll
                for (int m = 0; m < 4; ++m)
#pragma unroll
                    for (int n = 0; n < 2; ++n) acc[a][b][m][n] = (f32x4){0.f, 0.f, 0.f, 0.f};
        cur = nxt; cA = nA; cB = nB; ++ui;
        if constexpr (ALIGN_EPI) { if (wr == 1) PG8_BAR; }
    }
    PG8_WAIT_V(0);
    if constexpr (!ALIGN_EPI) { if (wr == 0) PG8_BAR; }
    PG8_BAR;
    if constexpr (Epi::AFTER_DRAIN) { E.fused(acc, cur, wr, wc, fr, fq, lds, wid, lane); S.done(cur); }
#undef PG8_SA
#undef PG8_SB
#undef PG8_STAGE
#undef PG8_LDA
#undef PG8_LDB
#undef PG8_MMA
#undef PG8_WAIT_V
#undef PG8_WAIT_L
#undef PG8_BAR
#undef PG8_SCHED
}
}
#ifndef PG8_SP2
#define PG8_SP2 true
#endif
#ifndef PG8_ALIGN
#define PG8_ALIGN true
#endif
#ifndef MK_N_LAUNCHES
#define MK_N_LAUNCHES 1
#endif
#define DI __device__ __forceinline__
#define LAS __attribute__((address_space(3)))
typedef unsigned short bf16;
typedef unsigned v4u __attribute__((ext_vector_type(4)));
typedef unsigned v2u __attribute__((ext_vector_type(2)));
typedef float f32x4 __attribute__((ext_vector_type(4)));
typedef float f32x16 __attribute__((ext_vector_type(16)));
typedef short bf16x8 __attribute__((ext_vector_type(8)));
using pg8::Unit;

constexpr int D = 1024, MP = 8192, M = 16384, MCTX = 2048, MALL = 18432;
constexpr int FF = 2816, NGU = 5632, NINP = 3584, NMODS = 9216;
constexpr float EPS = 1e-6f, LOG2E = 1.4426950408889634f;
constexpr float A_QS = 0.125f * LOG2E;
constexpr float B_QS = 0.10206207261596575f * LOG2E;
constexpr size_t OUT_K = (size_t)M * D, OUT_V = OUT_K + 8192 * 128, OUT_CKV = OUT_V + 8192 * 128, OUT_KR = OUT_CKV + 8192 * 256;
constexpr size_t MiB = 1u << 20;
constexpr size_t OFF_MODS = 0, OFF_SSQQ = 196608, OFF_SSQKV = 262144, ZERO_BYTES = 327680, OFF_ROPEA = 393216, OFF_ROPEB = 401408;
constexpr size_t OFF_WGU1 = 1 * MiB, OFF_WGU2 = 12 * MiB, OFF_WD1 = 23 * MiB, OFF_WD2 = OFF_WD1 + 5767168, OFF_WIN = 34 * MiB, OFF_WOUT = 41 * MiB,
                 OFF_WOA = 43 * MiB, OFF_WOB = 44 * MiB, OFF_WUQ = 45 * MiB, OFF_WK = OFF_WUQ + 393216, OFF_WV = OFF_WK + 262144;
constexpr size_t OFF_H = 46 * MiB, OFF_OA = OFF_H, OFF_OB = OFF_H + 16 * MiB;
constexpr size_t OFF_ACT = 78 * MiB;
constexpr size_t OFF_QA = OFF_ACT, OFF_KA = OFF_QA + 16 * MiB, OFF_VAT = OFF_KA + (size_t)MALL * 128 * 2, OFF_QLAT = OFF_VAT + (size_t)MALL * 128 * 2,
                 OFF_CKV = OFF_QLAT + 8 * MiB, OFF_KROPE = OFF_CKV + 9 * MiB, OFF_QB = OFF_KROPE + (size_t)MALL * 32 * 2 + 131072, OFF_KN = OFF_QB + 24 * MiB;
constexpr size_t OFF_MM = OFF_ACT;
constexpr size_t OFF_GA = 166 * MiB, OFF_GB = 198 * MiB, OFF_VBT = 230 * MiB, WS_END = 248 * MiB;
static_assert(OFF_QLAT + 8 * MiB >= OFF_MM + 32 * MiB, "m overlay");
static_assert(OFF_KN + 18 * MiB <= OFF_GA && OFF_WV + 262144 <= OFF_H, "ws map");
constexpr int LDS_BYTES = 147456;

DI unsigned f2bf(float f) { unsigned u = __builtin_bit_cast(unsigned, f); return (u + 0x7fffu + ((u >> 16) & 1u)) >> 16; }
DI unsigned pk2(float lo, float hi) { return f2bf(lo) | (f2bf(hi) << 16); }
DI float bflo(unsigned w) { return __builtin_bit_cast(float, w << 16); }
DI float bfhi(unsigned w) { return __builtin_bit_cast(float, w & 0xffff0000u); }
DI float fexp2(float x) { return __builtin_amdgcn_exp2f(x); }
DI float frcp(float x) { return __builtin_amdgcn_rcpf(x); }
DI float sigm(float x) { return frcp(1.f + fexp2(-x * LOG2E)); }
#define LDS_WAIT() asm volatile("s_waitcnt lgkmcnt(0)" ::: "memory")
DI float wave_sum(float v) {
#pragma unroll
    for (int o = 1; o < 64; o <<= 1) v += __shfl_xor(v, o);
    return v;
}
DI int mod_index(int row) { return row < MP ? 0 : 1 + ((row - MP) >> 11); }

DI void transpose_item(const float* W, int N, bf16* WT, int K, int k0, int src_n0, int dst_r0, const float* kscale, float sscale, LAS float* scr, int lane) {
    if (src_n0 >= 0) {
#pragma unroll 8
        for (int i = 0; i < 32; ++i) { const int kk = 2 * i + (lane >> 5); float v = W[(size_t)(k0 + kk) * N + src_n0 + (lane & 31)]; if (kscale) v *= kscale[k0 + kk]; scr[kk * 33 + (lane & 31)] = v * sscale; }
    } else {
#pragma unroll 8
        for (int i = 0; i < 32; ++i) { const int kk = 2 * i + (lane >> 5); scr[kk * 33 + (lane & 31)] = 0.f; }
    }
    LDS_WAIT(); asm volatile("" ::: "memory");
    const int c = lane & 7;
#pragma unroll
    for (int j = 0; j < 4; ++j) { const int n = (lane >> 3) + 8 * j; const LAS float* s = scr + (8 * c) * 33 + n;
        v4u o; o.x = pk2(s[0 * 33], s[1 * 33]); o.y = pk2(s[2 * 33], s[3 * 33]); o.z = pk2(s[4 * 33], s[5 * 33]); o.w = pk2(s[6 * 33], s[7 * 33]);
        *(v4u*)(WT + (size_t)(dst_r0 + n) * K + k0 + 8 * c) = o; }
    LDS_WAIT(); asm volatile("" ::: "memory");
}

struct Args { const float* in[27]; float* out; unsigned char* ws; int ph_lo, ph_hi; };

DI void p0_weights(const Args& a, LAS unsigned char* lds, int gw, int NGW, int wave, int lane) {
    LAS float* scr = (LAS float*)(lds + wave * 16384);
    unsigned char* ws = a.ws;
    constexpr int I_GU = 16 * 176, I_D = 44 * 32, I_IN = 16 * 112, I_OUT = 16 * 32, I_O = 8 * 32, I_UQ = 4 * 24, I_K = 4 * 16;
    constexpr int NIT = 2 * I_GU + 2 * I_D + I_IN + I_OUT + 2 * I_O + I_UQ + 2 * I_K;
    for (int it = gw; it < NIT; it += NGW) {
        int r = it;
        if (r < 2 * I_GU) { const int w = r >= I_GU; r -= w * I_GU; const int kb = r / 176, nb = r % 176, R0 = 32 * nb;
            const int pn = R0 >> 8, half = (R0 >> 7) & 1, j = R0 & 127;
            transpose_item(a.in[w ? 24 : 11], NGU, (bf16*)(ws + (w ? OFF_WGU2 : OFF_WGU1)), 1024, 64 * kb, half * FF + 128 * pn + j, R0, nullptr, 1.f, scr, lane); continue; }
        r -= 2 * I_GU;
        if (r < 2 * I_D) { const int w = r >= I_D; r -= w * I_D; const int kb = r / 32, nb = r % 32;
            transpose_item(a.in[w ? 25 : 12], 1024, (bf16*)(ws + (w ? OFF_WD2 : OFF_WD1)), FF, 64 * kb, 32 * nb, 32 * nb, nullptr, 1.f, scr, lane); continue; }
        r -= 2 * I_D;
        if (r < I_IN) { const int kb = r / 112, nb = r % 112, R0 = 32 * nb;
            const int src = R0 < 1280 ? R0 : (R0 < 3328 ? R0 + 32 : (R0 == 3328 ? 1280 : -1));
            transpose_item(a.in[14], 3360, (bf16*)(ws + OFF_WIN), 1024, 64 * kb, src, R0, nullptr, 1.f, scr, lane); continue; }
        r -= I_IN;
        if (r < I_OUT) { const int kb = r / 32, nb = r % 32; transpose_item(a.in[22], 1024, (bf16*)(ws + OFF_WOUT), 1024, 64 * kb, 32 * nb, 32 * nb, nullptr, 1.f, scr, lane); continue; }
        r -= I_OUT;
        if (r < 2 * I_O) { const int w = r >= I_O; r -= w * I_O; const int kb = r / 32, nb = r % 32;
            transpose_item(a.in[w ? 21 : 20], 1024, (bf16*)(ws + (w ? OFF_WOB : OFF_WOA)), 512, 64 * kb, 32 * nb, 32 * nb, nullptr, 1.f, scr, lane); continue; }
        r -= 2 * I_O;
        if (r < I_UQ) { const int kb = r / 24, nb = r % 24, R0 = 32 * nb;
            const int src = R0 < 512 ? (R0 >> 6) * 96 + (R0 & 63) : ((R0 - 512) >> 5) * 96 + 64;
            transpose_item(a.in[18], 768, (bf16*)(ws + OFF_WUQ), 256, 64 * kb, src, R0, a.in[16], B_QS, scr, lane); continue; }
        r -= I_UQ;
        { const int w = r >= I_K; r -= w * I_K; const int kb = r / 16, nb = r % 16, R0 = 32 * nb;
            const int src = (R0 >> 6) * 128 + (R0 & 63) + (w ? 64 : 0);
            transpose_item(a.in[19], 1024, (bf16*)(ws + (w ? OFF_WV : OFF_WK)), 256, 64 * kb, src, R0, a.in[17], 1.f, scr, lane); }
    }
}
DI void p0_ada(const Args& a, LAS unsigned char* lds, int tid) {
    LAS float* sc = (LAS float*)lds;
    LAS float* red = (LAS float*)(lds + 4096);
    float* mods = (float*)(a.ws + OFF_MODS);
    const float* adaw = a.in[8];
    for (int it = blockIdx.x; it < 256; it += gridDim.x) {
        const int cgp = it & 31, ks = it >> 5;
        __syncthreads();
        for (int i = tid; i < 640; i += 512) { const int v = i >> 7, k = ks * 128 + (i & 127); const float c = v == 0 ? a.in[7][k] : a.in[6][(v - 1) * 1024 + k]; sc[i] = c * sigm(c); }
        __syncthreads();
        const int colq = tid % 72, kl = tid / 72;
        if (kl < 7) {
            f32x4 acc[5];
#pragma unroll
            for (int v = 0; v < 5; ++v) acc[v] = (f32x4){0.f, 0.f, 0.f, 0.f};
            for (int k = kl; k < 128; k += 7) { const f32x4 w = *(const f32x4*)(adaw + (size_t)(ks * 128 + k) * NMODS + cgp * 288 + colq * 4);
#pragma unroll
                for (int v = 0; v < 5; ++v) acc[v] += w * sc[v * 128 + k]; }
#pragma unroll
            for (int v = 0; v < 5; ++v) *(LAS f32x4*)(red + (kl * 5 + v) * 288 + colq * 4) = acc[v];
        }
        __syncthreads();
        for (int i = tid; i < 1440; i += 512) { const int v = i / 288, cc = i % 288; float s = 0.f;
#pragma unroll
            for (int q = 0; q < 7; ++q) s += red[(q * 5 + v) * 288 + cc];
            const int col = cgp * 288 + cc; if (ks == 0) s += a.in[9][col];
            atomicAdd(mods + v * NMODS + col, s); }
    }
    __syncthreads();
}
DI void ctx_convert(const Args& a, int gtid, int NT) {
    unsigned char* ws = a.ws;
    bf16* ka = (bf16*)(ws + OFF_KA) + (size_t)M * 128; bf16* vaT = (bf16*)(ws + OFF_VAT); bf16* ckv = (bf16*)(ws + OFF_CKV) + (size_t)M * 256; bf16* kr = (bf16*)(ws + OFF_KROPE) + (size_t)M * 32;
    for (int i = gtid; i < MCTX * 128; i += NT) ka[i] = (bf16)f2bf(a.in[2][i]);
    for (int i = gtid; i < MCTX * 128; i += NT) { const int f = i >> 11, tk = i & 2047; vaT[(size_t)f * MALL + M + tk] = (bf16)f2bf(a.in[3][tk * 128 + f]); }
    for (int i = gtid; i < MCTX * 256; i += NT) ckv[i] = (bf16)f2bf(a.in[4][i] / a.in[17][i & 255]);
    for (int i = gtid; i < MCTX * 32; i += NT) kr[i] = (bf16)f2bf(a.in[5][i]);
}
DI void p0_misc(const Args& a, int gtid, int NT) {
    unsigned char* ws = a.ws;
    float2* ra = (float2*)(ws + OFF_ROPEA); float2* rb = (float2*)(ws + OFF_ROPEB);
    for (int i = gtid; i < 1024; i += NT) { const int pos = i >> 4, fi = i & 15; const float inv = 1.0f / powf(10000.f, (float)(2 * fi) / 32.f); const float ang = (float)pos * inv; ra[i] = make_float2(cosf(ang), sinf(ang)); }
    for (int i = gtid; i < 512; i += NT) { const int pos = i >> 3, fi = i & 7; const float inv = 1.0f / powf(10000.f, (float)(2 * fi) / 16.f); const float ang = (float)pos * inv; rb[i] = make_float2(cosf(ang), sinf(ang)); }
}

DI void norm_mod_phase(const float* xa, const float* xb, const float* gain, const float* mods, int s, bf16* h, int gw, int NGW, int lane) {
    for (int row = gw; row < M; row += NGW) {
        const float* xr = row < MP ? xa + (size_t)row * D : xb + (size_t)(row - MP) * D;
        f32x4 v[4]; float ss = 0.f;
#pragma unroll
        for (int j = 0; j < 4; ++j) { v[j] = *(const f32x4*)(xr + 4 * (64 * j + lane)); ss += (v[j].x * v[j].x + v[j].y * v[j].y) + (v[j].z * v[j].z + v[j].w * v[j].w); }
        const float rstd = 1.0f / sqrtf(wave_sum(ss) * (1.f / D) + EPS);
        const float* sh = mods + mod_index(row) * NMODS + (3 * s) * D; const float* sc = sh + D;
#pragma unroll
        for (int j = 0; j < 4; ++j) { const int c = 4 * (64 * j + lane); const f32x4 g = *(const f32x4*)(gain + c), s4 = *(const f32x4*)(sh + c), c4 = *(const f32x4*)(sc + c);
            const f32x4 o = (v[j] * rstd * g) * (c4 + 1.0f) + s4; v2u w; w.x = pk2(o.x, o.y); w.y = pk2(o.z, o.w); *(v2u*)(h + (size_t)row * D + c) = w; }
    }
}
DI void final_norm_phase(float* x, const float* gain, int gw, int NGW, int lane) {
    for (int row = gw; row < M; row += NGW) {
        float* xr = x + (size_t)row * D; f32x4 v[4]; float ss = 0.f;
#pragma unroll
        for (int j = 0; j < 4; ++j) { v[j] = *(const f32x4*)(xr + 4 * (64 * j + lane)); ss += (v[j].x * v[j].x + v[j].y * v[j].y) + (v[j].z * v[j].z + v[j].w * v[j].w); }
        const float rstd = 1.0f / sqrtf(wave_sum(ss) * (1.f / D) + EPS);
#pragma unroll
        for (int j = 0; j < 4; ++j) { const int c = 4 * (64 * j + lane); *(f32x4*)(xr + c) = v[j] * rstd * *(const f32x4*)(gain + c); }
    }
}
#define EPI_ARGS const f32x4 (&acc)[2][2][4][2], const Unit& u, int wr, int wc, int fr, int fq
DI v4u pack8(const f32x4& a, const f32x4& b) { v4u w; w.x = pk2(a.x, a.y); w.y = pk2(a.z, a.w); w.z = pk2(b.x, b.y); w.w = pk2(b.z, b.w); return w; }
DI void unpack8(const v4u& w, f32x4& a, f32x4& b) { a = (f32x4){bflo(w.x), bfhi(w.x), bflo(w.y), bfhi(w.y)}; b = (f32x4){bflo(w.z), bfhi(w.z), bflo(w.w), bfhi(w.w)}; }
DI f32x4 shx4(const f32x4& v, int m) { return (f32x4){__shfl_xor(v.x, m), __shfl_xor(v.y, m), __shfl_xor(v.z, m), __shfl_xor(v.w, m)}; }
DI void rope8(f32x4& v0, f32x4& v1, const float2* cs, int xm, float sgn) {
    const f32x4 p0 = shx4(v0, xm), p1 = shx4(v1, xm);
    const f32x4 t0 = *(const f32x4*)(cs), t1 = *(const f32x4*)(cs + 2), t2 = *(const f32x4*)(cs + 4), t3 = *(const f32x4*)(cs + 6);
    v0 = (f32x4){v0.x * t0.x + sgn * p0.x * t0.y, v0.y * t0.z + sgn * p0.y * t0.w, v0.z * t1.x + sgn * p0.z * t1.y, v0.w * t1.z + sgn * p0.w * t1.w};
    v1 = (f32x4){v1.x * t2.x + sgn * p1.x * t2.y, v1.y * t2.z + sgn * p1.y * t2.w, v1.z * t3.x + sgn * p1.z * t3.y, v1.w * t3.z + sgn * p1.w * t3.w};
}

struct EpiSwiglu { static constexpr bool PERM = true, AFTER_DRAIN = false; bf16* O;
    DI void operator()(EPI_ARGS) const {
        asm volatile("" : "+v"(fr), "+v"(fq));
        const int row0 = u.pm * 256 + wr * 64 + fr, col0 = u.pn * 128 + wc * 32 + 8 * fq;
#pragma unroll
        for (int ai = 0; ai < 2; ++ai)
#pragma unroll
            for (int m = 0; m < 4; ++m) { f32x4 o[2];
#pragma unroll
                for (int n = 0; n < 2; ++n) { const f32x4 g = acc[ai][0][m][n], uu = acc[ai][1][m][n];
#pragma unroll
                    for (int j = 0; j < 4; ++j) o[n][j] = g[j] * sigm(g[j]) * uu[j]; }
                *(v4u*)(O + (size_t)(row0 + ai * 128 + m * 16) * FF + col0) = pack8(o[0], o[1]); }
    }
};
struct EpiResid { static constexpr bool PERM = false, AFTER_DRAIN = false; const float* inA; const float* inB; float* out; const float* mods; int gslot; float coef;
    DI void operator()(EPI_ARGS) const {
        asm volatile("" : "+v"(fr), "+v"(fq));
        const int row0 = u.pm * 256 + wr * 64 + fr, col0 = u.pn * 256 + wc * 32 + 4 * fq;
        const float* gate = mods + mod_index(u.pm * 256) * NMODS + gslot * D;
        f32x4 gv[2][2];
#pragma unroll
        for (int bj = 0; bj < 2; ++bj)
#pragma unroll
            for (int n = 0; n < 2; ++n) gv[bj][n] = *(const f32x4*)(gate + col0 + bj * 128 + n * 16) * coef;
#pragma unroll
        for (int ai = 0; ai < 2; ++ai)
#pragma unroll
            for (int m = 0; m < 4; ++m) { const int row = row0 + ai * 128 + m * 16;
                const float* ip = row < MP ? inA + (size_t)row * D : inB + (size_t)(row - MP) * D; float* op = out + (size_t)row * D;
#pragma unroll
                for (int bj = 0; bj < 2; ++bj)
#pragma unroll
                    for (int n = 0; n < 2; ++n) { const int c = col0 + bj * 128 + n * 16; *(f32x4*)(op + c) = *(const f32x4*)(ip + c) + gv[bj][n] * acc[ai][bj][m][n]; } }
    }
};
struct EpiWin { static constexpr bool PERM = true, AFTER_DRAIN = false;
    bf16 *qa, *ka, *vaT, *qlat, *ckv, *ga, *gb, *krope; float *ssq_q, *ssq_kv; float* out; const float2* ropeA; const float2* ropeB;
    DI void operator()(EPI_ARGS) const {
        asm volatile("" : "+v"(fr), "+v"(fq));
        const int pn = u.pn; const bool sample = u.pm >= 32;
        const int rbase = u.pm * 256 + wr * 64 + fr;
        if (pn < 3) {
#pragma unroll
            for (int ai = 0; ai < 2; ++ai)
#pragma unroll
                for (int m = 0; m < 4; ++m) { const int row = rbase + ai * 128 + m * 16; const int t = (row - MP) & 2047; const int pos = (wc & 1) ? (t & 63) : (t >> 6);
                    const float2* cs = ropeA + pos * 16 + 8 * (fq & 1); const float sgn = (fq & 2) ? 1.f : -1.f;
#pragma unroll
                    for (int bj = 0; bj < 2; ++bj) { f32x4 v0 = acc[ai][bj][m][0], v1 = acc[ai][bj][m][1]; const int cl = bj * 128 + wc * 32 + 8 * fq;
                        if (pn < 2) { if (sample) rope8(v0, v1, cs, 32, sgn); v0 = v0 * A_QS; v1 = v1 * A_QS; *(v4u*)(qa + (size_t)row * 512 + pn * 256 + cl) = pack8(v0, v1); }
                        else if (bj == 0) { if (sample) rope8(v0, v1, cs, 32, sgn); *(v4u*)(ka + (size_t)row * 128 + cl) = pack8(v0, v1);
                            if (!sample) { float* o = out + OUT_K + (size_t)row * 128 + cl; *(f32x4*)o = v0; *(f32x4*)(o + 4) = v1; } }
                        else { const int c = cl - 128;
#pragma unroll
                            for (int j = 0; j < 4; ++j) { vaT[(size_t)(c + j) * MALL + row] = (bf16)f2bf(v0[j]); vaT[(size_t)(c + 4 + j) * MALL + row] = (bf16)f2bf(v1[j]); }
                            if (!sample) { float* o = out + OUT_V + (size_t)row * 128 + c; *(f32x4*)o = v0; *(f32x4*)(o + 4) = v1; } } } }
        } else if (pn < 5) {
            bf16* dst = pn == 3 ? qlat : ckv; float* ssq = pn == 3 ? ssq_q : ssq_kv;
#pragma unroll
            for (int ai = 0; ai < 2; ++ai)
#pragma unroll
                for (int m = 0; m < 4; ++m) { const int row = rbase + ai * 128 + m * 16; float s = 0.f;
#pragma unroll
                    for (int bj = 0; bj < 2; ++bj) { const f32x4 v0 = acc[ai][bj][m][0], v1 = acc[ai][bj][m][1];
                        s += (v0.x * v0.x + v0.y * v0.y) + (v0.z * v0.z + v0.w * v0.w) + (v1.x * v1.x + v1.y * v1.y) + (v1.z * v1.z + v1.w * v1.w);
                        *(v4u*)(dst + (size_t)row * 256 + bj * 128 + wc * 32 + 8 * fq) = pack8(v0, v1); }
                    s += __shfl_xor(s, 16); s += __shfl_xor(s, 32);
                    if (fq == 0) atomicAdd(ssq + row, s); }
        } else if (pn < 13) {
            bf16* dst = pn < 9 ? ga : gb; const int ct = ((pn - 5) & 3) * 256;
#pragma unroll
            for (int ai = 0; ai < 2; ++ai)
#pragma unroll
                for (int m = 0; m < 4; ++m) { const int row = rbase + ai * 128 + m * 16;
#pragma unroll
                    for (int bj = 0; bj < 2; ++bj) { f32x4 v0 = acc[ai][bj][m][0], v1 = acc[ai][bj][m][1];
#pragma unroll
                        for (int j = 0; j < 4; ++j) { v0[j] = sigm(v0[j]); v1[j] = sigm(v1[j]); }
                        *(v4u*)(dst + (size_t)row * D + ct + bj * 128 + wc * 32 + 8 * fq) = pack8(v0, v1); } }
        } else if (wc == 0) {
#pragma unroll
            for (int ai = 0; ai < 2; ++ai)
#pragma unroll
                for (int m = 0; m < 4; ++m) { const int row = rbase + ai * 128 + m * 16; const int t = (row - MP) & 2047; const int pos = (fq & 2) ? (t & 63) : (t >> 6);
                    f32x4 v0 = acc[ai][0][m][0], v1 = acc[ai][0][m][1];
                    if (sample) rope8(v0, v1, ropeB + pos * 8, 16, (fq & 1) ? 1.f : -1.f);
                    *(v4u*)(krope + (size_t)row * 32 + 8 * fq) = pack8(v0, v1);
                    if (!sample) { float* o = out + OUT_KR + (size_t)row * 32 + 8 * fq; *(f32x4*)o = v0; *(f32x4*)(o + 4) = v1; } }
        }
    }
};
struct EpiQB { static constexpr bool PERM = true, AFTER_DRAIN = false; bf16* qb; const float* ssq; const float2* ropeB;
    DI void operator()(EPI_ARGS) const {
        asm volatile("" : "+v"(fr), "+v"(fq));
        const int rbase = u.pm * 256 + wr * 64 + fr; const bool sample = u.pm >= 32;
#pragma unroll
        for (int ai = 0; ai < 2; ++ai)
#pragma unroll
            for (int m = 0; m < 4; ++m) { const int row = rbase + ai * 128 + m * 16; const float rs = 1.0f / sqrtf(ssq[row] * (1.f / 256.f) + EPS);
                const int t = (row - MP) & 2047; const int pos = (fq & 2) ? (t & 63) : (t >> 6);
#pragma unroll
                for (int bj = 0; bj < 2; ++bj) { f32x4 v0 = acc[ai][bj][m][0] * rs, v1 = acc[ai][bj][m][1] * rs;
                    if (u.pn == 2 && sample) rope8(v0, v1, ropeB + pos * 8, 16, (fq & 1) ? 1.f : -1.f);
                    *(v4u*)(qb + (size_t)row * 768 + u.pn * 256 + bj * 128 + wc * 32 + 8 * fq) = pack8(v0, v1); } }
    }
};
struct EpiKN { static constexpr bool PERM = true, AFTER_DRAIN = false; bf16* kn; const float* ssq;
    DI void operator()(EPI_ARGS) const {
        asm volatile("" : "+v"(fr), "+v"(fq));
        const int rbase = u.pm * 256 + wr * 64 + fr; const bool lat = u.pm < 64;
#pragma unroll
        for (int ai = 0; ai < 2; ++ai)
#pragma unroll
            for (int m = 0; m < 4; ++m) { const int row = rbase + ai * 128 + m * 16; const float rs = lat ? 1.0f / sqrtf(ssq[row] * (1.f / 256.f) + EPS) : 1.0f;
#pragma unroll
                for (int bj = 0; bj < 2; ++bj) *(v4u*)(kn + (size_t)row * 512 + u.pn * 256 + bj * 128 + wc * 32 + 8 * fq) = pack8(acc[ai][bj][m][0] * rs, acc[ai][bj][m][1] * rs); }
    }
};
struct EpiVT { static constexpr bool PERM = true, AFTER_DRAIN = false; bf16* vt; const float* ssq;
    DI void operator()(EPI_ARGS) const {
        asm volatile("" : "+v"(fr), "+v"(fq));
        const int rbase = u.pm * 256 + wr * 64 + fr; const bool lat = u.pn < 64;
        f32x4 rs[2][2];
#pragma unroll
        for (int bj = 0; bj < 2; ++bj)
#pragma unroll
            for (int n = 0; n < 2; ++n) { const int c = u.pn * 256 + bj * 128 + wc * 32 + 8 * fq + 4 * n;
                if (lat) { const f32x4 q = *(const f32x4*)(ssq + c); rs[bj][n] = (f32x4){1.0f / sqrtf(q.x * (1.f / 256.f) + EPS), 1.0f / sqrtf(q.y * (1.f / 256.f) + EPS), 1.0f / sqrtf(q.z * (1.f / 256.f) + EPS), 1.0f / sqrtf(q.w * (1.f / 256.f) + EPS)}; }
                else rs[bj][n] = (f32x4){1.f, 1.f, 1.f, 1.f}; }
#pragma unroll
        for (int ai = 0; ai < 2; ++ai)
#pragma unroll
            for (int m = 0; m < 4; ++m) { const int row = rbase + ai * 128 + m * 16;
#pragma unroll
                for (int bj = 0; bj < 2; ++bj) *(v4u*)(vt + (size_t)row * MALL + u.pn * 256 + bj * 128 + wc * 32 + 8 * fq) = pack8(acc[ai][bj][m][0] * rs[bj][0], acc[ai][bj][m][1] * rs[bj][1]); }
    }
};
template <bool SECOND> struct EpiMerge { static constexpr bool PERM = true, AFTER_DRAIN = false; bf16* mm; const bf16* g;
    DI void operator()(EPI_ARGS) const {
        asm volatile("" : "+v"(fr), "+v"(fq));
        const int rbase = u.pm * 256 + wr * 64 + fr;
#pragma unroll
        for (int ai = 0; ai < 2; ++ai)
#pragma unroll
            for (int m = 0; m < 4; ++m) { const int row = rbase + ai * 128 + m * 16;
#pragma unroll
                for (int bj = 0; bj < 2; ++bj) { const size_t o = (size_t)row * D + u.pn * 256 + bj * 128 + wc * 32 + 8 * fq;
                    f32x4 g0, g1; unpack8(*(const v4u*)(g + o), g0, g1); f32x4 v0 = acc[ai][bj][m][0] * g0, v1 = acc[ai][bj][m][1] * g1;
                    if (SECOND) { f32x4 p0, p1; unpack8(*(const v4u*)(mm + o), p0, p1); v0 += p0; v1 += p1; }
                    *(v4u*)(mm + o) = pack8(v0, v1); } }
    }
};
#define MFMA32(a, b, c) __builtin_amdgcn_mfma_f32_32x32x16_bf16((a), (b), (c), 0, 0, 0)
template <int DQ>
DI void attn_unit(LAS unsigned char* lds, int tid, int lane,
                  const bf16* qn, int ldqn, const bf16* qr, int ldqr,
                  const bf16* Kb, int ldk, const bf16* Kr, const bf16* Vt,
                  int s0_tok, int s0_n, int s1_tok, int s1_n, bool band, int qtok,
                  float m_init, float l_init, bf16* outp, int ldo) {
    constexpr int KS = DQ * 2 + 16, VS = 144, BUF = 64 * KS + 64 * VS, NKS = DQ / 16;
    const int r = lane & 31, hh = lane >> 5;
    const int pr = (r & ~12) | ((r & 4) << 1) | ((r & 8) >> 1);
    bf16x8 qf[NKS];
#pragma unroll
    for (int ks = 0; ks < NKS; ++ks) qf[ks] = ks < 4 ? *(const bf16x8*)(qn + (size_t)r * ldqn + 16 * ks + 8 * hh) : *(const bf16x8*)(qr + (size_t)r * ldqr + 16 * (ks - 4) + 8 * hh);
    f32x16 ot[2];
#pragma unroll
    for (int i = 0; i < 16; ++i) { ot[0][i] = 0.f; ot[1][i] = 0.f; }
    float mrun = m_init, lrun = l_init;
    const int ntile = s0_n + s1_n;
    const int krow = tid >> 3, kch = tid & 7, rrow = tid >> 2, rch = tid & 3;
    v4u kreg, rreg, vreg;
    auto tile_tok = [&](int t) { return t < s0_n ? s0_tok + 64 * t : s1_tok + 64 * (t - s0_n); };
    auto gload = [&](int t) { const int tok0 = tile_tok(t);
        kreg = *(const v4u*)(Kb + (size_t)(tok0 + krow) * ldk + kch * 8);
        if (DQ == 96) { if (tid < 256) rreg = *(const v4u*)(Kr + (size_t)(tok0 + rrow) * 32 + rch * 8); }
        vreg = *(const v4u*)(Vt + (size_t)krow * MALL + tok0 + kch * 8); };
    auto lstore = [&](int b) { LAS unsigned char* kb_ = lds + b * BUF;
        *(LAS v4u*)(kb_ + krow * KS + kch * 16) = kreg;
        if (DQ == 96) { if (tid < 256) *(LAS v4u*)(kb_ + rrow * KS + 128 + rch * 16) = rreg; }
        *(LAS v4u*)(kb_ + 64 * KS + krow * VS + kch * 16) = vreg; };
    gload(0); lstore(0); __syncthreads();
    for (int t = 0; t < ntile; ++t) {
        const bool more = t + 1 < ntile;
        if (more) gload(t + 1);
        LAS unsigned char* kb_ = lds + (t & 1) * BUF; LAS unsigned char* vb_ = kb_ + 64 * KS;
        f32x16 st[2];
#pragma unroll
        for (int kb = 0; kb < 2; ++kb) {
#pragma unroll
            for (int i = 0; i < 16; ++i) st[kb][i] = 0.f;
#pragma unroll
            for (int ks = 0; ks < NKS; ++ks) { const bf16x8 kf = *(const LAS bf16x8*)(kb_ + (32 * kb + pr) * KS + (16 * ks + 8 * hh) * 2); st[kb] = MFMA32(kf, qf[ks], st[kb]); }
        }
        if (band && t < s0_n) { const int d0 = tile_tok(t) + 8 * hh - (qtok + r);
#pragma unroll
            for (int kb = 0; kb < 2; ++kb)
#pragma unroll
                for (int i = 0; i < 16; ++i) { const int d = d0 + 32 * kb + 16 * (i >> 3) + (i & 7); if (d > 128 || d < -128) st[kb][i] = -1e30f; } }
        float mx = st[0][0];
#pragma unroll
        for (int kb = 0; kb < 2; ++kb)
#pragma unroll
            for (int i = 0; i < 16; ++i) mx = fmaxf(mx, st[kb][i]);
        mx = fmaxf(mx, __shfl_xor(mx, 32));
        const float mnew = fmaxf(mrun, mx), alpha = fexp2(mrun - mnew); mrun = mnew;
        float ps = 0.f;
#pragma unroll
        for (int kb = 0; kb < 2; ++kb)
#pragma unroll
            for (int i = 0; i < 16; ++i) { const float p = fexp2(st[kb][i] - mnew); st[kb][i] = p; ps += p; }
        lrun = lrun * alpha + ps;
#pragma unroll
        for (int i = 0; i < 16; ++i) { ot[0][i] *= alpha; ot[1][i] *= alpha; }
#pragma unroll
        for (int kb = 0; kb < 2; ++kb)
#pragma unroll
            for (int s = 0; s < 2; ++s) { v4u pw; pw.x = pk2(st[kb][8 * s], st[kb][8 * s + 1]); pw.y = pk2(st[kb][8 * s + 2], st[kb][8 * s + 3]); pw.z = pk2(st[kb][8 * s + 4], st[kb][8 * s + 5]); pw.w = pk2(st[kb][8 * s + 6], st[kb][8 * s + 7]);
                const bf16x8 pf = __builtin_bit_cast(bf16x8, pw);
#pragma unroll
                for (int db = 0; db < 2; ++db) { const bf16x8 vf = *(const LAS bf16x8*)(vb_ + (32 * db + r) * VS + (32 * kb + 16 * s + 8 * hh) * 2); ot[db] = MFMA32(vf, pf, ot[db]); } }
        if (more) lstore((t + 1) & 1);
        __syncthreads();
    }
    const float inv = 1.0f / (lrun + __shfl_xor(lrun, 32));
#pragma unroll
    for (int db = 0; db < 2; ++db)
#pragma unroll
        for (int a4 = 0; a4 < 4; ++a4) { v2u w; w.x = pk2(ot[db][4 * a4] * inv, ot[db][4 * a4 + 1] * inv); w.y = pk2(ot[db][4 * a4 + 2] * inv, ot[db][4 * a4 + 3] * inv);
            *(v2u*)(outp + (size_t)r * ldo + 32 * db + 8 * a4 + 4 * hh) = w; }
}

DI void attn_phase(const Args& a, LAS unsigned char* lds, int tid, int wave, int lane) {
    unsigned char* ws = a.ws;
    const bf16* qa = (const bf16*)(ws + OFF_QA); const bf16* ka = (const bf16*)(ws + OFF_KA); const bf16* vaT = (const bf16*)(ws + OFF_VAT);
    const bf16* qb = (const bf16*)(ws + OFF_QB); const bf16* kn = (const bf16*)(ws + OFF_KN); const bf16* kr = (const bf16*)(ws + OFF_KROPE); const bf16* vbT = (const bf16*)(ws + OFF_VBT);
    bf16* oa = (bf16*)(ws + OFF_OA); bf16* ob = (bf16*)(ws + OFF_OB);
    const float* sink = a.in[15];
    for (int uu = blockIdx.x; uu < 1024; uu += gridDim.x) {
        const int type = uu >> 8, u0 = uu & 255, vu = (u0 & 7) * 32 + (u0 >> 3);
        if (type == 0) {
            const int b = vu >> 6, h = (vu >> 3) & 7, qblk = vu & 7; const int tok = MP + b * 2048 + qblk * 256 + 32 * wave;
            attn_unit<96>(lds, tid, lane, qb + (size_t)tok * 768 + h * 64, 768, qb + (size_t)tok * 768 + 512 + h * 32, 768, kn + h * 64, 512, kr, vbT + (size_t)(h * 64) * MALL,
                          M + b * 512, 8, MP + b * 2048, 32, false, 0, -1e30f, 0.f, ob + (size_t)tok * 512 + h * 64, 512);
        } else if (type == 1) {
            const int b = vu >> 6, kh = (vu >> 5) & 1, qblk = vu & 31; const int head = kh * 4 + (wave >> 1); const int tok = MP + b * 2048 + qblk * 64 + 32 * (wave & 1);
            const int lo = qblk - 2 < 0 ? 0 : qblk - 2, hi = qblk + 2 > 31 ? 31 : qblk + 2;
            attn_unit<64>(lds, tid, lane, qa + (size_t)tok * 512 + head * 64, 512, nullptr, 0, ka + kh * 64, 128, nullptr, vaT + (size_t)(kh * 64) * MALL,
                          MP + b * 2048 + lo * 64, hi - lo + 1, M + b * 512, 8, true, tok, sink[head] * LOG2E, (lane >> 5) ? 0.f : 1.f, oa + (size_t)tok * 512 + head * 64, 512);
        } else if (type == 2) {
            const int b = vu >> 3, kh = (vu >> 2) & 1, qblk = vu & 3; const int head = kh * 4 + (wave >> 1); const int tok = b * 256 + qblk * 64 + 32 * (wave & 1);
            attn_unit<64>(lds, tid, lane, qa + (size_t)tok * 512 + head * 64, 512, nullptr, 0, ka + kh * 64, 128, nullptr, vaT + (size_t)(kh * 64) * MALL,
                          b * 256, 4, 0, 0, false, 0, sink[head] * LOG2E, (lane >> 5) ? 0.f : 1.f, oa + (size_t)tok * 512 + head * 64, 512);
        } else {
            const int b = vu >> 3, h = vu & 7; const int tok = b * 256 + 32 * wave;
            attn_unit<96>(lds, tid, lane, qb + (size_t)tok * 768 + h * 64, 768, qb + (size_t)tok * 768 + 512 + h * 32, 768, kn + h * 64, 512, kr, vbT + (size_t)(h * 64) * MALL,
                          b * 256, 4, 0, 0, false, 0, -1e30f, 0.f, ob + (size_t)tok * 512 + h * 64, 512);
        }
    }
}

__global__ void __launch_bounds__(512, 2) mk_fwd(Args a) {
    extern __shared__ __attribute__((aligned(16))) unsigned char lds_raw[];
    LAS unsigned char* lds = (LAS unsigned char*)lds_raw;
    cg::grid_group grid = cg::this_grid();
    const int tid = threadIdx.x, lane = tid & 63, wave = __builtin_amdgcn_readfirstlane(tid >> 6);
    const int G = gridDim.x, gw = blockIdx.x * 8 + wave, NGW = G * 8, gtid = blockIdx.x * 512 + tid, NT = G * 512;
    unsigned char* ws = a.ws;
    float* mods = (float*)(ws + OFF_MODS); float* ssq_q = (float*)(ws + OFF_SSQQ); float* ssq_kv = (float*)(ws + OFF_SSQKV);
    const float2* ropeA = (const float2*)(ws + OFF_ROPEA); const float2* ropeB = (const float2*)(ws + OFF_ROPEB);
    bf16* H = (bf16*)(ws + OFF_H); bf16* ACT = (bf16*)(ws + OFF_ACT);
    float* xr = a.out;
    const int lo = a.ph_lo, hi = a.ph_hi;
#ifndef P6M
#define P6M 7
#endif
#ifndef PH_MASK
#define PH_MASK 0x3fff
#endif
#define IN(k) (((PH_MASK >> (k)) & 1) && lo <= (k) && (k) < hi)
#define SEAM(k) do { if (IN(k) && IN((k) + 1)) grid.sync(); } while (0)
    if (IN(0)) { p0_weights(a, lds, gw, NGW, wave, lane); p0_misc(a, gtid, NT); p0_ada(a, lds, tid); }
    SEAM(0);
    if (IN(1)) norm_mod_phase(a.in[0], a.in[1], a.in[10], mods, 0, H, gw, NGW, lane);
    SEAM(1);
    if (IN(2)) { pg8::Gemm g{H, (const bf16*)(ws + OFF_WGU1), M, NGU, D}; pg8::StaticOrder S; S.init(M, NGU, G, (int)blockIdx.x); EpiSwiglu E{ACT};
        pg8::gemm_phase<EpiSwiglu, pg8::StaticOrder, PG8_ALIGN, PG8_SP2>(lds, g, S, E); }
    SEAM(2);
    if (IN(3)) { pg8::Gemm g{ACT, (const bf16*)(ws + OFF_WD1), M, D, FF}; pg8::StaticOrder S; S.init(M, D, G, (int)blockIdx.x); EpiResid E{a.in[0], a.in[1], xr, mods, 2, 0.5f};
        pg8::gemm_phase<EpiResid, pg8::StaticOrder, PG8_ALIGN, PG8_SP2>(lds, g, S, E); }
    SEAM(3);
    if (IN(4)) { norm_mod_phase(xr, xr + (size_t)MP * D, a.in[13], mods, 1, H, gw, NGW, lane); ctx_convert(a, gtid, NT); }
    SEAM(4);
    if (IN(5)) { pg8::Gemm g{H, (const bf16*)(ws + OFF_WIN), M, NINP, D}; pg8::StaticOrder S; S.init(M, NINP, G, (int)blockIdx.x);
        EpiWin E{(bf16*)(ws + OFF_QA), (bf16*)(ws + OFF_KA), (bf16*)(ws + OFF_VAT), (bf16*)(ws + OFF_QLAT), (bf16*)(ws + OFF_CKV), (bf16*)(ws + OFF_GA), (bf16*)(ws + OFF_GB), (bf16*)(ws + OFF_KROPE),
                 ssq_q, ssq_kv, a.out, ropeA, ropeB};
        pg8::gemm_phase<EpiWin, pg8::StaticOrder, PG8_ALIGN, PG8_SP2>(lds, g, S, E); }
    SEAM(5);
    if (IN(6)) {
        int K6 = 256; asm volatile("" : "+s"(K6));
#if P6M & 1
        { pg8::Gemm g{(const bf16*)(ws + OFF_QLAT), (const bf16*)(ws + OFF_WUQ), M, 768, K6}; pg8::StaticOrder S; S.init(M, 768, G, (int)blockIdx.x); EpiQB E{(bf16*)(ws + OFF_QB), ssq_q, ropeB};
          pg8::gemm_phase<EpiQB, pg8::StaticOrder, PG8_ALIGN, PG8_SP2>(lds, g, S, E); }
#endif
#if P6M & 2
        { pg8::Gemm g{(const bf16*)(ws + OFF_CKV), (const bf16*)(ws + OFF_WK), MALL, 512, K6}; pg8::StaticOrder S; S.init(MALL, 512, G, (int)((blockIdx.x + 64) % G)); EpiKN E{(bf16*)(ws + OFF_KN), ssq_kv};
          pg8::gemm_phase<EpiKN, pg8::StaticOrder, PG8_ALIGN, PG8_SP2>(lds, g, S, E); }
#endif
#if P6M & 4
        { pg8::Gemm g{(const bf16*)(ws + OFF_WV), (const bf16*)(ws + OFF_CKV), 512, MALL, K6}; pg8::StaticOrder S; S.init(512, MALL, G, (int)((blockIdx.x + 176) % G)); EpiVT E{(bf16*)(ws + OFF_VBT), ssq_kv};
          pg8::gemm_phase<EpiVT, pg8::StaticOrder, PG8_ALIGN, PG8_SP2>(lds, g, S, E); }
#endif
        { const bf16* ckv = (const bf16*)(ws + OFF_CKV); const float* gn = a.in[17]; float* o = a.out + OUT_CKV;
          for (int row = gw; row < MP; row += NGW) { const float rs = 1.0f / sqrtf(ssq_kv[row] * (1.f / 256.f) + EPS); const v2u w = *(const v2u*)(ckv + (size_t)row * 256 + 4 * lane); const f32x4 g4 = *(const f32x4*)(gn + 4 * lane);
              *(f32x4*)(o + (size_t)row * 256 + 4 * lane) = (f32x4){bflo(w.x), bfhi(w.x), bflo(w.y), bfhi(w.y)} * rs * g4; } }
    }
    SEAM(6);
    if (IN(7)) attn_phase(a, lds, tid, wave, lane);
    SEAM(7);
    if (IN(8)) {
        { pg8::Gemm g{(const bf16*)(ws + OFF_OA), (const bf16*)(ws + OFF_WOA), M, D, 512}; pg8::StaticOrder S; S.init(M, D, G, (int)blockIdx.x); EpiMerge<false> E{(bf16*)(ws + OFF_MM), (const bf16*)(ws + OFF_GA)};
          pg8::gemm_phase<EpiMerge<false>, pg8::StaticOrder, PG8_ALIGN, PG8_SP2>(lds, g, S, E); }
        { pg8::Gemm g{(const bf16*)(ws + OFF_OB), (const bf16*)(ws + OFF_WOB), M, D, 512}; pg8::StaticOrder S; S.init(M, D, G, (int)blockIdx.x); EpiMerge<true> E{(bf16*)(ws + OFF_MM), (const bf16*)(ws + OFF_GB)};
          pg8::gemm_phase<EpiMerge<true>, pg8::StaticOrder, PG8_ALIGN, PG8_SP2>(lds, g, S, E); }
    }
    SEAM(8);
    if (IN(9)) { pg8::Gemm g{(const bf16*)(ws + OFF_MM), (const bf16*)(ws + OFF_WOUT), M, D, D}; pg8::StaticOrder S; S.init(M, D, G, (int)blockIdx.x); EpiResid E{xr, xr + (size_t)MP * D, xr, mods, 5, 1.0f};
        pg8::gemm_phase<EpiResid, pg8::StaticOrder, PG8_ALIGN, PG8_SP2>(lds, g, S, E); }
    SEAM(9);
    if (IN(10)) norm_mod_phase(xr, xr + (size_t)MP * D, a.in[23], mods, 2, H, gw, NGW, lane);
    SEAM(10);
    if (IN(11)) { pg8::Gemm g{H, (const bf16*)(ws + OFF_WGU2), M, NGU, D}; pg8::StaticOrder S; S.init(M, NGU, G, (int)blockIdx.x); EpiSwiglu E{ACT};
        pg8::gemm_phase<EpiSwiglu, pg8::StaticOrder, PG8_ALIGN, PG8_SP2>(lds, g, S, E); }
    SEAM(11);
    if (IN(12)) { pg8::Gemm g{ACT, (const bf16*)(ws + OFF_WD2), M, D, FF}; pg8::StaticOrder S; S.init(M, D, G, (int)blockIdx.x); EpiResid E{xr, xr + (size_t)MP * D, xr, mods, 8, 0.5f};
        pg8::gemm_phase<EpiResid, pg8::StaticOrder, PG8_ALIGN, PG8_SP2>(lds, g, S, E); }
    SEAM(12);
    if (IN(13)) final_norm_phase(xr, a.in[26], gw, NGW, lane);

#ifdef PROBE_SCALE
    grid.sync();
    { const size_t ranges[6][2] = {{0, (size_t)MP * D}, {(size_t)MP * D, (size_t)M * D}, {OUT_K, OUT_V}, {OUT_V, OUT_CKV}, {OUT_CKV, OUT_KR}, {OUT_KR, OUT_KR + 8192 * 32}};
#pragma unroll
      for (int o = 0; o < 6; ++o) if ((PROBE_SCALE >> o) & 1) for (size_t i = ranges[o][0] + gtid; i < ranges[o][1]; i += NT) a.out[i] *= 1.01f; }
#endif
#undef IN
#undef SEAM
}

constexpr int N_PHASES = 14;
extern "C" void kernel_launch(void* const* d_in, const int* in_sizes, int n_in, void* d_out, int out_size, void* d_ws, size_t ws_size, hipStream_t stream) {
    static int grid = 0;
    if (grid == 0) {
        if (n_in != 27 || ws_size < WS_END) { fprintf(stderr, "kernel_launch: unexpected n_in %d / ws %zu\n", n_in, ws_size); grid = -1; return; }
        int dev = 0, cus = 0, per_cu = 0;
        hipGetDevice(&dev); hipDeviceGetAttribute(&cus, hipDeviceAttributeMultiprocessorCount, dev);
        if (hipFuncSetAttribute((const void*)mk_fwd, hipFuncAttributeMaxDynamicSharedMemorySize, LDS_BYTES) != hipSuccess) { fprintf(stderr, "kernel_launch: hipFuncSetAttribute failed\n"); grid = -1; return; }
        if (hipOccupancyMaxActiveBlocksPerMultiprocessor(&per_cu, (const void*)mk_fwd, 512, LDS_BYTES) != hipSuccess || per_cu < 1) { fprintf(stderr, "kernel_launch: occupancy query gave %d\n", per_cu); per_cu = 1; }
        (void)hipGetLastError();
        grid = cus * 1;
        fprintf(stderr, "kernel_launch: cus %d per_cu %d grid %d\n", cus, per_cu, grid);
    }
    if (grid < 0) return;
    (void)hipMemsetAsync(d_ws, 0, ZERO_BYTES, stream);
    Args a{};
    for (int i = 0; i < 27; ++i) a.in[i] = (const float*)d_in[i];
    a.out = (float*)d_out; a.ws = (unsigned char*)d_ws;
#if MK_N_LAUNCHES == 1
    a.ph_lo = 0; a.ph_hi = N_PHASES;
    void* args[] = {&a};
    hipError_t e = hipLaunchCooperativeKernel((const void*)mk_fwd, dim3(grid), dim3(512), args, LDS_BYTES, stream);
    if (e != hipSuccess) fprintf(stderr, "cooperative launch failed: %s (grid %d)\n", hipGetErrorString(e), grid);
#else
    for (int p = 0; p < N_PHASES; ++p) { a.ph_lo = p; a.ph_hi = p + 1; hipLaunchKernelGGL(mk_fwd, dim3(grid), dim3(512), LDS_BYTES, stream, a); }
#endif
}
```

```cpp
#include <hip/hip_runtime.h>
#include <hip/hip_cooperative_groups.h>
#include <cstdio>
#include <cstdint>
namespace cg = cooperative_groups;
namespace pg8 {
#define PG8_LAS __attribute__((address_space(3)))
typedef unsigned short bf16_t;
typedef short bf16x8 __attribute__((ext_vector_type(8)));
typedef float f32x4 __attribute__((ext_vector_type(4)));
typedef unsigned u32x4 __attribute__((ext_vector_type(4)));
constexpr int BM = 256, BK = 64, HALF = 128, HTB = HALF * BK * 2  , STAGE_BYTES = 8 * HTB, NXCD = 8, WGM = 8;

__host__ __device__ __forceinline__ int lds_byte(int r, int c) { const int st = (r >> 4) * 2 + (c >> 5), rr = r & 15, cc = c & 31, ob = rr * 64 + cc * 2; return st * 1024 + (ob ^ (((ob >> 9) & 1) << 5)); }
__host__ __device__ __forceinline__ void stage_rc(int b, int& R, int& C) { const int st = b / 1024, sb = b % 1024, swz = sb ^ (((sb >> 9) & 1) << 5); R = (st >> 1) * 16 + swz / 64; C = (st & 1) * 32 + (swz % 64) / 2; }
__host__ __device__ __forceinline__ int perm32(int rho) { const int n = rho >> 4, i = rho & 15; return 8 * (i >> 2) + 4 * n + (i & 3); }

struct Unit { int pm, pn; };
struct Gemm { const bf16_t* A; const bf16_t* Bt; int M, N, K; };

struct StaticOrder {
    int nM, nN, nwg, G, c;
    __host__ __device__ void init(int M, int N, int G_, int c_) { nM = M / BM; nN = N / BM; nwg = nM * nN; G = G_; c = c_; }
    __host__ __device__ bool next(int i, Unit& u) const {
        const long L = (long)i * G + c; if (L >= nwg) return false;
        int wgid = (int)L; { const int q = nwg / NXCD, r = nwg % NXCD, xcd = wgid % NXCD, off = wgid / NXCD; wgid = (xcd < r ? xcd * (q + 1) : r * (q + 1) + (xcd - r) * q) + off; }
        const int nig = WGM * nN, gid = wgid / nig, fm = gid * WGM, gsz = (nM - fm) < WGM ? (nM - fm) : WGM;
        u.pm = fm + ((wgid % nig) % gsz); u.pn = (wgid % nig) / gsz; return true;
    }
    __device__ __forceinline__ void a_ready(const Unit&) const {}
    __device__ __forceinline__ void done(const Unit&) const {}
};
__device__ __forceinline__ unsigned cvt_pk_bf16(float lo, float hi) { unsigned r; asm volatile("v_cvt_pk_bf16_f32 %0, %1, %2" : "=v"(r) : "v"(lo), "v"(hi)); return r; }
typedef float f32x2 __attribute__((ext_vector_type(2)));
template <class Epi, class Sched, bool ALIGN_EPI = false, bool SP2 = false>
__device__ __forceinline__ void gemm_phase(PG8_LAS unsigned char* lds, const Gemm g, const Sched& S, const Epi& E) {
    const int tid = threadIdx.x, wid = __builtin_amdgcn_readfirstlane(tid >> 6), lane = tid & 63, wr = wid >> 2, wc = wid & 3, fr = lane & 15, fq = lane >> 4;
    const int K = g.K, nt = K / BK;
    unsigned voffA[2], voffB[2];
#pragma unroll
    for (int i = 0; i < 2; ++i) { int R, C; stage_rc(tid * 16 + i * 8192, R, C); const int Rb = Epi::PERM ? ((R & ~31) + perm32(R & 31)) : R;
        voffA[i] = (unsigned)(R * K + C) * 2u; voffB[i] = (unsigned)(Rb * K + C) * 2u; }
    const size_t kstep = (size_t)(BK * 2);
    const size_t hstep = (size_t)HALF * K * 2;
    const size_t tstep = 2 * hstep;
    const unsigned ldsw = (unsigned)wid * 1024u;
    const int aoff = lds_byte(wr * 64 + fr, fq * 8), boff = lds_byte(wc * 32 + fr, fq * 8);
#define PG8_SA(b, h) (((b) * 2 + (h)) * HTB)
#define PG8_SB(b, h) ((4 + (b) * 2 + (h)) * HTB)
#define PG8_STAGE(bufoff, gbase, voff) do { _Pragma("unroll") for (int _i = 0; _i < 2; ++_i) \
        __builtin_amdgcn_global_load_lds((const unsigned*)((const char*)(gbase) + (voff)[_i]), (PG8_LAS unsigned*)(lds + (bufoff) + ldsw + _i * 8192), 16, 0, 0); } while (0)
#define PG8_LDA(dst, b, h) do { _Pragma("unroll") for (int m = 0; m < 4; ++m) _Pragma("unroll") for (int k = 0; k < 2; ++k) dst[m][k] = *(const PG8_LAS bf16x8*)(lds + PG8_SA(b, h) + aoff + m * 2048 + k * 1024); } while (0)
#define PG8_LDB(dst, b, h) do { _Pragma("unroll") for (int n = 0; n < 2; ++n) _Pragma("unroll") for (int k = 0; k < 2; ++k) dst[n][k] = *(const PG8_LAS bf16x8*)(lds + PG8_SB(b, h) + boff + n * 2048 + k * 1024); } while (0)
#define PG8_MMA(ai, bj, At, Bt) do { __builtin_amdgcn_s_setprio(1); _Pragma("unroll") for (int m = 0; m < 4; ++m) _Pragma("unroll") for (int n = 0; n < 2; ++n) _Pragma("unroll") for (int k = 0; k < 2; ++k) \
        acc[ai][bj][m][n] = __builtin_amdgcn_mfma_f32_16x16x32_bf16(Bt[n][k], At[m][k], acc[ai][bj][m][n], 0, 0, 0); __builtin_amdgcn_s_setprio(0); } while (0)
#define PG8_WAIT_V(n) asm volatile("s_waitcnt vmcnt(" #n ")" ::: "memory")
#define PG8_WAIT_L(n) asm volatile("s_waitcnt lgkmcnt(" #n ")" ::: "memory")
#define PG8_BAR __builtin_amdgcn_s_barrier()
#define PG8_SCHED __builtin_amdgcn_sched_barrier(0)
    Unit cur, nxt; int ui = 0;
    if (!S.next(0, cur)) return;
    f32x4 acc[2][2][4][2];
#pragma unroll
    for (int a = 0; a < 2; ++a)
#pragma unroll
        for (int b = 0; b < 2; ++b)
#pragma unroll
            for (int m = 0; m < 4; ++m)
#pragma unroll
                for (int n = 0; n < 2; ++n) acc[a][b][m][n] = (f32x4){0.f, 0.f, 0.f, 0.f};
    bf16x8 At[4][2], B0[2][2], B1[2][2];
    const char* cA = (const char*)g.A + (size_t)cur.pm * tstep; const char* cB = (const char*)g.Bt + (size_t)cur.pn * tstep;
    S.a_ready(cur);
    if constexpr (SP2) {
        PG8_STAGE(PG8_SB(0, 0), cB, voffB); PG8_STAGE(PG8_SB(0, 1), cB + hstep, voffB); PG8_STAGE(PG8_SA(0, 0), cA, voffA); PG8_STAGE(PG8_SA(0, 1), cA + hstep, voffA);
        if (wr == 1) PG8_BAR;
        PG8_WAIT_V(2); PG8_BAR;
        PG8_STAGE(PG8_SB(1, 0), cB + kstep, voffB); PG8_STAGE(PG8_SA(1, 0), cA + kstep, voffA); PG8_STAGE(PG8_SB(1, 1), cB + hstep + kstep, voffB);
        PG8_WAIT_V(6); PG8_BAR;
    } else {
        PG8_STAGE(PG8_SB(0, 0), cB, voffB); PG8_STAGE(PG8_SA(0, 0), cA, voffA); PG8_STAGE(PG8_SB(0, 1), cB + hstep, voffB); PG8_STAGE(PG8_SA(0, 1), cA + hstep, voffA);
        if (wr == 1) PG8_BAR;
        PG8_WAIT_V(4); PG8_BAR;
        PG8_STAGE(PG8_SB(1, 0), cB + kstep, voffB); PG8_STAGE(PG8_SA(1, 0), cA + kstep, voffA); PG8_STAGE(PG8_SB(1, 1), cB + hstep + kstep, voffB);
        PG8_WAIT_V(6); PG8_BAR;
    }
    for (;;) {
        const bool has_next = S.next(ui + 1, nxt);
        const char* nA = has_next ? (const char*)g.A + (size_t)nxt.pm * tstep : cA; const char* nB = has_next ? (const char*)g.Bt + (size_t)nxt.pn * tstep : cB;
        for (int t = 0; t < nt; t += 2) {
            const bool last = (t == nt - 2);
            const char* a1 = cA + (size_t)(t + 1) * kstep;
            const char* a2 = last ? nA : cA + (size_t)(t + 2) * kstep; const char* b2 = last ? nB : cB + (size_t)(t + 2) * kstep;
            const char* a3 = a2 + kstep; const char* b3 = b2 + kstep;
            if (last && has_next) S.a_ready(nxt);
            if constexpr (SP2) {
            PG8_LDB(B0, 0, 0); PG8_LDB(B1, 0, 1); PG8_SCHED; PG8_LDA(At, 0, 0); PG8_STAGE(PG8_SA(1, 1), a1 + hstep, voffA);
            PG8_WAIT_V(8); PG8_WAIT_L(0); PG8_BAR; PG8_MMA(0, 0, At, B0); PG8_MMA(0, 1, At, B1); PG8_BAR; PG8_SCHED;
            PG8_LDA(At, 0, 1); PG8_STAGE(PG8_SB(0, 0), b2, voffB); PG8_STAGE(PG8_SB(0, 1), b2 + hstep, voffB); PG8_STAGE(PG8_SA(0, 0), a2, voffA);
            PG8_WAIT_V(8); PG8_WAIT_L(0); PG8_BAR; PG8_MMA(1, 0, At, B0); PG8_MMA(1, 1, At, B1); PG8_BAR; PG8_SCHED;
            PG8_LDB(B0, 1, 0); PG8_LDB(B1, 1, 1); PG8_SCHED; PG8_LDA(At, 1, 0); PG8_STAGE(PG8_SA(0, 1), a2 + hstep, voffA);
            PG8_WAIT_V(8); PG8_WAIT_L(0); PG8_BAR; PG8_MMA(0, 0, At, B0); PG8_MMA(0, 1, At, B1); PG8_BAR; PG8_SCHED;
            PG8_LDA(At, 1, 1); PG8_STAGE(PG8_SB(1, 0), b3, voffB); PG8_STAGE(PG8_SB(1, 1), b3 + hstep, voffB); PG8_STAGE(PG8_SA(1, 0), a3, voffA);
            PG8_WAIT_V(8); PG8_WAIT_L(0); PG8_BAR; PG8_MMA(1, 0, At, B0); PG8_MMA(1, 1, At, B1); PG8_BAR; PG8_SCHED;
            } else {
            PG8_LDB(B0, 0, 0); PG8_SCHED; PG8_LDA(At, 0, 0); PG8_STAGE(PG8_SA(1, 1), a1 + hstep, voffA);
            PG8_WAIT_L(8); PG8_BAR; PG8_WAIT_L(0); PG8_MMA(0, 0, At, B0); PG8_BAR; PG8_SCHED;
            PG8_LDB(B1, 0, 1); PG8_STAGE(PG8_SB(0, 0), b2, voffB);
            PG8_BAR; PG8_WAIT_L(0); PG8_MMA(0, 1, At, B1); PG8_BAR;
            PG8_LDA(At, 0, 1); PG8_STAGE(PG8_SA(0, 0), a2, voffA);
            PG8_BAR; PG8_WAIT_L(0); PG8_MMA(1, 0, At, B0); PG8_BAR; PG8_SCHED;
            PG8_STAGE(PG8_SB(0, 1), b2 + hstep, voffB);
            PG8_WAIT_V(6); PG8_BAR; PG8_MMA(1, 1, At, B1); PG8_BAR;
            PG8_LDB(B0, 1, 0); PG8_SCHED; PG8_LDA(At, 1, 0); PG8_STAGE(PG8_SA(0, 1), a2 + hstep, voffA);
            PG8_WAIT_L(8); PG8_BAR; PG8_WAIT_L(0); PG8_MMA(0, 0, At, B0); PG8_BAR; PG8_SCHED;
            PG8_LDB(B1, 1, 1); PG8_STAGE(PG8_SB(1, 0), b3, voffB);
            PG8_BAR; PG8_WAIT_L(0); PG8_MMA(0, 1, At, B1); PG8_BAR;
            PG8_LDA(At, 1, 1); PG8_STAGE(PG8_SA(1, 0), a3, voffA);
            PG8_BAR; PG8_WAIT_L(0); PG8_MMA(1, 0, At, B0); PG8_BAR; PG8_SCHED;
            PG8_STAGE(PG8_SB(1, 1), b3 + hstep, voffB);
            PG8_WAIT_V(6); PG8_BAR; PG8_MMA(1, 1, At, B1); PG8_BAR;
            }
        }
        if constexpr (ALIGN_EPI) { if (wr == 0) PG8_BAR; }
        if constexpr (!Epi::AFTER_DRAIN) { E(acc, cur, wr, wc, fr, fq); S.done(cur); }
        if (!has_next) break;
#pragma unroll
        for (int a = 0; a < 2; ++a)
#pragma unroll
            for (int b = 0; b < 2; ++b)
#pragma unroll
                for (int m = 0; m < 4; ++m)
#pragma unroll
                    for (int n = 0; n < 2; ++n) acc[a][b][m][n] = (f32x4){0.f, 0.f, 0.f, 0.f};
        cur = nxt; cA = nA; cB = nB; ++ui;
        if constexpr (ALIGN_EPI) { if (wr == 1) PG8_BAR; }
    }
    PG8_WAIT_V(0);
    if constexpr (!ALIGN_EPI) { if (wr == 0) PG8_BAR; }
    PG8_BAR;
    if constexpr (Epi::AFTER_DRAIN) { E.fused(acc, cur, wr, wc, fr, fq, lds, wid, lane); S.done(cur); }
#undef PG8_SA
#undef PG8_SB
#undef PG8_STAGE
#undef PG8_LDA
#undef PG8_LDB
#undef PG8_MMA
#undef PG8_WAIT_V
#undef PG8_WAIT_L
#undef PG8_BAR
#undef PG8_SCHED
}
}
#ifndef PG8_SP2
#define PG8_SP2 true
#endif
#ifndef PG8_ALIGN
#define PG8_ALIGN true
#endif
#ifndef MK_N_LAUNCHES
#define MK_N_LAUNCHES 1
#endif
#define DI __device__ __forceinline__
#define LAS __attribute__((address_space(3)))
typedef unsigned short bf16;
typedef unsigned v4u __attribute__((ext_vector_type(4)));
typedef unsigned v2u __attribute__((ext_vector_type(2)));
typedef float f32x4 __attribute__((ext_vector_type(4)));
typedef float f32x16 __attribute__((ext_vector_type(16)));
typedef short bf16x8 __attribute__((ext_vector_type(8)));
using pg8::Unit;

constexpr int D = 1024, MP = 8192, M = 16384, MCTX = 2048, MALL = 18432;
constexpr int FF = 2816, NGU = 5632, NINP = 3584, NMODS = 9216;
constexpr float EPS = 1e-6f, LOG2E = 1.4426950408889634f;
constexpr float A_QS = 0.125f * LOG2E;
constexpr float B_QS = 0.10206207261596575f * LOG2E;
constexpr size_t OUT_K = (size_t)M * D, OUT_V = OUT_K + 8192 * 128, OUT_CKV = OUT_V + 8192 * 128, OUT_KR = OUT_CKV + 8192 * 256;
constexpr size_t MiB = 1u << 20;
constexpr size_t OFF_MODS = 0, OFF_SSQQ = 196608, OFF_SSQKV = 262144, OFF_BAR = 327680, ZERO_BYTES = 344064, OFF_ROPEA = 393216, OFF_ROPEB = 401408;
constexpr size_t OFF_WGU1 = 1 * MiB, OFF_WGU2 = 12 * MiB, OFF_WD1 = 23 * MiB, OFF_WD2 = OFF_WD1 + 5767168, OFF_WIN = 34 * MiB, OFF_WOUT = 41 * MiB,
                 OFF_WOA = 43 * MiB, OFF_WOB = 44 * MiB, OFF_WUQ = 45 * MiB, OFF_WK = OFF_WUQ + 393216, OFF_WV = OFF_WK + 262144;
constexpr size_t OFF_H = 46 * MiB, OFF_OA = OFF_H, OFF_OB = OFF_H + 16 * MiB;
constexpr size_t OFF_ACT = 78 * MiB;
constexpr size_t OFF_QA = OFF_ACT, OFF_KA = OFF_QA + 16 * MiB, OFF_VAT = OFF_KA + (size_t)MALL * 128 * 2, OFF_QLAT = OFF_VAT + (size_t)MALL * 128 * 2,
                 OFF_CKV = OFF_QLAT + 8 * MiB, OFF_KROPE = OFF_CKV + 9 * MiB, OFF_QB = OFF_KROPE + (size_t)MALL * 32 * 2 + 131072, OFF_KN = OFF_QB + 24 * MiB;
constexpr size_t OFF_MM = OFF_ACT;
constexpr size_t OFF_GA = 166 * MiB, OFF_GB = 198 * MiB, OFF_VBT = 230 * MiB, WS_END = 248 * MiB;
static_assert(OFF_QLAT + 8 * MiB >= OFF_MM + 32 * MiB, "m overlay");
static_assert(OFF_KN + 18 * MiB <= OFF_GA && OFF_WV + 262144 <= OFF_H, "ws map");
constexpr int LDS_BYTES = 147456;

DI unsigned f2bf(float f) { unsigned u = __builtin_bit_cast(unsigned, f); return (u + 0x7fffu + ((u >> 16) & 1u)) >> 16; }
DI unsigned pk2(float lo, float hi) { return f2bf(lo) | (f2bf(hi) << 16); }
DI float bflo(unsigned w) { return __builtin_bit_cast(float, w << 16); }
DI float bfhi(unsigned w) { return __builtin_bit_cast(float, w & 0xffff0000u); }
DI float fexp2(float x) { return __builtin_amdgcn_exp2f(x); }
DI float frcp(float x) { return __builtin_amdgcn_rcpf(x); }
DI float sigm(float x) { return frcp(1.f + fexp2(-x * LOG2E)); }
#define LDS_WAIT() asm volatile("s_waitcnt lgkmcnt(0)" ::: "memory")
DI float wave_sum(float v) {
#pragma unroll
    for (int o = 1; o < 64; o <<= 1) v += __shfl_xor(v, o);
    return v;
}
DI int mod_index(int row) { return row < MP ? 0 : 1 + ((row - MP) >> 11); }

#define XB_TMO      128
#define XB_XCNT(j)  (256  + 64 * (j))
#define XB_XSUB(j)  (1280 + 64 * (j))
#define XB_XGEN(j)  (2304 + 64 * (j))
#define XB_TOP      3328
#define XB_TOPGEN   3392
#define XCD_BAR_WORDS 3456
#define XB_SPIN_CAP (1u << 18)

__device__ __forceinline__ unsigned xb_ld(unsigned* p)              { return __hip_atomic_load(p, __ATOMIC_RELAXED, __HIP_MEMORY_SCOPE_AGENT); }
__device__ __forceinline__ unsigned xb_add(unsigned* p, unsigned v) { return __hip_atomic_fetch_add(p, v, __ATOMIC_RELAXED, __HIP_MEMORY_SCOPE_AGENT); }
__device__ __forceinline__ unsigned xb_xcc_id() { return (unsigned)__builtin_amdgcn_s_getreg((3 << 11) | 20) & 0xFu; }
#define XB_SPIN(cond, bar) do { unsigned _sp = 0; while (cond) { __builtin_amdgcn_s_sleep(1); \
    if ((++_sp & 255u) == 0u) { if (xb_ld(&(bar)[XB_TMO])) break; if (_sp > XB_SPIN_CAP) { atomicAdd(&(bar)[XB_TMO], 1u); break; } } } } while (0)

struct XcdBarrier {
    unsigned* bar; unsigned x;
    volatile LAS unsigned* st;
};

__device__ __forceinline__ XcdBarrier xcd_barrier_post(unsigned* bar, volatile LAS unsigned* st) {
    XcdBarrier b; b.bar = bar; b.x = xb_xcc_id(); b.st = st;
    if (threadIdx.x == 0) (void)xb_add(&bar[XB_XCNT(b.x)], 1u);
    return b;
}
__device__ __forceinline__ void xcd_barrier_complete(unsigned* bar, unsigned x, unsigned& nloc, unsigned& nx) {
    const unsigned G = gridDim.x * gridDim.y * gridDim.z;
    unsigned sum, cnt, mine, sp = 0u;
    for (;;) {
        sum = 0u; cnt = 0u; mine = 0u;
#pragma unroll
        for (unsigned j = 0; j < 16; ++j) { const unsigned c = xb_ld(&bar[XB_XCNT(j)]); sum += c; cnt += (c > 0u) ? 1u : 0u; mine = (j == x) ? c : mine; }
        if (sum == G) break;
        __builtin_amdgcn_s_sleep(1);
        if ((++sp & 255u) == 0u) { if (xb_ld(&bar[XB_TMO])) break; if (sp > XB_SPIN_CAP) { atomicAdd(&bar[XB_TMO], 1u); break; } }
    }
    nloc = mine > 0u ? mine : 1u; nx = cnt > 0u ? cnt : 1u;
}

__device__ __forceinline__ void xcd_barrier(const XcdBarrier& b) {
    asm volatile("s_waitcnt vmcnt(0)" ::: "memory");
    __syncthreads();
    if (threadIdx.x == 0) {
        unsigned* bar = b.bar;
        __builtin_amdgcn_s_waitcnt(0);
        unsigned nloc = b.st[0], nx = b.st[1];
        if (nloc == 0u) { xcd_barrier_complete(bar, b.x, nloc, nx); b.st[0] = nloc; b.st[1] = nx; }
        const unsigned old = xb_add(&bar[XB_XSUB(b.x)], 1u);
        const unsigned gen = old / nloc;
        if (old + 1u == (gen + 1u) * nloc) {
            __builtin_amdgcn_fence(__ATOMIC_RELEASE, "agent");
            asm volatile("s_waitcnt vmcnt(0)" ::: "memory");
            const unsigned og = xb_add(&bar[XB_TOP], 1u);
            const unsigned tg = og / nx;
            if (og + 1u == (tg + 1u) * nx) xb_add(&bar[XB_TOPGEN], 1u);
            else XB_SPIN(xb_ld(&bar[XB_TOPGEN]) == tg, bar);
            __builtin_amdgcn_fence(__ATOMIC_ACQUIRE, "agent");
            xb_add(&bar[XB_XGEN(b.x)], 1u);
            asm volatile("s_waitcnt vmcnt(0)" ::: "memory");
        } else {
            XB_SPIN(xb_ld(&bar[XB_XGEN(b.x)]) == gen, bar);
            __builtin_amdgcn_fence(__ATOMIC_ACQUIRE, "agent");
            asm volatile("s_waitcnt vmcnt(0)" ::: "memory");
        }
    }
    __syncthreads();
}


DI void transpose_item(const float* W, int N, bf16* WT, int K, int k0, int src_n0, int dst_r0, const float* kscale, float sscale, LAS float* scr, int lane) {
    if (src_n0 >= 0) {
#pragma unroll 8
        for (int i = 0; i < 32; ++i) { const int kk = 2 * i + (lane >> 5); float v = W[(size_t)(k0 + kk) * N + src_n0 + (lane & 31)]; if (kscale) v *= kscale[k0 + kk]; scr[kk * 33 + (lane & 31)] = v * sscale; }
    } else {
#pragma unroll 8
        for (int i = 0; i < 32; ++i) { const int kk = 2 * i + (lane >> 5); scr[kk * 33 + (lane & 31)] = 0.f; }
    }
    LDS_WAIT(); asm volatile("" ::: "memory");
    const int c = lane & 7;
#pragma unroll
    for (int j = 0; j < 4; ++j) { const int n = (lane >> 3) + 8 * j; const LAS float* s = scr + (8 * c) * 33 + n;
        v4u o; o.x = pk2(s[0 * 33], s[1 * 33]); o.y = pk2(s[2 * 33], s[3 * 33]); o.z = pk2(s[4 * 33], s[5 * 33]); o.w = pk2(s[6 * 33], s[7 * 33]);
        *(v4u*)(WT + (size_t)(dst_r0 + n) * K + k0 + 8 * c) = o; }
    LDS_WAIT(); asm volatile("" ::: "memory");
}

struct Args { const float* in[27]; float* out; unsigned char* ws; int ph_lo, ph_hi; };

DI void p0_weights(const Args& a, LAS unsigned char* lds, int gw, int NGW, int wave, int lane) {
    LAS float* scr = (LAS float*)(lds + wave * 16384);
    unsigned char* ws = a.ws;
    constexpr int I_GU = 16 * 176, I_D = 44 * 32, I_IN = 16 * 112, I_OUT = 16 * 32, I_O = 8 * 32, I_UQ = 4 * 24, I_K = 4 * 16;
    constexpr int NIT = 2 * I_GU + 2 * I_D + I_IN + I_OUT + 2 * I_O + I_UQ + 2 * I_K;
    for (int it = gw; it < NIT; it += NGW) {
        int r = it;
        if (r < 2 * I_GU) { const int w = r >= I_GU; r -= w * I_GU; const int kb = r / 176, nb = r % 176, R0 = 32 * nb;
            const int pn = R0 >> 8, half = (R0 >> 7) & 1, j = R0 & 127;
            transpose_item(a.in[w ? 24 : 11], NGU, (bf16*)(ws + (w ? OFF_WGU2 : OFF_WGU1)), 1024, 64 * kb, half * FF + 128 * pn + j, R0, nullptr, 1.f, scr, lane); continue; }
        r -= 2 * I_GU;
        if (r < 2 * I_D) { const int w = r >= I_D; r -= w * I_D; const int kb = r / 32, nb = r % 32;
            transpose_item(a.in[w ? 25 : 12], 1024, (bf16*)(ws + (w ? OFF_WD2 : OFF_WD1)), FF, 64 * kb, 32 * nb, 32 * nb, nullptr, 1.f, scr, lane); continue; }
        r -= 2 * I_D;
        if (r < I_IN) { const int kb = r / 112, nb = r % 112, R0 = 32 * nb;
            const int src = R0 < 1280 ? R0 : (R0 < 3328 ? R0 + 32 : (R0 == 3328 ? 1280 : -1));
            transpose_item(a.in[14], 3360, (bf16*)(ws + OFF_WIN), 1024, 64 * kb, src, R0, nullptr, 1.f, scr, lane); continue; }
        r -= I_IN;
        if (r < I_OUT) { const int kb = r / 32, nb = r % 32; transpose_item(a.in[22], 1024, (bf16*)(ws + OFF_WOUT), 1024, 64 * kb, 32 * nb, 32 * nb, nullptr, 1.f, scr, lane); continue; }
        r -= I_OUT;
        if (r < 2 * I_O) { const int w = r >= I_O; r -= w * I_O; const int kb = r / 32, nb = r % 32;
            transpose_item(a.in[w ? 21 : 20], 1024, (bf16*)(ws + (w ? OFF_WOB : OFF_WOA)), 512, 64 * kb, 32 * nb, 32 * nb, nullptr, 1.f, scr, lane); continue; }
        r -= 2 * I_O;
        if (r < I_UQ) { const int kb = r / 24, nb = r % 24, R0 = 32 * nb;
            const int src = R0 < 512 ? (R0 >> 6) * 96 + (R0 & 63) : ((R0 - 512) >> 5) * 96 + 64;
            transpose_item(a.in[18], 768, (bf16*)(ws + OFF_WUQ), 256, 64 * kb, src, R0, a.in[16], B_QS, scr, lane); continue; }
        r -= I_UQ;
        { const int w = r >= I_K; r -= w * I_K; const int kb = r / 16, nb = r % 16, R0 = 32 * nb;
            const int src = (R0 >> 6) * 128 + (R0 & 63) + (w ? 64 : 0);
            transpose_item(a.in[19], 1024, (bf16*)(ws + (w ? OFF_WV : OFF_WK)), 256, 64 * kb, src, R0, a.in[17], 1.f, scr, lane); }
    }
}
DI void p0_ada(const Args& a, LAS unsigned char* lds, int tid) {
    LAS float* sc = (LAS float*)lds;
    LAS float* red = (LAS float*)(lds + 4096);
    float* mods = (float*)(a.ws + OFF_MODS);
    const float* adaw = a.in[8];
    for (int it = blockIdx.x; it < 256; it += gridDim.x) {
        const int cgp = it & 31, ks = it >> 5;
        __syncthreads();
        for (int i = tid; i < 640; i += 512) { const int v = i >> 7, k = ks * 128 + (i & 127); const float c = v == 0 ? a.in[7][k] : a.in[6][(v - 1) * 1024 + k]; sc[i] = c * sigm(c); }
        __syncthreads();
        const int colq = tid % 72, kl = tid / 72;
        if (kl < 7) {
            f32x4 acc[5];
#pragma unroll
            for (int v = 0; v < 5; ++v) acc[v] = (f32x4){0.f, 0.f, 0.f, 0.f};
            for (int k = kl; k < 128; k += 7) { const f32x4 w = *(const f32x4*)(adaw + (size_t)(ks * 128 + k) * NMODS + cgp * 288 + colq * 4);
#pragma unroll
                for (int v = 0; v < 5; ++v) acc[v] += w * sc[v * 128 + k]; }
#pragma unroll
            for (int v = 0; v < 5; ++v) *(LAS f32x4*)(red + (kl * 5 + v) * 288 + colq * 4) = acc[v];
        }
        __syncthreads();
        for (int i = tid; i < 1440; i += 512) { const int v = i / 288, cc = i % 288; float s = 0.f;
#pragma unroll
            for (int q = 0; q < 7; ++q) s += red[(q * 5 + v) * 288 + cc];
            const int col = cgp * 288 + cc; if (ks == 0) s += a.in[9][col];
            atomicAdd(mods + v * NMODS + col, s); }
    }
    __syncthreads();
}
DI void ctx_convert(const Args& a, int gtid, int NT) {
    unsigned char* ws = a.ws;
    bf16* ka = (bf16*)(ws + OFF_KA) + (size_t)M * 128; bf16* vaT = (bf16*)(ws + OFF_VAT); bf16* ckv = (bf16*)(ws + OFF_CKV) + (size_t)M * 256; bf16* kr = (bf16*)(ws + OFF_KROPE) + (size_t)M * 32;
    for (int i = gtid; i < MCTX * 128; i += NT) ka[i] = (bf16)f2bf(a.in[2][i]);
    for (int i = gtid; i < MCTX * 128; i += NT) { const int f = i >> 11, tk = i & 2047; vaT[(size_t)f * MALL + M + tk] = (bf16)f2bf(a.in[3][tk * 128 + f]); }
    for (int i = gtid; i < MCTX * 256; i += NT) ckv[i] = (bf16)f2bf(a.in[4][i] / a.in[17][i & 255]);
    for (int i = gtid; i < MCTX * 32; i += NT) kr[i] = (bf16)f2bf(a.in[5][i]);
}
DI void p0_misc(const Args& a, int gtid, int NT) {
    unsigned char* ws = a.ws;
    float2* ra = (float2*)(ws + OFF_ROPEA); float2* rb = (float2*)(ws + OFF_ROPEB);
    for (int i = gtid; i < 1024; i += NT) { const int pos = i >> 4, fi = i & 15; const float inv = 1.0f / powf(10000.f, (float)(2 * fi) / 32.f); const float ang = (float)pos * inv; ra[i] = make_float2(cosf(ang), sinf(ang)); }
    for (int i = gtid; i < 512; i += NT) { const int pos = i >> 3, fi = i & 7; const float inv = 1.0f / powf(10000.f, (float)(2 * fi) / 16.f); const float ang = (float)pos * inv; rb[i] = make_float2(cosf(ang), sinf(ang)); }
}

DI void norm_mod_phase(const float* xa, const float* xb, const float* gain, const float* mods, int s, bf16* h, int gw, int NGW, int lane) {
    for (int row = gw; row < M; row += NGW) {
        const float* xr = row < MP ? xa + (size_t)row * D : xb + (size_t)(row - MP) * D;
        f32x4 v[4]; float ss = 0.f;
#pragma unroll
        for (int j = 0; j < 4; ++j) { v[j] = *(const f32x4*)(xr + 4 * (64 * j + lane)); ss += (v[j].x * v[j].x + v[j].y * v[j].y) + (v[j].z * v[j].z + v[j].w * v[j].w); }
        const float rstd = 1.0f / sqrtf(wave_sum(ss) * (1.f / D) + EPS);
        const float* sh = mods + mod_index(row) * NMODS + (3 * s) * D; const float* sc = sh + D;
#pragma unroll
        for (int j = 0; j < 4; ++j) { const int c = 4 * (64 * j + lane); const f32x4 g = *(const f32x4*)(gain + c), s4 = *(const f32x4*)(sh + c), c4 = *(const f32x4*)(sc + c);
            const f32x4 o = (v[j] * rstd * g) * (c4 + 1.0f) + s4; v2u w; w.x = pk2(o.x, o.y); w.y = pk2(o.z, o.w); *(v2u*)(h + (size_t)row * D + c) = w; }
    }
}
DI void final_norm_phase(float* x, const float* gain, int gw, int NGW, int lane) {
    for (int row = gw; row < M; row += NGW) {
        float* xr = x + (size_t)row * D; f32x4 v[4]; float ss = 0.f;
#pragma unroll
        for (int j = 0; j < 4; ++j) { v[j] = *(const f32x4*)(xr + 4 * (64 * j + lane)); ss += (v[j].x * v[j].x + v[j].y * v[j].y) + (v[j].z * v[j].z + v[j].w * v[j].w); }
        const float rstd = 1.0f / sqrtf(wave_sum(ss) * (1.f / D) + EPS);
#pragma unroll
        for (int j = 0; j < 4; ++j) { const int c = 4 * (64 * j + lane); *(f32x4*)(xr + c) = v[j] * rstd * *(const f32x4*)(gain + c); }
    }
}
#define EPI_ARGS const f32x4 (&acc)[2][2][4][2], const Unit& u, int wr, int wc, int fr, int fq
DI v4u pack8(const f32x4& a, const f32x4& b) { v4u w; w.x = pk2(a.x, a.y); w.y = pk2(a.z, a.w); w.z = pk2(b.x, b.y); w.w = pk2(b.z, b.w); return w; }
DI void unpack8(const v4u& w, f32x4& a, f32x4& b) { a = (f32x4){bflo(w.x), bfhi(w.x), bflo(w.y), bfhi(w.y)}; b = (f32x4){bflo(w.z), bfhi(w.z), bflo(w.w), bfhi(w.w)}; }
DI f32x4 shx4(const f32x4& v, int m) { return (f32x4){__shfl_xor(v.x, m), __shfl_xor(v.y, m), __shfl_xor(v.z, m), __shfl_xor(v.w, m)}; }
DI void rope8(f32x4& v0, f32x4& v1, const float2* cs, int xm, float sgn) {
    const f32x4 p0 = shx4(v0, xm), p1 = shx4(v1, xm);
    const f32x4 t0 = *(const f32x4*)(cs), t1 = *(const f32x4*)(cs + 2), t2 = *(const f32x4*)(cs + 4), t3 = *(const f32x4*)(cs + 6);
    v0 = (f32x4){v0.x * t0.x + sgn * p0.x * t0.y, v0.y * t0.z + sgn * p0.y * t0.w, v0.z * t1.x + sgn * p0.z * t1.y, v0.w * t1.z + sgn * p0.w * t1.w};
    v1 = (f32x4){v1.x * t2.x + sgn * p1.x * t2.y, v1.y * t2.z + sgn * p1.y * t2.w, v1.z * t3.x + sgn * p1.z * t3.y, v1.w * t3.z + sgn * p1.w * t3.w};
}

struct EpiSwiglu { static constexpr bool PERM = true, AFTER_DRAIN = false; bf16* O;
    DI void operator()(EPI_ARGS) const {
        asm volatile("" : "+v"(fr), "+v"(fq));
        const int row0 = u.pm * 256 + wr * 64 + fr, col0 = u.pn * 128 + wc * 32 + 8 * fq;
#pragma unroll
        for (int ai = 0; ai < 2; ++ai)
#pragma unroll
            for (int m = 0; m < 4; ++m) { f32x4 o[2];
#pragma unroll
                for (int n = 0; n < 2; ++n) { const f32x4 g = acc[ai][0][m][n], uu = acc[ai][1][m][n];
#pragma unroll
                    for (int j = 0; j < 4; ++j) o[n][j] = g[j] * sigm(g[j]) * uu[j]; }
                *(v4u*)(O + (size_t)(row0 + ai * 128 + m * 16) * FF + col0) = pack8(o[0], o[1]); }
    }
};
struct EpiResid { static constexpr bool PERM = false, AFTER_DRAIN = false; const float* inA; const float* inB; float* out; const float* mods; int gslot; float coef;
    DI void operator()(EPI_ARGS) const {
        asm volatile("" : "+v"(fr), "+v"(fq));
        const int row0 = u.pm * 256 + wr * 64 + fr, col0 = u.pn * 256 + wc * 32 + 4 * fq;
        const float* gate = mods + mod_index(u.pm * 256) * NMODS + gslot * D;
        f32x4 gv[2][2];
#pragma unroll
        for (int bj = 0; bj < 2; ++bj)
#pragma unroll
            for (int n = 0; n < 2; ++n) gv[bj][n] = *(const f32x4*)(gate + col0 + bj * 128 + n * 16) * coef;
#pragma unroll
        for (int ai = 0; ai < 2; ++ai)
#pragma unroll
            for (int m = 0; m < 4; ++m) { const int row = row0 + ai * 128 + m * 16;
                const float* ip = row < MP ? inA + (size_t)row * D : inB + (size_t)(row - MP) * D; float* op = out + (size_t)row * D;
#pragma unroll
                for (int bj = 0; bj < 2; ++bj)
#pragma unroll
                    for (int n = 0; n < 2; ++n) { const int c = col0 + bj * 128 + n * 16; *(f32x4*)(op + c) = *(const f32x4*)(ip + c) + gv[bj][n] * acc[ai][bj][m][n]; } }
    }
};
struct EpiWin { static constexpr bool PERM = true, AFTER_DRAIN = false;
    bf16 *qa, *ka, *vaT, *qlat, *ckv, *ga, *gb, *krope; float *ssq_q, *ssq_kv; float* out; const float2* ropeA; const float2* ropeB;
    DI void operator()(EPI_ARGS) const {
        asm volatile("" : "+v"(fr), "+v"(fq));
        const int pn = u.pn; const bool sample = u.pm >= 32;
        const int rbase = u.pm * 256 + wr * 64 + fr;
        if (pn < 3) {
#pragma unroll
            for (int ai = 0; ai < 2; ++ai)
#pragma unroll
                for (int m = 0; m < 4; ++m) { const int row = rbase + ai * 128 + m * 16; const int t = (row - MP) & 2047; const int pos = (wc & 1) ? (t & 63) : (t >> 6);
                    const float2* cs = ropeA + pos * 16 + 8 * (fq & 1); const float sgn = (fq & 2) ? 1.f : -1.f;
#pragma unroll
                    for (int bj = 0; bj < 2; ++bj) { f32x4 v0 = acc[ai][bj][m][0], v1 = acc[ai][bj][m][1]; const int cl = bj * 128 + wc * 32 + 8 * fq;
                        if (pn < 2) { if (sample) rope8(v0, v1, cs, 32, sgn); v0 = v0 * A_QS; v1 = v1 * A_QS; *(v4u*)(qa + (size_t)row * 512 + pn * 256 + cl) = pack8(v0, v1); }
                        else if (bj == 0) { if (sample) rope8(v0, v1, cs, 32, sgn); *(v4u*)(ka + (size_t)row * 128 + cl) = pack8(v0, v1);
                            if (!sample) { float* o = out + OUT_K + (size_t)row * 128 + cl; *(f32x4*)o = v0; *(f32x4*)(o + 4) = v1; } }
                        else { const int c = cl - 128;
#pragma unroll
                            for (int j = 0; j < 4; ++j) { vaT[(size_t)(c + j) * MALL + row] = (bf16)f2bf(v0[j]); vaT[(size_t)(c + 4 + j) * MALL + row] = (bf16)f2bf(v1[j]); }
                            if (!sample) { float* o = out + OUT_V + (size_t)row * 128 + c; *(f32x4*)o = v0; *(f32x4*)(o + 4) = v1; } } } }
        } else if (pn < 5) {
            bf16* dst = pn == 3 ? qlat : ckv; float* ssq = pn == 3 ? ssq_q : ssq_kv;
#pragma unroll
            for (int ai = 0; ai < 2; ++ai)
#pragma unroll
                for (int m = 0; m < 4; ++m) { const int row = rbase + ai * 128 + m * 16; float s = 0.f;
#pragma unroll
                    for (int bj = 0; bj < 2; ++bj) { const f32x4 v0 = acc[ai][bj][m][0], v1 = acc[ai][bj][m][1];
                        s += (v0.x * v0.x + v0.y * v0.y) + (v0.z * v0.z + v0.w * v0.w) + (v1.x * v1.x + v1.y * v1.y) + (v1.z * v1.z + v1.w * v1.w);
                        *(v4u*)(dst + (size_t)row * 256 + bj * 128 + wc * 32 + 8 * fq) = pack8(v0, v1); }
                    s += __shfl_xor(s, 16); s += __shfl_xor(s, 32);
                    if (fq == 0) atomicAdd(ssq + row, s); }
        } else if (pn < 13) {
            bf16* dst = pn < 9 ? ga : gb; const int ct = ((pn - 5) & 3) * 256;
#pragma unroll
            for (int ai = 0; ai < 2; ++ai)
#pragma unroll
                for (int m = 0; m < 4; ++m) { const int row = rbase + ai * 128 + m * 16;
#pragma unroll
                    for (int bj = 0; bj < 2; ++bj) { f32x4 v0 = acc[ai][bj][m][0], v1 = acc[ai][bj][m][1];
#pragma unroll
                        for (int j = 0; j < 4; ++j) { v0[j] = sigm(v0[j]); v1[j] = sigm(v1[j]); }
                        *(v4u*)(dst + (size_t)row * D + ct + bj * 128 + wc * 32 + 8 * fq) = pack8(v0, v1); } }
        } else if (wc == 0) {
#pragma unroll
            for (int ai = 0; ai < 2; ++ai)
#pragma unroll
                for (int m = 0; m < 4; ++m) { const int row = rbase + ai * 128 + m * 16; const int t = (row - MP) & 2047; const int pos = (fq & 2) ? (t & 63) : (t >> 6);
                    f32x4 v0 = acc[ai][0][m][0], v1 = acc[ai][0][m][1];
                    if (sample) rope8(v0, v1, ropeB + pos * 8, 16, (fq & 1) ? 1.f : -1.f);
                    *(v4u*)(krope + (size_t)row * 32 + 8 * fq) = pack8(v0, v1);
                    if (!sample) { float* o = out + OUT_KR + (size_t)row * 32 + 8 * fq; *(f32x4*)o = v0; *(f32x4*)(o + 4) = v1; } }
        }
    }
};
struct EpiQB { static constexpr bool PERM = true, AFTER_DRAIN = false; bf16* qb; const float* ssq; const float2* ropeB;
    DI void operator()(EPI_ARGS) const {
        asm volatile("" : "+v"(fr), "+v"(fq));
        const int rbase = u.pm * 256 + wr * 64 + fr; const bool sample = u.pm >= 32;
#pragma unroll
        for (int ai = 0; ai < 2; ++ai)
#pragma unroll
            for (int m = 0; m < 4; ++m) { const int row = rbase + ai * 128 + m * 16; const float rs = 1.0f / sqrtf(ssq[row] * (1.f / 256.f) + EPS);
                const int t = (row - MP) & 2047; const int pos = (fq & 2) ? (t & 63) : (t >> 6);
#pragma unroll
                for (int bj = 0; bj < 2; ++bj) { f32x4 v0 = acc[ai][bj][m][0] * rs, v1 = acc[ai][bj][m][1] * rs;
                    if (u.pn == 2 && sample) rope8(v0, v1, ropeB + pos * 8, 16, (fq & 1) ? 1.f : -1.f);
                    *(v4u*)(qb + (size_t)row * 768 + u.pn * 256 + bj * 128 + wc * 32 + 8 * fq) = pack8(v0, v1); } }
    }
};
struct EpiKN { static constexpr bool PERM = true, AFTER_DRAIN = false; bf16* kn; const float* ssq;
    DI void operator()(EPI_ARGS) const {
        asm volatile("" : "+v"(fr), "+v"(fq));
        const int rbase = u.pm * 256 + wr * 64 + fr; const bool lat = u.pm < 64;
#pragma unroll
        for (int ai = 0; ai < 2; ++ai)
#pragma unroll
            for (int m = 0; m < 4; ++m) { const int row = rbase + ai * 128 + m * 16; const float rs = lat ? 1.0f / sqrtf(ssq[row] * (1.f / 256.f) + EPS) : 1.0f;
#pragma unroll
                for (int bj = 0; bj < 2; ++bj) *(v4u*)(kn + (size_t)row * 512 + u.pn * 256 + bj * 128 + wc * 32 + 8 * fq) = pack8(acc[ai][bj][m][0] * rs, acc[ai][bj][m][1] * rs); }
    }
};
struct EpiVT { static constexpr bool PERM = true, AFTER_DRAIN = false; bf16* vt; const float* ssq;
    DI void operator()(EPI_ARGS) const {
        asm volatile("" : "+v"(fr), "+v"(fq));
        const int rbase = u.pm * 256 + wr * 64 + fr; const bool lat = u.pn < 64;
        f32x4 rs[2][2];
#pragma unroll
        for (int bj = 0; bj < 2; ++bj)
#pragma unroll
            for (int n = 0; n < 2; ++n) { const int c = u.pn * 256 + bj * 128 + wc * 32 + 8 * fq + 4 * n;
                if (lat) { const f32x4 q = *(const f32x4*)(ssq + c); rs[bj][n] = (f32x4){1.0f / sqrtf(q.x * (1.f / 256.f) + EPS), 1.0f / sqrtf(q.y * (1.f / 256.f) + EPS), 1.0f / sqrtf(q.z * (1.f / 256.f) + EPS), 1.0f / sqrtf(q.w * (1.f / 256.f) + EPS)}; }
                else rs[bj][n] = (f32x4){1.f, 1.f, 1.f, 1.f}; }
#pragma unroll
        for (int ai = 0; ai < 2; ++ai)
#pragma unroll
            for (int m = 0; m < 4; ++m) { const int row = rbase + ai * 128 + m * 16;
#pragma unroll
                for (int bj = 0; bj < 2; ++bj) *(v4u*)(vt + (size_t)row * MALL + u.pn * 256 + bj * 128 + wc * 32 + 8 * fq) = pack8(acc[ai][bj][m][0] * rs[bj][0], acc[ai][bj][m][1] * rs[bj][1]); }
    }
};
template <bool SECOND> struct EpiMerge { static constexpr bool PERM = true, AFTER_DRAIN = false; bf16* mm; const bf16* g;
    DI void operator()(EPI_ARGS) const {
        asm volatile("" : "+v"(fr), "+v"(fq));
        const int rbase = u.pm * 256 + wr * 64 + fr;
#pragma unroll
        for (int ai = 0; ai < 2; ++ai)
#pragma unroll
            for (int m = 0; m < 4; ++m) { const int row = rbase + ai * 128 + m * 16;
#pragma unroll
                for (int bj = 0; bj < 2; ++bj) { const size_t o = (size_t)row * D + u.pn * 256 + bj * 128 + wc * 32 + 8 * fq;
                    f32x4 g0, g1; unpack8(*(const v4u*)(g + o), g0, g1); f32x4 v0 = acc[ai][bj][m][0] * g0, v1 = acc[ai][bj][m][1] * g1;
                    if (SECOND) { f32x4 p0, p1; unpack8(*(const v4u*)(mm + o), p0, p1); v0 += p0; v1 += p1; }
                    *(v4u*)(mm + o) = pack8(v0, v1); } }
    }
};
#define MFMA32(a, b, c) __builtin_amdgcn_mfma_f32_32x32x16_bf16((a), (b), (c), 0, 0, 0)
template <int DQ>
DI void attn_unit(LAS unsigned char* lds, int tid, int lane,
                  const bf16* qn, int ldqn, const bf16* qr, int ldqr,
                  const bf16* Kb, int ldk, const bf16* Kr, const bf16* Vt,
                  int s0_tok, int s0_n, int s1_tok, int s1_n, bool band, int qtok,
                  float m_init, float l_init, bf16* outp, int ldo) {
    constexpr int KS = DQ * 2 + 16, VS = 144, BUF = 64 * KS + 64 * VS, NKS = DQ / 16;
    const int r = lane & 31, hh = lane >> 5;
    const int pr = (r & ~12) | ((r & 4) << 1) | ((r & 8) >> 1);
    bf16x8 qf[NKS];
#pragma unroll
    for (int ks = 0; ks < NKS; ++ks) qf[ks] = ks < 4 ? *(const bf16x8*)(qn + (size_t)r * ldqn + 16 * ks + 8 * hh) : *(const bf16x8*)(qr + (size_t)r * ldqr + 16 * (ks - 4) + 8 * hh);
    f32x16 ot[2];
#pragma unroll
    for (int i = 0; i < 16; ++i) { ot[0][i] = 0.f; ot[1][i] = 0.f; }
    float mrun = m_init, lrun = l_init;
    const int ntile = s0_n + s1_n;
    const int krow = tid >> 3, kch = tid & 7, rrow = tid >> 2, rch = tid & 3;
    v4u kreg, rreg, vreg;
    auto tile_tok = [&](int t) { return t < s0_n ? s0_tok + 64 * t : s1_tok + 64 * (t - s0_n); };
    auto gload = [&](int t) { const int tok0 = tile_tok(t);
        kreg = *(const v4u*)(Kb + (size_t)(tok0 + krow) * ldk + kch * 8);
        if (DQ == 96) { if (tid < 256) rreg = *(const v4u*)(Kr + (size_t)(tok0 + rrow) * 32 + rch * 8); }
        vreg = *(const v4u*)(Vt + (size_t)krow * MALL + tok0 + kch * 8); };
    auto lstore = [&](int b) { LAS unsigned char* kb_ = lds + b * BUF;
        *(LAS v4u*)(kb_ + krow * KS + kch * 16) = kreg;
        if (DQ == 96) { if (tid < 256) *(LAS v4u*)(kb_ + rrow * KS + 128 + rch * 16) = rreg; }
        *(LAS v4u*)(kb_ + 64 * KS + krow * VS + kch * 16) = vreg; };
    gload(0); lstore(0); __syncthreads();
    for (int t = 0; t < ntile; ++t) {
        const bool more = t + 1 < ntile;
        if (more) gload(t + 1);
        LAS unsigned char* kb_ = lds + (t & 1) * BUF; LAS unsigned char* vb_ = kb_ + 64 * KS;
        f32x16 st[2];
#pragma unroll
        for (int kb = 0; kb < 2; ++kb) {
#pragma unroll
            for (int i = 0; i < 16; ++i) st[kb][i] = 0.f;
#pragma unroll
            for (int ks = 0; ks < NKS; ++ks) { const bf16x8 kf = *(const LAS bf16x8*)(kb_ + (32 * kb + pr) * KS + (16 * ks + 8 * hh) * 2); st[kb] = MFMA32(kf, qf[ks], st[kb]); }
        }
        if (band && t < s0_n) { const int d0 = tile_tok(t) + 8 * hh - (qtok + r);
#pragma unroll
            for (int kb = 0; kb < 2; ++kb)
#pragma unroll
                for (int i = 0; i < 16; ++i) { const int d = d0 + 32 * kb + 16 * (i >> 3) + (i & 7); if (d > 128 || d < -128) st[kb][i] = -1e30f; } }
        float mx = st[0][0];
#pragma unroll
        for (int kb = 0; kb < 2; ++kb)
#pragma unroll
            for (int i = 0; i < 16; ++i) mx = fmaxf(mx, st[kb][i]);
        mx = fmaxf(mx, __shfl_xor(mx, 32));
        const float mnew = fmaxf(mrun, mx), alpha = fexp2(mrun - mnew); mrun = mnew;
        float ps = 0.f;
#pragma unroll
        for (int kb = 0; kb < 2; ++kb)
#pragma unroll
            for (int i = 0; i < 16; ++i) { const float p = fexp2(st[kb][i] - mnew); st[kb][i] = p; ps += p; }
        lrun = lrun * alpha + ps;
#pragma unroll
        for (int i = 0; i < 16; ++i) { ot[0][i] *= alpha; ot[1][i] *= alpha; }
#pragma unroll
        for (int kb = 0; kb < 2; ++kb)
#pragma unroll
            for (int s = 0; s < 2; ++s) { v4u pw; pw.x = pk2(st[kb][8 * s], st[kb][8 * s + 1]); pw.y = pk2(st[kb][8 * s + 2], st[kb][8 * s + 3]); pw.z = pk2(st[kb][8 * s + 4], st[kb][8 * s + 5]); pw.w = pk2(st[kb][8 * s + 6], st[kb][8 * s + 7]);
                const bf16x8 pf = __builtin_bit_cast(bf16x8, pw);
#pragma unroll
                for (int db = 0; db < 2; ++db) { const bf16x8 vf = *(const LAS bf16x8*)(vb_ + (32 * db + r) * VS + (32 * kb + 16 * s + 8 * hh) * 2); ot[db] = MFMA32(vf, pf, ot[db]); } }
        if (more) lstore((t + 1) & 1);
        __syncthreads();
    }
    const float inv = 1.0f / (lrun + __shfl_xor(lrun, 32));
#pragma unroll
    for (int db = 0; db < 2; ++db)
#pragma unroll
        for (int a4 = 0; a4 < 4; ++a4) { v2u w; w.x = pk2(ot[db][4 * a4] * inv, ot[db][4 * a4 + 1] * inv); w.y = pk2(ot[db][4 * a4 + 2] * inv, ot[db][4 * a4 + 3] * inv);
            *(v2u*)(outp + (size_t)r * ldo + 32 * db + 8 * a4 + 4 * hh) = w; }
}

DI void attn_phase(const Args& a, LAS unsigned char* lds, int tid, int wave, int lane) {
    unsigned char* ws = a.ws;
    const bf16* qa = (const bf16*)(ws + OFF_QA); const bf16* ka = (const bf16*)(ws + OFF_KA); const bf16* vaT = (const bf16*)(ws + OFF_VAT);
    const bf16* qb = (const bf16*)(ws + OFF_QB); const bf16* kn = (const bf16*)(ws + OFF_KN); const bf16* kr = (const bf16*)(ws + OFF_KROPE); const bf16* vbT = (const bf16*)(ws + OFF_VBT);
    bf16* oa = (bf16*)(ws + OFF_OA); bf16* ob = (bf16*)(ws + OFF_OB);
    const float* sink = a.in[15];
    for (int uu = blockIdx.x; uu < 1024; uu += gridDim.x) {
        const int type = uu >> 8, u0 = uu & 255, vu = (u0 & 7) * 32 + (u0 >> 3);
        if (type == 0) {
            const int b = vu >> 6, h = (vu >> 3) & 7, qblk = vu & 7; const int tok = MP + b * 2048 + qblk * 256 + 32 * wave;
            attn_unit<96>(lds, tid, lane, qb + (size_t)tok * 768 + h * 64, 768, qb + (size_t)tok * 768 + 512 + h * 32, 768, kn + h * 64, 512, kr, vbT + (size_t)(h * 64) * MALL,
                          M + b * 512, 8, MP + b * 2048, 32, false, 0, -1e30f, 0.f, ob + (size_t)tok * 512 + h * 64, 512);
        } else if (type == 1) {
            const int b = vu >> 6, kh = (vu >> 5) & 1, qblk = vu & 31; const int head = kh * 4 + (wave >> 1); const int tok = MP + b * 2048 + qblk * 64 + 32 * (wave & 1);
            const int lo = qblk - 2 < 0 ? 0 : qblk - 2, hi = qblk + 2 > 31 ? 31 : qblk + 2;
            attn_unit<64>(lds, tid, lane, qa + (size_t)tok * 512 + head * 64, 512, nullptr, 0, ka + kh * 64, 128, nullptr, vaT + (size_t)(kh * 64) * MALL,
                          MP + b * 2048 + lo * 64, hi - lo + 1, M + b * 512, 8, true, tok, sink[head] * LOG2E, (lane >> 5) ? 0.f : 1.f, oa + (size_t)tok * 512 + head * 64, 512);
        } else if (type == 2) {
            const int b = vu >> 3, kh = (vu >> 2) & 1, qblk = vu & 3; const int head = kh * 4 + (wave >> 1); const int tok = b * 256 + qblk * 64 + 32 * (wave & 1);
            attn_unit<64>(lds, tid, lane, qa + (size_t)tok * 512 + head * 64, 512, nullptr, 0, ka + kh * 64, 128, nullptr, vaT + (size_t)(kh * 64) * MALL,
                          b * 256, 4, 0, 0, false, 0, sink[head] * LOG2E, (lane >> 5) ? 0.f : 1.f, oa + (size_t)tok * 512 + head * 64, 512);
        } else {
            const int b = vu >> 3, h = vu & 7; const int tok = b * 256 + 32 * wave;
            attn_unit<96>(lds, tid, lane, qb + (size_t)tok * 768 + h * 64, 768, qb + (size_t)tok * 768 + 512 + h * 32, 768, kn + h * 64, 512, kr, vbT + (size_t)(h * 64) * MALL,
                          b * 256, 4, 0, 0, false, 0, -1e30f, 0.f, ob + (size_t)tok * 512 + h * 64, 512);
        }
    }
}

__global__ void __launch_bounds__(512, 2) mk_fwd(Args a) {
    extern __shared__ __attribute__((aligned(16))) unsigned char lds_raw[];
    LAS unsigned char* lds = (LAS unsigned char*)lds_raw;
    cg::grid_group grid = cg::this_grid();
    const int tid = threadIdx.x, lane = tid & 63, wave = __builtin_amdgcn_readfirstlane(tid >> 6);
    const int G = gridDim.x, gw = blockIdx.x * 8 + wave, NGW = G * 8, gtid = blockIdx.x * 512 + tid, NT = G * 512;
    unsigned char* ws = a.ws;
    float* mods = (float*)(ws + OFF_MODS); float* ssq_q = (float*)(ws + OFF_SSQQ); float* ssq_kv = (float*)(ws + OFF_SSQKV);
    const float2* ropeA = (const float2*)(ws + OFF_ROPEA); const float2* ropeB = (const float2*)(ws + OFF_ROPEB);
    bf16* H = (bf16*)(ws + OFF_H); bf16* ACT = (bf16*)(ws + OFF_ACT);
    float* xr = a.out;
    const int lo = a.ph_lo, hi = a.ph_hi;
    if (hi > 1000) grid.sync();
    volatile LAS unsigned* xst = (volatile LAS unsigned*)(lds + 131072);
    if (tid < 2) xst[tid] = 0u;
    __syncthreads();
    XcdBarrier xbar = xcd_barrier_post((unsigned*)(ws + OFF_BAR), xst);
#ifndef P6M
#define P6M 7
#endif
#ifndef PH_MASK
#define PH_MASK 0x3fff
#endif
#define IN(k) (((PH_MASK >> (k)) & 1) && lo <= (k) && (k) < hi)
#define SEAM(k) do { if (IN(k) && IN((k) + 1)) xcd_barrier(xbar); } while (0)
    if (IN(0)) { p0_weights(a, lds, gw, NGW, wave, lane); p0_misc(a, gtid, NT); p0_ada(a, lds, tid); }
#if defined(DUP0)
    xcd_barrier(xbar); p0_weights(a, lds, gw, NGW, wave, lane);
#endif
    SEAM(0);
    if (IN(1)) norm_mod_phase(a.in[0], a.in[1], a.in[10], mods, 0, H, gw, NGW, lane);
#if defined(DUP1)
    xcd_barrier(xbar); norm_mod_phase(a.in[0], a.in[1], a.in[10], mods, 0, H, gw, NGW, lane);
#endif
    SEAM(1);
    if (IN(2)) { pg8::Gemm g{H, (const bf16*)(ws + OFF_WGU1), M, NGU, D}; pg8::StaticOrder S; S.init(M, NGU, G, (int)blockIdx.x); EpiSwiglu E{ACT};
        pg8::gemm_phase<EpiSwiglu, pg8::StaticOrder, PG8_ALIGN, PG8_SP2>(lds, g, S, E); }
#if defined(DUP2)
    xcd_barrier(xbar); { pg8::Gemm g{H, (const bf16*)(ws + OFF_WGU1), M, NGU, D}; pg8::StaticOrder S; S.init(M, NGU, G, (int)blockIdx.x); EpiSwiglu E{ACT};
        pg8::gemm_phase<EpiSwiglu, pg8::StaticOrder, PG8_ALIGN, PG8_SP2>(lds, g, S, E); }
#endif
    SEAM(2);
    if (IN(3)) { pg8::Gemm g{ACT, (const bf16*)(ws + OFF_WD1), M, D, FF}; pg8::StaticOrder S; S.init(M, D, G, (int)blockIdx.x); EpiResid E{a.in[0], a.in[1], xr, mods, 2, 0.5f};
        pg8::gemm_phase<EpiResid, pg8::StaticOrder, PG8_ALIGN, PG8_SP2>(lds, g, S, E); }
#if defined(DUP3)
    xcd_barrier(xbar); { pg8::Gemm g{ACT, (const bf16*)(ws + OFF_WD1), M, D, FF}; pg8::StaticOrder S; S.init(M, D, G, (int)blockIdx.x); EpiResid E{a.in[0], a.in[1], xr, mods, 2, 0.5f};
        pg8::gemm_phase<EpiResid, pg8::StaticOrder, PG8_ALIGN, PG8_SP2>(lds, g, S, E); }
#endif
#if defined(DUPS)
    for (int q = 0; q < 10; ++q) xcd_barrier(xbar);
#endif
    SEAM(3);
    if (IN(4)) { norm_mod_phase(xr, xr + (size_t)MP * D, a.in[13], mods, 1, H, gw, NGW, lane); ctx_convert(a, gtid, NT); }
    SEAM(4);
    if (IN(5)) { pg8::Gemm g{H, (const bf16*)(ws + OFF_WIN), M, NINP, D}; pg8::StaticOrder S; S.init(M, NINP, G, (int)blockIdx.x);
        EpiWin E{(bf16*)(ws + OFF_QA), (bf16*)(ws + OFF_KA), (bf16*)(ws + OFF_VAT), (bf16*)(ws + OFF_QLAT), (bf16*)(ws + OFF_CKV), (bf16*)(ws + OFF_GA), (bf16*)(ws + OFF_GB), (bf16*)(ws + OFF_KROPE),
                 ssq_q, ssq_kv, a.out, ropeA, ropeB};
        pg8::gemm_phase<EpiWin, pg8::StaticOrder, PG8_ALIGN, PG8_SP2>(lds, g, S, E); }
    SEAM(5);
    if (IN(6)) {
        int K6 = 256; asm volatile("" : "+s"(K6));
#if P6M & 1
        { pg8::Gemm g{(const bf16*)(ws + OFF_QLAT), (const bf16*)(ws + OFF_WUQ), M, 768, K6}; pg8::StaticOrder S; S.init(M, 768, G, (int)blockIdx.x); EpiQB E{(bf16*)(ws + OFF_QB), ssq_q, ropeB};
          pg8::gemm_phase<EpiQB, pg8::StaticOrder, PG8_ALIGN, PG8_SP2>(lds, g, S, E); }
#endif
#if P6M & 2
        { pg8::Gemm g{(const bf16*)(ws + OFF_CKV), (const bf16*)(ws + OFF_WK), MALL, 512, K6}; pg8::StaticOrder S; S.init(MALL, 512, G, (int)((blockIdx.x + 64) % G)); EpiKN E{(bf16*)(ws + OFF_KN), ssq_kv};
          pg8::gemm_phase<EpiKN, pg8::StaticOrder, PG8_ALIGN, PG8_SP2>(lds, g, S, E); }
#endif
#if P6M & 4
        { pg8::Gemm g{(const bf16*)(ws + OFF_WV), (const bf16*)(ws + OFF_CKV), 512, MALL, K6}; pg8::StaticOrder S; S.init(512, MALL, G, (int)((blockIdx.x + 176) % G)); EpiVT E{(bf16*)(ws + OFF_VBT), ssq_kv};
          pg8::gemm_phase<EpiVT, pg8::StaticOrder, PG8_ALIGN, PG8_SP2>(lds, g, S, E); }
#endif
        { const bf16* ckv = (const bf16*)(ws + OFF_CKV); const float* gn = a.in[17]; float* o = a.out + OUT_CKV;
          for (int row = gw; row < MP; row += NGW) { const float rs = 1.0f / sqrtf(ssq_kv[row] * (1.f / 256.f) + EPS); const v2u w = *(const v2u*)(ckv + (size_t)row * 256 + 4 * lane); const f32x4 g4 = *(const f32x4*)(gn + 4 * lane);
              *(f32x4*)(o + (size_t)row * 256 + 4 * lane) = (f32x4){bflo(w.x), bfhi(w.x), bflo(w.y), bfhi(w.y)} * rs * g4; } }
    }
    SEAM(6);
    if (IN(7)) attn_phase(a, lds, tid, wave, lane);
#if defined(DUP7)
    xcd_barrier(xbar); attn_phase(a, lds, tid, wave, lane);
#endif
    SEAM(7);
    if (IN(8)) {
        { pg8::Gemm g{(const bf16*)(ws + OFF_OA), (const bf16*)(ws + OFF_WOA), M, D, 512}; pg8::StaticOrder S; S.init(M, D, G, (int)blockIdx.x); EpiMerge<false> E{(bf16*)(ws + OFF_MM), (const bf16*)(ws + OFF_GA)};
          pg8::gemm_phase<EpiMerge<false>, pg8::StaticOrder, PG8_ALIGN, PG8_SP2>(lds, g, S, E); }
        { pg8::Gemm g{(const bf16*)(ws + OFF_OB), (const bf16*)(ws + OFF_WOB), M, D, 512}; pg8::StaticOrder S; S.init(M, D, G, (int)blockIdx.x); EpiMerge<true> E{(bf16*)(ws + OFF_MM), (const bf16*)(ws + OFF_GB)};
          pg8::gemm_phase<EpiMerge<true>, pg8::StaticOrder, PG8_ALIGN, PG8_SP2>(lds, g, S, E); }
    }
    SEAM(8);
    if (IN(9)) { pg8::Gemm g{(const bf16*)(ws + OFF_MM), (const bf16*)(ws + OFF_WOUT), M, D, D}; pg8::StaticOrder S; S.init(M, D, G, (int)blockIdx.x); EpiResid E{xr, xr + (size_t)MP * D, xr, mods, 5, 1.0f};
        pg8::gemm_phase<EpiResid, pg8::StaticOrder, PG8_ALIGN, PG8_SP2>(lds, g, S, E); }
    SEAM(9);
    if (IN(10)) norm_mod_phase(xr, xr + (size_t)MP * D, a.in[23], mods, 2, H, gw, NGW, lane);
    SEAM(10);
    if (IN(11)) { pg8::Gemm g{H, (const bf16*)(ws + OFF_WGU2), M, NGU, D}; pg8::StaticOrder S; S.init(M, NGU, G, (int)blockIdx.x); EpiSwiglu E{ACT};
        pg8::gemm_phase<EpiSwiglu, pg8::StaticOrder, PG8_ALIGN, PG8_SP2>(lds, g, S, E); }
    SEAM(11);
    if (IN(12)) { pg8::Gemm g{ACT, (const bf16*)(ws + OFF_WD2), M, D, FF}; pg8::StaticOrder S; S.init(M, D, G, (int)blockIdx.x); EpiResid E{xr, xr + (size_t)MP * D, xr, mods, 8, 0.5f};
        pg8::gemm_phase<EpiResid, pg8::StaticOrder, PG8_ALIGN, PG8_SP2>(lds, g, S, E); }
    SEAM(12);
    if (IN(13)) final_norm_phase(xr, a.in[26], gw, NGW, lane);

#ifdef PROBE_SCALE
    grid.sync();
    { const size_t ranges[6][2] = {{0, (size_t)MP * D}, {(size_t)MP * D, (size_t)M * D}, {OUT_K, OUT_V}, {OUT_V, OUT_CKV}, {OUT_CKV, OUT_KR}, {OUT_KR, OUT_KR + 8192 * 32}};
#pragma unroll
      for (int o = 0; o < 6; ++o) if ((PROBE_SCALE >> o) & 1) for (size_t i = ranges[o][0] + gtid; i < ranges[o][1]; i += NT) a.out[i] *= 1.01f; }
#endif
#undef IN
#undef SEAM
}

constexpr int N_PHASES = 14;
extern "C" void kernel_launch(void* const* d_in, const int* in_sizes, int n_in, void* d_out, int out_size, void* d_ws, size_t ws_size, hipStream_t stream) {
    static int grid = 0;
    if (grid == 0) {
        if (n_in != 27 || ws_size < WS_END) { fprintf(stderr, "kernel_launch: unexpected n_in %d / ws %zu\n", n_in, ws_size); grid = -1; return; }
        int dev = 0, cus = 0, per_cu = 0;
        hipGetDevice(&dev); hipDeviceGetAttribute(&cus, hipDeviceAttributeMultiprocessorCount, dev);
        if (hipFuncSetAttribute((const void*)mk_fwd, hipFuncAttributeMaxDynamicSharedMemorySize, LDS_BYTES) != hipSuccess) { fprintf(stderr, "kernel_launch: hipFuncSetAttribute failed\n"); grid = -1; return; }
        if (hipOccupancyMaxActiveBlocksPerMultiprocessor(&per_cu, (const void*)mk_fwd, 512, LDS_BYTES) != hipSuccess || per_cu < 1) { fprintf(stderr, "kernel_launch: occupancy query gave %d\n", per_cu); per_cu = 1; }
        (void)hipGetLastError();
        grid = cus * 1;
        fprintf(stderr, "kernel_launch: cus %d per_cu %d grid %d\n", cus, per_cu, grid);
    }
    if (grid < 0) return;
    (void)hipMemsetAsync(d_ws, 0, ZERO_BYTES, stream);
    Args a{};
    for (int i = 0; i < 27; ++i) a.in[i] = (const float*)d_in[i];
    a.out = (float*)d_out; a.ws = (unsigned char*)d_ws;
#if MK_N_LAUNCHES == 1
    a.ph_lo = 0; a.ph_hi = N_PHASES;
    void* args[] = {&a};
    hipError_t e = hipLaunchCooperativeKernel((const void*)mk_fwd, dim3(grid), dim3(512), args, LDS_BYTES, stream);
    if (e != hipSuccess) fprintf(stderr, "cooperative launch failed: %s (grid %d)\n", hipGetErrorString(e), grid);
#else
    for (int p = 0; p < N_PHASES; ++p) { a.ph_lo = p; a.ph_hi = p + 1; hipLaunchKernelGGL(mk_fwd, dim3(grid), dim3(512), LDS_BYTES, stream, a); }
#endif
}
```

```cpp
#include <hip/hip_runtime.h>
#include <hip/hip_cooperative_groups.h>
#include <cstdio>
#include <cstdint>
namespace cg = cooperative_groups;
namespace pg8 {
#define PG8_LAS __attribute__((address_space(3)))
typedef unsigned short bf16_t;
typedef short bf16x8 __attribute__((ext_vector_type(8)));
typedef float f32x4 __attribute__((ext_vector_type(4)));
typedef unsigned u32x4 __attribute__((ext_vector_type(4)));
constexpr int BM = 256, BK = 64, HALF = 128, HTB = HALF * BK * 2  , STAGE_BYTES = 8 * HTB, NXCD = 8, WGM = 8;

__host__ __device__ __forceinline__ int lds_byte(int r, int c) { const int st = (r >> 4) * 2 + (c >> 5), rr = r & 15, cc = c & 31, ob = rr * 64 + cc * 2; return st * 1024 + (ob ^ (((ob >> 9) & 1) << 5)); }
__host__ __device__ __forceinline__ void stage_rc(int b, int& R, int& C) { const int st = b / 1024, sb = b % 1024, swz = sb ^ (((sb >> 9) & 1) << 5); R = (st >> 1) * 16 + swz / 64; C = (st & 1) * 32 + (swz % 64) / 2; }
__host__ __device__ __forceinline__ int perm32(int rho) { const int n = rho >> 4, i = rho & 15; return 8 * (i >> 2) + 4 * n + (i & 3); }

struct Unit { int pm, pn, half; };
struct Gemm { const bf16_t* A; const bf16_t* Bt; int M, N, K; };

struct StaticOrder {
    int nM, nN, nwg, G, c;
    __host__ __device__ void init(int M, int N, int G_, int c_) { nM = M / BM; nN = N / BM; nwg = nM * nN; G = G_; c = c_; }
    __host__ __device__ bool next(int i, Unit& u) const { const long L = (long)i * G + c; if (L >= nwg) return false; map(L, u); return true; }
    __host__ __device__ void map(long L, Unit& u) const {
        int wgid = (int)L; { const int q = nwg / NXCD, r = nwg % NXCD, xcd = wgid % NXCD, off = wgid / NXCD; wgid = (xcd < r ? xcd * (q + 1) : r * (q + 1) + (xcd - r) * q) + off; }
        const int nig = WGM * nN, gid = wgid / nig, fm = gid * WGM, gsz = (nM - fm) < WGM ? (nM - fm) : WGM;
        u.pm = fm + ((wgid % nig) % gsz); u.pn = (wgid % nig) / gsz; u.half = 0;
    }
    __device__ __forceinline__ void a_ready(const Unit&) const {}
    __device__ __forceinline__ void done(const Unit&) const {}
};
struct TailOrder : StaticOrder {
    __host__ __device__ bool next(int i, Unit& u) const {
        const int full = nwg / G, rem = nwg - full * G;
        if (rem == 0 || 2 * rem > G || (rem & 7) || (G & 15)) return StaticOrder::next(i, u);
        if (i < full) return StaticOrder::next(i, u);
        if (i > full) return false;
        const int x = c & 7, j = c >> 3;
        if ((j >> 1) >= rem / 8) return false;
        map((long)full * G + 8 * (j >> 1) + x, u); u.half = 1 + (j & 1); return true;
    }
};
__device__ __forceinline__ unsigned cvt_pk_bf16(float lo, float hi) { unsigned r; asm volatile("v_cvt_pk_bf16_f32 %0, %1, %2" : "=v"(r) : "v"(lo), "v"(hi)); return r; }
typedef float f32x2 __attribute__((ext_vector_type(2)));
template <class T, class = void> struct MidK { static constexpr bool value = false; };
template <class T> struct MidK<T, decltype((void)T::MIDK)> { static constexpr bool value = T::MIDK; };
template <class Epi, class Sched, bool ALIGN_EPI = false, bool SP2 = false>
__device__ __forceinline__ void gemm_phase(PG8_LAS unsigned char* lds, const Gemm g, const Sched& S, const Epi& E) {
    const int tid = threadIdx.x, wid = __builtin_amdgcn_readfirstlane(tid >> 6), lane = tid & 63, wr = wid >> 2, wc = wid & 3, fr = lane & 15, fq = lane >> 4;
    const int K = g.K, nt = K / BK;
    unsigned voffA[2], voffB[2];
#pragma unroll
    for (int i = 0; i < 2; ++i) { int R, C; stage_rc(tid * 16 + i * 8192, R, C); const int Rb = Epi::PERM ? ((R & ~31) + perm32(R & 31)) : R;
        voffA[i] = (unsigned)(R * K + C) * 2u; voffB[i] = (unsigned)(Rb * K + C) * 2u; }
    const size_t kstep = (size_t)(BK * 2);
    const size_t hstep = (size_t)HALF * K * 2;
    const size_t tstep = 2 * hstep;
    const unsigned ldsw = (unsigned)wid * 1024u;
    const int aoff = lds_byte(wr * 64 + fr, fq * 8), boff = lds_byte(wc * 32 + fr, fq * 8);
#define PG8_SA(b, h) (((b) * 2 + (h)) * HTB)
#define PG8_SB(b, h) ((4 + (b) * 2 + (h)) * HTB)
#define PG8_STAGE(bufoff, gbase, voff) do { _Pragma("unroll") for (int _i = 0; _i < 2; ++_i) \
        __builtin_amdgcn_global_load_lds((const unsigned*)((const char*)(gbase) + (voff)[_i]), (PG8_LAS unsigned*)(lds + (bufoff) + ldsw + _i * 8192), 16, 0, 0); } while (0)
#define PG8_LDA(dst, b, h) do { _Pragma("unroll") for (int m = 0; m < 4; ++m) _Pragma("unroll") for (int k = 0; k < 2; ++k) dst[m][k] = *(const PG8_LAS bf16x8*)(lds + PG8_SA(b, h) + aoff + m * 2048 + k * 1024); } while (0)
#define PG8_LDB(dst, b, h) do { _Pragma("unroll") for (int n = 0; n < 2; ++n) _Pragma("unroll") for (int k = 0; k < 2; ++k) dst[n][k] = *(const PG8_LAS bf16x8*)(lds + PG8_SB(b, h) + boff + n * 2048 + k * 1024); } while (0)
#define PG8_MMA(ai, bj, At, Bt) do { __builtin_amdgcn_s_setprio(1); _Pragma("unroll") for (int m = 0; m < 4; ++m) _Pragma("unroll") for (int n = 0; n < 2; ++n) _Pragma("unroll") for (int k = 0; k < 2; ++k) \
        acc[ai][bj][m][n] = __builtin_amdgcn_mfma_f32_16x16x32_bf16(Bt[n][k], At[m][k], acc[ai][bj][m][n], 0, 0, 0); __builtin_amdgcn_s_setprio(0); } while (0)
#define PG8_WAIT_V(n) asm volatile("s_waitcnt vmcnt(" #n ")" ::: "memory")
#define PG8_WAIT_L(n) asm volatile("s_waitcnt lgkmcnt(" #n ")" ::: "memory")
#define PG8_BAR __builtin_amdgcn_s_barrier()
#define PG8_SCHED __builtin_amdgcn_sched_barrier(0)
    Unit cur, nxt; int ui = 0;
    if (!S.next(0, cur)) return;
    f32x4 acc[2][2][4][2];
#pragma unroll
    for (int a = 0; a < 2; ++a)
#pragma unroll
        for (int b = 0; b < 2; ++b)
#pragma unroll
            for (int m = 0; m < 4; ++m)
#pragma unroll
                for (int n = 0; n < 2; ++n) acc[a][b][m][n] = (f32x4){0.f, 0.f, 0.f, 0.f};
    bf16x8 At[4][2], B0[2][2], B1[2][2];
    const char* cA = (const char*)g.A + (size_t)cur.pm * tstep + (cur.half == 2 ? hstep : (size_t)0); const char* cB = (const char*)g.Bt + (size_t)cur.pn * tstep;
    S.a_ready(cur);
    if constexpr (SP2) {
        PG8_STAGE(PG8_SB(0, 0), cB, voffB); PG8_STAGE(PG8_SB(0, 1), cB + hstep, voffB); PG8_STAGE(PG8_SA(0, 0), cA, voffA); PG8_STAGE(PG8_SA(0, 1), cA + hstep, voffA);
        if (wr == 1) PG8_BAR;
        PG8_WAIT_V(2); PG8_BAR;
        PG8_STAGE(PG8_SB(1, 0), cB + kstep, voffB); PG8_STAGE(PG8_SA(1, 0), cA + kstep, voffA); PG8_STAGE(PG8_SB(1, 1), cB + hstep + kstep, voffB);
        PG8_WAIT_V(6); PG8_BAR;
    } else {
        PG8_STAGE(PG8_SB(0, 0), cB, voffB); PG8_STAGE(PG8_SA(0, 0), cA, voffA); PG8_STAGE(PG8_SB(0, 1), cB + hstep, voffB); PG8_STAGE(PG8_SA(0, 1), cA + hstep, voffA);
        if (wr == 1) PG8_BAR;
        PG8_WAIT_V(4); PG8_BAR;
        PG8_STAGE(PG8_SB(1, 0), cB + kstep, voffB); PG8_STAGE(PG8_SA(1, 0), cA + kstep, voffA); PG8_STAGE(PG8_SB(1, 1), cB + hstep + kstep, voffB);
        PG8_WAIT_V(6); PG8_BAR;
    }
    for (;;) {
        const bool has_next = S.next(ui + 1, nxt);
        const char* nA = has_next ? (const char*)g.A + (size_t)nxt.pm * tstep + (nxt.half == 2 ? hstep : (size_t)0) : cA; const char* nB = has_next ? (const char*)g.Bt + (size_t)nxt.pn * tstep : cB;
        for (int t = 0; t < nt; t += 2) {
            const bool last = (t == nt - 2);
            const char* a1 = cA + (size_t)(t + 1) * kstep;
            const char* a2 = last ? nA : cA + (size_t)(t + 2) * kstep; const char* b2 = last ? nB : cB + (size_t)(t + 2) * kstep;
            const char* a3 = a2 + kstep; const char* b3 = b2 + kstep;
            if constexpr (MidK<Epi>::value) { if (t == nt / 2) E.mid(acc, cur, wr, wc, fr, fq); }
            if (last && has_next) S.a_ready(nxt);
            if constexpr (SP2) {
            PG8_LDB(B0, 0, 0); PG8_LDB(B1, 0, 1); PG8_SCHED; PG8_LDA(At, 0, 0); PG8_STAGE(PG8_SA(1, 1), a1 + hstep, voffA);
            PG8_WAIT_V(8); PG8_WAIT_L(0); PG8_BAR; PG8_MMA(0, 0, At, B0); PG8_MMA(0, 1, At, B1); PG8_BAR; PG8_SCHED;
            PG8_LDA(At, 0, 1); PG8_STAGE(PG8_SB(0, 0), b2, voffB); PG8_STAGE(PG8_SB(0, 1), b2 + hstep, voffB); PG8_STAGE(PG8_SA(0, 0), a2, voffA);
            PG8_WAIT_V(8); PG8_WAIT_L(0); PG8_BAR; PG8_MMA(1, 0, At, B0); PG8_MMA(1, 1, At, B1); PG8_BAR; PG8_SCHED;
            PG8_LDB(B0, 1, 0); PG8_LDB(B1, 1, 1); PG8_SCHED; PG8_LDA(At, 1, 0); PG8_STAGE(PG8_SA(0, 1), a2 + hstep, voffA);
            PG8_WAIT_V(8); PG8_WAIT_L(0); PG8_BAR; PG8_MMA(0, 0, At, B0); PG8_MMA(0, 1, At, B1); PG8_BAR; PG8_SCHED;
            PG8_LDA(At, 1, 1); PG8_STAGE(PG8_SB(1, 0), b3, voffB); PG8_STAGE(PG8_SB(1, 1), b3 + hstep, voffB); PG8_STAGE(PG8_SA(1, 0), a3, voffA);
            PG8_WAIT_V(8); PG8_WAIT_L(0); PG8_BAR; PG8_MMA(1, 0, At, B0); PG8_MMA(1, 1, At, B1); PG8_BAR; PG8_SCHED;
            } else {
            PG8_LDB(B0, 0, 0); PG8_SCHED; PG8_LDA(At, 0, 0); PG8_STAGE(PG8_SA(1, 1), a1 + hstep, voffA);
            PG8_WAIT_L(8); PG8_BAR; PG8_WAIT_L(0); PG8_MMA(0, 0, At, B0); PG8_BAR; PG8_SCHED;
            PG8_LDB(B1, 0, 1); PG8_STAGE(PG8_SB(0, 0), b2, voffB);
            PG8_BAR; PG8_WAIT_L(0); PG8_MMA(0, 1, At, B1); PG8_BAR;
            PG8_LDA(At, 0, 1); PG8_STAGE(PG8_SA(0, 0), a2, voffA);
            PG8_BAR; PG8_WAIT_L(0); PG8_MMA(1, 0, At, B0); PG8_BAR; PG8_SCHED;
            PG8_STAGE(PG8_SB(0, 1), b2 + hstep, voffB);
            PG8_WAIT_V(6); PG8_BAR; PG8_MMA(1, 1, At, B1); PG8_BAR;
            PG8_LDB(B0, 1, 0); PG8_SCHED; PG8_LDA(At, 1, 0); PG8_STAGE(PG8_SA(0, 1), a2 + hstep, voffA);
            PG8_WAIT_L(8); PG8_BAR; PG8_WAIT_L(0); PG8_MMA(0, 0, At, B0); PG8_BAR; PG8_SCHED;
            PG8_LDB(B1, 1, 1); PG8_STAGE(PG8_SB(1, 0), b3, voffB);
            PG8_BAR; PG8_WAIT_L(0); PG8_MMA(0, 1, At, B1); PG8_BAR;
            PG8_LDA(At, 1, 1); PG8_STAGE(PG8_SA(1, 0), a3, voffA);
            PG8_BAR; PG8_WAIT_L(0); PG8_MMA(1, 0, At, B0); PG8_BAR; PG8_SCHED;
            PG8_STAGE(PG8_SB(1, 1), b3 + hstep, voffB);
            PG8_WAIT_V(6); PG8_BAR; PG8_MMA(1, 1, At, B1); PG8_BAR;
            }
        }
        if constexpr (ALIGN_EPI) { if (wr == 0) PG8_BAR; }
        if constexpr (!Epi::AFTER_DRAIN) { E(acc, cur, wr, wc, fr, fq); S.done(cur); }
        if (!has_next) break;
#pragma unroll
        for (int a = 0; a < 2; ++a)
#pragma unroll
            for (int b = 0; b < 2; ++b)
#pragma unroll
                for (int m = 0; m < 4; ++m)
#pragma unroll
                    for (int n = 0; n < 2; ++n) acc[a][b][m][n] = (f32x4){0.f, 0.f, 0.f, 0.f};
        cur = nxt; cA = nA; cB = nB; ++ui;
        if constexpr (ALIGN_EPI) { if (wr == 1) PG8_BAR; }
    }
    PG8_WAIT_V(0);
    if constexpr (!ALIGN_EPI) { if (wr == 0) PG8_BAR; }
    PG8_BAR;
    if constexpr (Epi::AFTER_DRAIN) { E.fused(acc, cur, wr, wc, fr, fq, lds, wid, lane); S.done(cur); }
#undef PG8_SA
#undef PG8_SB
#undef PG8_STAGE
#undef PG8_LDA
#undef PG8_LDB
#undef PG8_MMA
#undef PG8_WAIT_V
#undef PG8_WAIT_L
#undef PG8_BAR
#undef PG8_SCHED
}
}
#ifndef PG8_SP2
#define PG8_SP2 true
#endif
#ifndef PG8_ALIGN
#define PG8_ALIGN true
#endif
#ifndef MK_N_LAUNCHES
#define MK_N_LAUNCHES 1
#endif
#define DI __device__ __forceinline__
#define LAS __attribute__((address_space(3)))
typedef unsigned short bf16;
typedef unsigned v4u __attribute__((ext_vector_type(4)));
typedef unsigned v2u __attribute__((ext_vector_type(2)));
typedef float f32x4 __attribute__((ext_vector_type(4)));
typedef float f32x16 __attribute__((ext_vector_type(16)));
typedef short bf16x8 __attribute__((ext_vector_type(8)));
using pg8::Unit;

constexpr int D = 1024, MP = 8192, M = 16384, MCTX = 2048, MALL = 18432;
constexpr int FF = 2816, NGU = 5632, NINP = 3584, NMODS = 9216;
constexpr float EPS = 1e-6f, LOG2E = 1.4426950408889634f;
constexpr float A_QS = 0.125f * LOG2E;
constexpr float B_QS = 0.10206207261596575f * LOG2E;
constexpr size_t OUT_K = (size_t)M * D, OUT_V = OUT_K + 8192 * 128, OUT_CKV = OUT_V + 8192 * 128, OUT_KR = OUT_CKV + 8192 * 256;
constexpr size_t MiB = 1u << 20;
constexpr size_t OFF_MODS = 0, OFF_SSQQ = 196608, OFF_SSQKV = 262144, OFF_BAR = 327680, OFF_SSQ1 = 344064, OFF_SSQ2 = 409600, OFF_PCNT = 475136, ZERO_BYTES = 491520, OFF_ROPEA = 524288, OFF_ROPEB = 532480, OFF_SHW2 = 589824, OFF_SHW3 = 663552;
constexpr size_t OFF_WGU1 = 1 * MiB, OFF_WGU2 = 12 * MiB, OFF_WD1 = 23 * MiB, OFF_WD2 = OFF_WD1 + 5767168, OFF_WIN = 34 * MiB, OFF_WOUT = 41 * MiB,
                 OFF_WOA = 43 * MiB, OFF_WOB = 44 * MiB, OFF_WUQ = 45 * MiB, OFF_WK = OFF_WUQ + 393216, OFF_WV = OFF_WK + 262144;
constexpr size_t OFF_H = 46 * MiB, OFF_OA = OFF_H, OFF_OB = OFF_H + 16 * MiB;
constexpr size_t OFF_ACT = 78 * MiB;
constexpr size_t OFF_QA = OFF_ACT, OFF_KA = OFF_QA + 16 * MiB, OFF_VAT = OFF_KA + (size_t)MALL * 128 * 2, OFF_QLAT = OFF_VAT + (size_t)MALL * 128 * 2,
                 OFF_CKV = OFF_QLAT + 8 * MiB, OFF_KROPE = OFF_CKV + 9 * MiB, OFF_QB = OFF_KROPE + (size_t)MALL * 32 * 2 + 131072, OFF_KN = OFF_QB + 24 * MiB;
constexpr size_t OFF_MM = OFF_ACT;
constexpr size_t OFF_GA = 166 * MiB, OFF_GB = 198 * MiB, OFF_VBT = 230 * MiB, OFF_PART1 = 248 * MiB, OFF_PART2 = 249 * MiB, OFF_PARTQ = 250 * MiB, OFF_PARTKV = 250 * MiB + 262144, WS_END = 251 * MiB;
static_assert(OFF_QLAT + 8 * MiB >= OFF_MM + 32 * MiB, "m overlay");
static_assert(OFF_KN + 18 * MiB <= OFF_GA && OFF_WV + 262144 <= OFF_H, "ws map");
constexpr int LDS_BYTES = 147456;

DI unsigned f2bf(float f) { unsigned u = __builtin_bit_cast(unsigned, f); return (u + 0x7fffu + ((u >> 16) & 1u)) >> 16; }
typedef __bf16 hbf16x2 __attribute__((ext_vector_type(2)));
typedef float hf32x2 __attribute__((ext_vector_type(2)));
DI unsigned pk2(float lo, float hi) { const hf32x2 f = {lo, hi}; return __builtin_bit_cast(unsigned, __builtin_convertvector(f, hbf16x2)); }
DI float bflo(unsigned w) { return __builtin_bit_cast(float, w << 16); }
DI float bfhi(unsigned w) { return __builtin_bit_cast(float, w & 0xffff0000u); }
DI float fexp2(float x) { return __builtin_amdgcn_exp2f(x); }
DI float frcp(float x) { return __builtin_amdgcn_rcpf(x); }
DI float sigm(float x) { return frcp(1.f + fexp2(-x * LOG2E)); }
#define LDS_WAIT() asm volatile("s_waitcnt lgkmcnt(0)" ::: "memory")
DI float wave_sum(float v) {
#pragma unroll
    for (int o = 1; o < 64; o <<= 1) v += __shfl_xor(v, o);
    return v;
}
DI float sum16(const float* p) { const f32x4 a = *(const f32x4*)p, b = *(const f32x4*)(p + 4), c = *(const f32x4*)(p + 8), d = *(const f32x4*)(p + 12); const f32x4 t = (a + b) + (c + d); return (t.x + t.y) + (t.z + t.w); }
DI float sum4(const float* p) { const f32x4 a = *(const f32x4*)p; return (a.x + a.y) + (a.z + a.w); }
DI int mod_index(int row) { return row < MP ? 0 : 1 + ((row - MP) >> 11); }

#define XB_TMO      128
#define XB_XCNT(j)  (256  + 64 * (j))
#define XB_XSUB(j)  (1280 + 64 * (j))
#define XB_XGEN(j)  (2304 + 64 * (j))
#define XB_TOP      3328
#define XB_TOPGEN   3392
#define XCD_BAR_WORDS 3456
#define XB_SPIN_CAP (1u << 18)

__device__ __forceinline__ unsigned xb_ld(unsigned* p)              { return __hip_atomic_load(p, __ATOMIC_RELAXED, __HIP_MEMORY_SCOPE_AGENT); }
__device__ __forceinline__ unsigned xb_add(unsigned* p, unsigned v) { return __hip_atomic_fetch_add(p, v, __ATOMIC_RELAXED, __HIP_MEMORY_SCOPE_AGENT); }
__device__ __forceinline__ unsigned xb_xcc_id() { return (unsigned)__builtin_amdgcn_s_getreg((3 << 11) | 20) & 0xFu; }
#define XB_SPIN(cond, bar) do { unsigned _sp = 0; while (cond) { __builtin_amdgcn_s_sleep(1); \
    if ((++_sp & 255u) == 0u) { if (xb_ld(&(bar)[XB_TMO])) break; if (_sp > XB_SPIN_CAP) { atomicAdd(&(bar)[XB_TMO], 1u); break; } } } } while (0)

struct XcdBarrier {
    unsigned* bar; unsigned x;
    volatile LAS unsigned* st;
};

__device__ __forceinline__ XcdBarrier xcd_barrier_post(unsigned* bar, volatile LAS unsigned* st) {
    XcdBarrier b; b.bar = bar; b.x = xb_xcc_id(); b.st = st;
    if (threadIdx.x == 0) (void)xb_add(&bar[XB_XCNT(b.x)], 1u);
    return b;
}
__device__ __forceinline__ void xcd_barrier_complete(unsigned* bar, unsigned x, unsigned& nloc, unsigned& nx) {
    const unsigned G = gridDim.x * gridDim.y * gridDim.z;
    unsigned sum, cnt, mine, sp = 0u;
    for (;;) {
        sum = 0u; cnt = 0u; mine = 0u;
#pragma unroll
        for (unsigned j = 0; j < 16; ++j) { const unsigned c = xb_ld(&bar[XB_XCNT(j)]); sum += c; cnt += (c > 0u) ? 1u : 0u; mine = (j == x) ? c : mine; }
        if (sum == G) break;
        __builtin_amdgcn_s_sleep(1);
        if ((++sp & 255u) == 0u) { if (xb_ld(&bar[XB_TMO])) break; if (sp > XB_SPIN_CAP) { atomicAdd(&bar[XB_TMO], 1u); break; } }
    }
    nloc = mine > 0u ? mine : 1u; nx = cnt > 0u ? cnt : 1u;
}

__device__ __forceinline__ void xcd_barrier(const XcdBarrier& b) {
    asm volatile("s_waitcnt vmcnt(0)" ::: "memory");
    __syncthreads();
    if (threadIdx.x == 0) {
        unsigned* bar = b.bar;
        __builtin_amdgcn_s_waitcnt(0);
        unsigned nloc = b.st[0], nx = b.st[1];
        if (nloc == 0u) { xcd_barrier_complete(bar, b.x, nloc, nx); b.st[0] = nloc; b.st[1] = nx; }
        const unsigned old = xb_add(&bar[XB_XSUB(b.x)], 1u);
        const unsigned gen = old / nloc;
        if (old + 1u == (gen + 1u) * nloc) {
            __builtin_amdgcn_fence(__ATOMIC_RELEASE, "agent");
            asm volatile("s_waitcnt vmcnt(0)" ::: "memory");
            const unsigned og = xb_add(&bar[XB_TOP], 1u);
            const unsigned tg = og / nx;
            if (og + 1u == (tg + 1u) * nx) xb_add(&bar[XB_TOPGEN], 1u);
            else XB_SPIN(xb_ld(&bar[XB_TOPGEN]) == tg, bar);
            __builtin_amdgcn_fence(__ATOMIC_ACQUIRE, "agent");
            xb_add(&bar[XB_XGEN(b.x)], 1u);
            asm volatile("s_waitcnt vmcnt(0)" ::: "memory");
        } else {
            XB_SPIN(xb_ld(&bar[XB_XGEN(b.x)]) == gen, bar);
            __builtin_amdgcn_fence(__ATOMIC_ACQUIRE, "agent");
            asm volatile("s_waitcnt vmcnt(0)" ::: "memory");
        }
    }
    __syncthreads();
}


DI void transpose_item(const float* W, int N, bf16* WT, int K, int k0, int src_n0, int dst_r0, const float* kscale, float sscale, LAS float* scr, int lane, int dk = 0) {
    if (src_n0 >= 0) {
        float v[32];
#pragma unroll
        for (int i = 0; i < 32; ++i) v[i] = __builtin_nontemporal_load(W + (size_t)(k0 + 2 * i + (lane >> 5)) * N + src_n0 + (lane & 31));
        if (kscale) {
#pragma unroll
            for (int i = 0; i < 32; ++i) v[i] *= kscale[k0 + 2 * i + (lane >> 5)]; }
#pragma unroll
        for (int i = 0; i < 32; ++i) scr[(2 * i + (lane >> 5)) * 33 + (lane & 31)] = v[i] * sscale;
    } else {
#pragma unroll 8
        for (int i = 0; i < 32; ++i) { const int kk = 2 * i + (lane >> 5); scr[kk * 33 + (lane & 31)] = 0.f; }
    }
    LDS_WAIT(); asm volatile("" ::: "memory");
    const int c = lane & 7;
#pragma unroll
    for (int j = 0; j < 4; ++j) { const int n = (lane >> 3) + 8 * j; const LAS float* s = scr + (8 * c) * 33 + n;
        v4u o; o.x = pk2(s[0 * 33], s[1 * 33]); o.y = pk2(s[2 * 33], s[3 * 33]); o.z = pk2(s[4 * 33], s[5 * 33]); o.w = pk2(s[6 * 33], s[7 * 33]);
        *(v4u*)(WT + (size_t)(dst_r0 + n) * K + k0 + dk + 8 * c) = o; }
    LDS_WAIT(); asm volatile("" ::: "memory");
}

struct Args { const float* in[27]; float* out; unsigned char* ws; int ph_lo, ph_hi; };

constexpr int I_GU = 16 * 176, I_D = 44 * 32, I_IN = 16 * 112, I_OUT = 16 * 32, I_O = 8 * 32, I_UQ = 4 * 24, I_K = 4 * 16;
constexpr int P0_EARLY = I_GU + I_IN, P0_NIT = P0_EARLY + I_GU + 2 * I_D + I_OUT + 2 * I_O + I_UQ + 2 * I_K;
DI void p0_weights(const Args& a, LAS unsigned char* lds, int gw, int NGW, int wave, int lane, int it_lo, int it_hi) {
    LAS float* scr = (LAS float*)(lds + wave * 16384);
    unsigned char* ws = a.ws;
    for (int it = it_lo + gw; it < it_hi; it += NGW) {
        int r = it;
        if (r < I_GU) { const int w = 0; const int kb = r / 176, nb = r % 176, R0 = 32 * nb;
            const int pn = R0 >> 8, half = (R0 >> 7) & 1, j = R0 & 127;
            transpose_item(a.in[w ? 24 : 11], NGU, (bf16*)(ws + (w ? OFF_WGU2 : OFF_WGU1)), 1024, 64 * kb, half * FF + 128 * pn + j, R0, nullptr, 1.f, scr, lane); continue; }
        r -= I_GU;
        if (r < I_IN) { const int kb = r / 112, nb = r % 112, R0 = 32 * nb;
            const int gq = R0 - 1280; const int src = R0 < 1280 ? R0 : (R0 < 3328 ? (((gq >> 7) & 1) ? 2336 : 1312) + 128 * (gq >> 8) + (gq & 127) : (R0 == 3328 ? 1280 : -1));
            transpose_item(a.in[14], 3360, (bf16*)(ws + OFF_WIN), 1024, 64 * kb, src, R0, nullptr, 1.f, scr, lane); continue; }
        r -= I_IN;
        if (r < I_GU) { const int w = 1; const int kb = r / 176, nb = r % 176, R0 = 32 * nb;
            const int pn = R0 >> 8, half = (R0 >> 7) & 1, j = R0 & 127;
            transpose_item(a.in[w ? 24 : 11], NGU, (bf16*)(ws + (w ? OFF_WGU2 : OFF_WGU1)), 1024, 64 * kb, half * FF + 128 * pn + j, R0, nullptr, 1.f, scr, lane); continue; }
        r -= I_GU;
        if (r < I_D) { const int kb = r / 32, nb = r % 32;
            transpose_item(a.in[12], 1024, (bf16*)(ws + OFF_WD1), FF, 64 * kb, 32 * nb, 32 * nb, nullptr, 1.f, scr, lane); continue; }
        r -= I_D;
        if (r < I_D) { const int kb = r / 32, nb = r % 32;
            transpose_item(a.in[25], 1024, (bf16*)(ws + OFF_WD2), FF, 64 * kb, 32 * nb, 32 * nb, nullptr, 1.f, scr, lane); continue; }
        r -= I_D;
        if (r < I_OUT) { const int kb = r / 32, nb = r % 32; transpose_item(a.in[22], 1024, (bf16*)(ws + OFF_WOUT), 1024, 64 * kb, 32 * nb, 32 * nb, nullptr, 1.f, scr, lane); continue; }
        r -= I_OUT;
        if (r < 2 * I_O) { const int w = r >= I_O; r -= w * I_O; const int kb = r / 32, nb = r % 32;
            transpose_item(a.in[w ? 21 : 20], 1024, (bf16*)(ws + OFF_WOA), 1024, 64 * kb, 32 * nb, 32 * nb, nullptr, 1.f, scr, lane, w ? 512 : 0); continue; }
        r -= 2 * I_O;
        if (r < I_UQ) { const int kb = r / 24, nb = r % 24, R0 = 32 * nb;
            const int src = R0 < 512 ? (R0 >> 6) * 96 + (R0 & 63) : ((R0 - 512) >> 5) * 96 + 64;
            transpose_item(a.in[18], 768, (bf16*)(ws + OFF_WUQ), 256, 64 * kb, src, R0, a.in[16], B_QS, scr, lane); continue; }
        r -= I_UQ;
        { const int w = r >= I_K; r -= w * I_K; const int kb = r / 16, nb = r % 16, R0 = 32 * nb;
            const int src = (R0 >> 6) * 128 + (R0 & 63) + (w ? 64 : 0);
            transpose_item(a.in[19], 1024, (bf16*)(ws + (w ? OFF_WV : OFF_WK)), 256, 64 * kb, src, R0, a.in[17], 1.f, scr, lane); }
    }
}
DI void p0_ada(const Args& a, LAS unsigned char* lds, int tid) {
    LAS float* sc = (LAS float*)lds;
    LAS float* red = (LAS float*)(lds + 4096);
    float* mods = (float*)(a.ws + OFF_MODS);
    const float* adaw = a.in[8];
    for (int it = blockIdx.x; it < 256; it += gridDim.x) {
        const int cgp = it & 31, ks = it >> 5;
        __syncthreads();
        for (int i = tid; i < 640; i += 512) { const int v = i >> 7, k = ks * 128 + (i & 127); const float c = v == 0 ? a.in[7][k] : a.in[6][(v - 1) * 1024 + k]; sc[i] = c * sigm(c); }
        __syncthreads();
        const int colq = tid % 72, kl = tid / 72;
        if (kl < 7) {
            f32x4 acc[5];
#pragma unroll
            for (int v = 0; v < 5; ++v) acc[v] = (f32x4){0.f, 0.f, 0.f, 0.f};
            f32x4 w[19];
#pragma unroll
            for (int q = 0; q < 19; ++q) { const int k = kl + 7 * q; w[q] = k < 128 ? __builtin_nontemporal_load((const f32x4*)(adaw + (size_t)(ks * 128 + k) * NMODS + cgp * 288 + colq * 4)) : (f32x4){0.f, 0.f, 0.f, 0.f}; }
#pragma unroll
            for (int q = 0; q < 19; ++q) { const int k = kl + 7 * q; if (k < 128) {
#pragma unroll
                for (int v = 0; v < 5; ++v) acc[v] += w[q] * sc[v * 128 + k]; } }
#pragma unroll
            for (int v = 0; v < 5; ++v) *(LAS f32x4*)(red + (kl * 5 + v) * 288 + colq * 4) = acc[v];
        }
        __syncthreads();
        for (int i = tid; i < 1440; i += 512) { const int v = i / 288, cc = i % 288; float s = 0.f;
#pragma unroll
            for (int q = 0; q < 7; ++q) s += red[(q * 5 + v) * 288 + cc];
            const int col = cgp * 288 + cc; if (ks == 0) s += a.in[9][col];
            atomicAdd(mods + v * NMODS + col, s); }
    }
    __syncthreads();
}
DI void ctx_convert(const Args& a, int gtid, int NT) {
    unsigned char* ws = a.ws;
    bf16* ka = (bf16*)(ws + OFF_KA) + (size_t)M * 128; bf16* vaT = (bf16*)(ws + OFF_VAT); bf16* ckv = (bf16*)(ws + OFF_CKV) + (size_t)M * 256; bf16* kr = (bf16*)(ws + OFF_KROPE) + (size_t)M * 32;
    for (int i = gtid; i < MCTX * 128; i += NT) ka[i] = (bf16)f2bf(a.in[2][i]);
    for (int i = gtid; i < MCTX * 128; i += NT) { const int f = i >> 11, tk = i & 2047; vaT[(size_t)f * MALL + M + tk] = (bf16)f2bf(a.in[3][tk * 128 + f]); }
    for (int i = gtid; i < MCTX * 256; i += NT) ckv[i] = (bf16)f2bf(a.in[4][i] / a.in[17][i & 255]);
    for (int i = gtid; i < MCTX * 32; i += NT) kr[i] = (bf16)f2bf(a.in[5][i]);
}
DI void p0_misc(const Args& a, int gtid, int NT) {
    unsigned char* ws = a.ws;
    float2* ra = (float2*)(ws + OFF_ROPEA); float2* rb = (float2*)(ws + OFF_ROPEB);
    for (int i = gtid; i < 1024; i += NT) { const int pos = i >> 4, fi = i & 15; const float inv = 1.0f / powf(10000.f, (float)(2 * fi) / 32.f); const float ang = (float)pos * inv; ra[i] = make_float2(cosf(ang), sinf(ang)); }
    for (int i = gtid; i < 512; i += NT) { const int pos = i >> 3, fi = i & 7; const float inv = 1.0f / powf(10000.f, (float)(2 * fi) / 16.f); const float ang = (float)pos * inv; rb[i] = make_float2(cosf(ang), sinf(ang)); }
}

DI void norm_mod_phase(const float* xa, const float* xb, const float* gain, const float* mods, int s, bf16* h, int gw, int NGW, int lane) {
    for (int row = gw; row < M; row += NGW) {
        const float* xr = row < MP ? xa + (size_t)row * D : xb + (size_t)(row - MP) * D;
        f32x4 v[4]; float ss = 0.f;
#pragma unroll
        for (int j = 0; j < 4; ++j) { v[j] = *(const f32x4*)(xr + 4 * (64 * j + lane)); ss += (v[j].x * v[j].x + v[j].y * v[j].y) + (v[j].z * v[j].z + v[j].w * v[j].w); }
        const float rstd = 1.0f / sqrtf(wave_sum(ss) * (1.f / D) + EPS);
        const float* sh = mods + mod_index(row) * NMODS + (3 * s) * D; const float* sc = sh + D;
#pragma unroll
        for (int j = 0; j < 4; ++j) { const int c = 4 * (64 * j + lane); const f32x4 g = *(const f32x4*)(gain + c), s4 = *(const f32x4*)(sh + c), c4 = *(const f32x4*)(sc + c);
            const f32x4 o = (v[j] * rstd * g) * (c4 + 1.0f) + s4; v2u w; w.x = pk2(o.x, o.y); w.y = pk2(o.z, o.w); *(v2u*)(h + (size_t)row * D + c) = w; }
    }
}
DI void shw_phase(const bf16* WT, int nrows, const float* mods, int shslot, float* shW, int gw, int NGW, int lane) {
    for (int n = gw; n < nrows; n += NGW) {
        const v4u w0 = *(const v4u*)(WT + (size_t)n * D + 16 * lane), w1 = *(const v4u*)(WT + (size_t)n * D + 16 * lane + 8);
        f32x4 a0, a1, a2, a3; { f32x4 t0, t1; a0 = (f32x4){bflo(w0.x), bfhi(w0.x), bflo(w0.y), bfhi(w0.y)}; a1 = (f32x4){bflo(w0.z), bfhi(w0.z), bflo(w0.w), bfhi(w0.w)};
            a2 = (f32x4){bflo(w1.x), bfhi(w1.x), bflo(w1.y), bfhi(w1.y)}; a3 = (f32x4){bflo(w1.z), bfhi(w1.z), bflo(w1.w), bfhi(w1.w)}; }
#pragma unroll
        for (int b = 0; b < 5; ++b) { const float* sh = mods + b * NMODS + shslot * D + 16 * lane;
            const f32x4 p = a0 * *(const f32x4*)(sh) + a1 * *(const f32x4*)(sh + 4) + a2 * *(const f32x4*)(sh + 8) + a3 * *(const f32x4*)(sh + 12);
            const float sum = wave_sum((p.x + p.y) + (p.z + p.w)); if (lane == 0) shW[b * nrows + n] = sum; }
    }
}
DI void final_norm_phase(float* x, const float* gain, int gw, int NGW, int lane) {
    for (int row = gw; row < M; row += NGW) {
        float* xr = x + (size_t)row * D; f32x4 v[4]; float ss = 0.f;
#pragma unroll
        for (int j = 0; j < 4; ++j) { v[j] = *(const f32x4*)(xr + 4 * (64 * j + lane)); ss += (v[j].x * v[j].x + v[j].y * v[j].y) + (v[j].z * v[j].z + v[j].w * v[j].w); }
        const float rstd = 1.0f / sqrtf(wave_sum(ss) * (1.f / D) + EPS);
#pragma unroll
        for (int j = 0; j < 4; ++j) { const int c = 4 * (64 * j + lane); *(f32x4*)(xr + c) = v[j] * rstd * *(const f32x4*)(gain + c); }
    }
}
#define EPI_ARGS const f32x4 (&acc)[2][2][4][2], const Unit& u, int wr, int wc, int fr, int fq
DI v4u pack8(const f32x4& a, const f32x4& b) { v4u w; w.x = pk2(a.x, a.y); w.y = pk2(a.z, a.w); w.z = pk2(b.x, b.y); w.w = pk2(b.z, b.w); return w; }
DI void unpack8(const v4u& w, f32x4& a, f32x4& b) { a = (f32x4){bflo(w.x), bfhi(w.x), bflo(w.y), bfhi(w.y)}; b = (f32x4){bflo(w.z), bfhi(w.z), bflo(w.w), bfhi(w.w)}; }
DI f32x4 shx4(const f32x4& v, int m) { return (f32x4){__shfl_xor(v.x, m), __shfl_xor(v.y, m), __shfl_xor(v.z, m), __shfl_xor(v.w, m)}; }
DI void rope8(f32x4& v0, f32x4& v1, const float2* cs, int xm, float sgn) {
    const f32x4 p0 = shx4(v0, xm), p1 = shx4(v1, xm);
    const f32x4 t0 = *(const f32x4*)(cs), t1 = *(const f32x4*)(cs + 2), t2 = *(const f32x4*)(cs + 4), t3 = *(const f32x4*)(cs + 6);
    v0 = (f32x4){v0.x * t0.x + sgn * p0.x * t0.y, v0.y * t0.z + sgn * p0.y * t0.w, v0.z * t1.x + sgn * p0.z * t1.y, v0.w * t1.z + sgn * p0.w * t1.w};
    v1 = (f32x4){v1.x * t2.x + sgn * p1.x * t2.y, v1.y * t2.z + sgn * p1.y * t2.w, v1.z * t3.x + sgn * p1.z * t3.y, v1.w * t3.z + sgn * p1.w * t3.w};
}

template <bool NORM> struct EpiSwiglu { static constexpr bool PERM = true, AFTER_DRAIN = false; bf16* O; const float* ssq; const float* shW;
    DI void operator()(EPI_ARGS) const {
        asm volatile("" : "+v"(fr), "+v"(fq));
        const int row0 = u.pm * 256 + (u.half == 2 ? 128 : 0) + wr * 64 + fr, col0 = u.pn * 128 + wc * 32 + 8 * fq;
        f32x4 sw[2][2];
        if (NORM) { const float* sp = shW + mod_index(u.pm * 256) * NGU + u.pn * 256 + wc * 32 + 8 * fq;
#pragma unroll
            for (int bj = 0; bj < 2; ++bj)
#pragma unroll
                for (int n = 0; n < 2; ++n) sw[bj][n] = *(const f32x4*)(sp + bj * 128 + 4 * n); }
#pragma unroll
        for (int ai = 0; ai < 2; ++ai) { if (ai == 1 && u.half) break;
#pragma unroll
            for (int m = 0; m < 4; ++m) { f32x4 o[2]; const int row = row0 + ai * 128 + m * 16;
                float rs = 1.f; if (NORM) rs = 1.0f / sqrtf(ssq[row] * (1.f / D) + EPS);
#pragma unroll
                for (int n = 0; n < 2; ++n) { f32x4 g = acc[ai][0][m][n], uu = acc[ai][1][m][n];
                    if (NORM) { g = g * rs + sw[0][n]; uu = uu * rs + sw[1][n]; }
#pragma unroll
                    for (int j = 0; j < 4; ++j) o[n][j] = g[j] * sigm(g[j]) * uu[j]; }
                *(v4u*)(O + (size_t)row * FF + col0) = pack8(o[0], o[1]); } }
    }
};
DI f32x4 gsafe(const f32x4& g) { f32x4 r; for (int j = 0; j < 4; ++j) r[j] = fabsf(g[j]) < 1e-20f ? 1e-20f : g[j]; return r; }
template <bool NEXT, bool RECON, bool WRITE_X> struct EpiResid { static constexpr bool PERM = false, AFTER_DRAIN = false;
    const float* inA; const float* inB; const bf16* hin; const float* gain_prev; float* out; const float* mods; bf16* hn; const float* gain; float* ssq; int gslot; int scprev; int scslot; float coef;
    DI void operator()(EPI_ARGS) const {
        asm volatile("" : "+v"(fr), "+v"(fq));
        const int row0 = u.pm * 256 + wr * 64 + fr, col0 = u.pn * 256 + wc * 32 + 4 * fq;
        const float* mb = mods + mod_index(u.pm * 256) * NMODS; const float* gate = mb + gslot * D;
        f32x4 gv[2][2], gg[2][2], rg[2][2];
#pragma unroll
        for (int bj = 0; bj < 2; ++bj)
#pragma unroll
            for (int n = 0; n < 2; ++n) { const int c = col0 + bj * 128 + n * 16; gv[bj][n] = *(const f32x4*)(gate + c) * coef;
                if (NEXT) gg[bj][n] = gsafe(*(const f32x4*)(gain + c) * (*(const f32x4*)(mb + scslot * D + c) + 1.0f));
                if (RECON) { const f32x4 g = gsafe(*(const f32x4*)(gain_prev + c) * (*(const f32x4*)(mb + scprev * D + c) + 1.0f)); rg[bj][n] = (f32x4){1.0f / g.x, 1.0f / g.y, 1.0f / g.z, 1.0f / g.w}; } }
#pragma unroll
        for (int ai = 0; ai < 2; ++ai)
#pragma unroll
            for (int m = 0; m < 4; ++m) { const int row = row0 + ai * 128 + m * 16;
                const float* ip = row < MP ? inA + (size_t)row * D : inB + (size_t)(row - MP) * D; float s = 0.f;
#pragma unroll
                for (int bj = 0; bj < 2; ++bj)
#pragma unroll
                    for (int n = 0; n < 2; ++n) { const int c = col0 + bj * 128 + n * 16; f32x4 xin;
                        if (RECON) { const v2u w = *(const v2u*)(hin + (size_t)row * D + c); xin = (f32x4){bflo(w.x), bfhi(w.x), bflo(w.y), bfhi(w.y)} * rg[bj][n]; }
                        else xin = __builtin_nontemporal_load((const f32x4*)(ip + c));
                        const f32x4 x = xin + gv[bj][n] * acc[ai][bj][m][n];
                        if (WRITE_X) *(f32x4*)(out + (size_t)row * D + c) = x;
                        if (NEXT) { s += (x.x * x.x + x.y * x.y) + (x.z * x.z + x.w * x.w); const f32x4 y = x * gg[bj][n]; v2u w; w.x = pk2(y.x, y.y); w.y = pk2(y.z, y.w); *(v2u*)(hn + (size_t)row * D + c) = w; } }
                if (NEXT) { s += __shfl_xor(s, 16); s += __shfl_xor(s, 32); if (fq == 0) atomicAdd(ssq + row, s); } }
    }
};
struct EpiFinal { static constexpr bool PERM = false, AFTER_DRAIN = true; const bf16* hin; const float* gain_prev; float* out; const float* mods; const float* fgain; float* xbuf; unsigned* cnt; int gslot; int scprev; float coef;
    DI void operator()(EPI_ARGS) const {}
    DI void fused(f32x4 (&acc)[2][2][4][2], const Unit& u, int wr, int wc, int fr, int fq, LAS unsigned char* lds, int wid, int lane) const {
        const int tid = wid * 64 + lane;
        const int row0 = u.pm * 256 + wr * 64 + fr, col0 = u.pn * 256 + wc * 32 + 4 * fq;
        const float* gate = mods + mod_index(u.pm * 256) * NMODS + gslot * D;
        LAS float* P = (LAS float*)lds; LAS float* S = (LAS float*)(lds + 4096);
        f32x4 gv[2][2], rg[2][2]; const float* mb = mods + mod_index(u.pm * 256) * NMODS;
#pragma unroll
        for (int bj = 0; bj < 2; ++bj)
#pragma unroll
            for (int n = 0; n < 2; ++n) { const int c = col0 + bj * 128 + n * 16; gv[bj][n] = *(const f32x4*)(gate + c) * coef;
                const f32x4 g = gsafe(*(const f32x4*)(gain_prev + c) * (*(const f32x4*)(mb + scprev * D + c) + 1.0f)); rg[bj][n] = (f32x4){1.0f / g.x, 1.0f / g.y, 1.0f / g.z, 1.0f / g.w}; }
#pragma unroll
        for (int ai = 0; ai < 2; ++ai)
#pragma unroll
            for (int m = 0; m < 4; ++m) { const int row = row0 + ai * 128 + m * 16; const bf16* ip = hin + (size_t)row * D; float s = 0.f;
#pragma unroll
                for (int bj = 0; bj < 2; ++bj)
#pragma unroll
                    for (int n = 0; n < 2; ++n) { const v2u w = __builtin_nontemporal_load((const v2u*)(ip + col0 + bj * 128 + n * 16)); const f32x4 x = (f32x4){bflo(w.x), bfhi(w.x), bflo(w.y), bfhi(w.y)} * rg[bj][n] + gv[bj][n] * acc[ai][bj][m][n]; acc[ai][bj][m][n] = x; s += (x.x * x.x + x.y * x.y) + (x.z * x.z + x.w * x.w); }
                s += __shfl_xor(s, 16); s += __shfl_xor(s, 32);
                if (fq == 0) P[(ai * 128 + wr * 64 + m * 16 + fr) * 4 + wc] = s; }
        LDS_WAIT(); __syncthreads();
        if (tid < 256) { const f32x4 p = *(const LAS f32x4*)(P + tid * 4);
            __hip_atomic_store(xbuf + (size_t)(u.pm * 256 + tid) * 4 + u.pn, (p.x + p.y) + (p.z + p.w), __ATOMIC_RELAXED, __HIP_MEMORY_SCOPE_AGENT);
            asm volatile("s_waitcnt vmcnt(0)" ::: "memory");
            if (lane == 0) __hip_atomic_fetch_add(cnt + 64 * u.pm, 1u, __ATOMIC_RELAXED, __HIP_MEMORY_SCOPE_AGENT); }
        if (wid == 0) { unsigned sp = 0;
            while ((unsigned)__builtin_amdgcn_readfirstlane(__hip_atomic_load(cnt + 64 * u.pm, __ATOMIC_RELAXED, __HIP_MEMORY_SCOPE_AGENT)) < 16u) { __builtin_amdgcn_s_sleep(2); if (++sp > (1u << 22)) break; }
            __builtin_amdgcn_fence(__ATOMIC_ACQUIRE, "agent"); }
        asm volatile("s_waitcnt vmcnt(0) lgkmcnt(0)" ::: "memory"); __syncthreads();
        if (tid < 256) { const float* xp = xbuf + (size_t)(u.pm * 256 + tid) * 4; float t = 0.f;
#pragma unroll
            for (int q = 0; q < 4; ++q) t += __hip_atomic_load(xp + q, __ATOMIC_RELAXED, __HIP_MEMORY_SCOPE_AGENT);
            S[tid] = 1.0f / sqrtf(t * (1.f / D) + EPS); }
        LDS_WAIT(); __syncthreads();
        f32x4 fg[2][2];
#pragma unroll
        for (int bj = 0; bj < 2; ++bj)
#pragma unroll
            for (int n = 0; n < 2; ++n) fg[bj][n] = *(const f32x4*)(fgain + col0 + bj * 128 + n * 16);
#pragma unroll
        for (int ai = 0; ai < 2; ++ai)
#pragma unroll
            for (int m = 0; m < 4; ++m) { const int rl = ai * 128 + wr * 64 + m * 16 + fr; const float rs = S[rl]; float* op = out + (size_t)(u.pm * 256 + rl) * D;
#pragma unroll
                for (int bj = 0; bj < 2; ++bj)
#pragma unroll
                    for (int n = 0; n < 2; ++n) __builtin_nontemporal_store(acc[ai][bj][m][n] * rs * fg[bj][n], (f32x4*)(op + col0 + bj * 128 + n * 16)); }
    }
};
struct EpiWin { static constexpr bool PERM = true, AFTER_DRAIN = false;
    bf16 *qa, *ka, *vaT, *qlat, *ckv, *ga, *gb, *krope; float *ssq_q, *ssq_kv; float* out; const float2* ropeA; const float2* ropeB; bool do_ssq; const float* ssq1; const float* shW;
    DI void operator()(EPI_ARGS) const {
        asm volatile("" : "+v"(fr), "+v"(fq));
        const int pn = u.pn; const bool sample = u.pm >= 32;
        const int rbase = u.pm * 256 + (u.half == 2 ? 128 : 0) + wr * 64 + fr;
        f32x4 sw[2][2]; { const float* sp = shW + mod_index(u.pm * 256) * NINP + pn * 256 + wc * 32 + 8 * fq;
#pragma unroll
            for (int bj = 0; bj < 2; ++bj)
#pragma unroll
                for (int n = 0; n < 2; ++n) sw[bj][n] = *(const f32x4*)(sp + bj * 128 + 4 * n); }
#define WACC(ai, bj, m, n) (acc[ai][bj][m][n] * rs + sw[bj][n])
        if (pn < 3) {
#pragma unroll
            for (int ai = 0; ai < 2; ++ai) { if (ai == 1 && u.half) break;
#pragma unroll
                for (int m = 0; m < 4; ++m) { const int row = rbase + ai * 128 + m * 16; const float rs = 1.0f / sqrtf(ssq1[row] * (1.f / D) + EPS); const int t = (row - MP) & 2047; const int pos = (wc & 1) ? (t & 63) : (t >> 6);
                    const float2* cs = ropeA + pos * 16 + 8 * (fq & 1); const float sgn = (fq & 2) ? 1.f : -1.f;
#pragma unroll
                    for (int bj = 0; bj < 2; ++bj) { f32x4 v0 = WACC(ai, bj, m, 0), v1 = WACC(ai, bj, m, 1); const int cl = bj * 128 + wc * 32 + 8 * fq;
                        if (pn < 2) { if (sample) rope8(v0, v1, cs, 32, sgn); v0 = v0 * A_QS; v1 = v1 * A_QS; *(v4u*)(qa + (size_t)row * 512 + pn * 256 + cl) = pack8(v0, v1); }
                        else if (bj == 0) { if (sample) rope8(v0, v1, cs, 32, sgn); *(v4u*)(ka + (size_t)row * 128 + cl) = pack8(v0, v1);
                            if (!sample) { float* o = out + OUT_K + (size_t)row * 128 + cl; __builtin_nontemporal_store(v0, (f32x4*)o); __builtin_nontemporal_store(v1, (f32x4*)(o + 4)); } }
                        else { const int c = cl - 128;
#pragma unroll
                            for (int j = 0; j < 4; ++j) { vaT[(size_t)(c + j) * MALL + row] = (bf16)f2bf(v0[j]); vaT[(size_t)(c + 4 + j) * MALL + row] = (bf16)f2bf(v1[j]); }
                            if (!sample) { float* o = out + OUT_V + (size_t)row * 128 + c; __builtin_nontemporal_store(v0, (f32x4*)o); __builtin_nontemporal_store(v1, (f32x4*)(o + 4)); } } } } }
        } else if (pn < 5) {
            bf16* dst = pn == 3 ? qlat : ckv; float* ssq = pn == 3 ? ssq_q : ssq_kv;
#pragma unroll
            for (int ai = 0; ai < 2; ++ai) { if (ai == 1 && u.half) break;
#pragma unroll
                for (int m = 0; m < 4; ++m) { const int row = rbase + ai * 128 + m * 16; const float rs = 1.0f / sqrtf(ssq1[row] * (1.f / D) + EPS); float s = 0.f;
#pragma unroll
                    for (int bj = 0; bj < 2; ++bj) { const f32x4 v0 = WACC(ai, bj, m, 0), v1 = WACC(ai, bj, m, 1);
                        s += (v0.x * v0.x + v0.y * v0.y) + (v0.z * v0.z + v0.w * v0.w) + (v1.x * v1.x + v1.y * v1.y) + (v1.z * v1.z + v1.w * v1.w);
                        *(v4u*)(dst + (size_t)row * 256 + bj * 128 + wc * 32 + 8 * fq) = pack8(v0, v1); }
                    s += __shfl_xor(s, 16); s += __shfl_xor(s, 32);
                    if (fq == 0 && do_ssq) atomicAdd(ssq + row, s); } }
        } else if (pn < 13) {
            const int ct = (pn - 5) * 128 + wc * 32 + 8 * fq;
#pragma unroll
            for (int ai = 0; ai < 2; ++ai) { if (ai == 1 && u.half) break;
#pragma unroll
                for (int m = 0; m < 4; ++m) { const int row = rbase + ai * 128 + m * 16; const float rs = 1.0f / sqrtf(ssq1[row] * (1.f / D) + EPS);
                    f32x4 r0, r1, b0, b1;
                    { const f32x4 a0 = WACC(ai, 0, m, 0), a1 = WACC(ai, 0, m, 1), c0 = WACC(ai, 1, m, 0), c1 = WACC(ai, 1, m, 1);
#pragma unroll
                      for (int j = 0; j < 4; ++j) { b0[j] = sigm(c0[j]); b1[j] = sigm(c1[j]); r0[j] = sigm(a0[j]) * frcp(fmaxf(b0[j], 1e-30f)); r1[j] = sigm(a1[j]) * frcp(fmaxf(b1[j], 1e-30f)); } }
                    *(v4u*)(ga + (size_t)row * D + ct) = pack8(r0, r1); *(v4u*)(gb + (size_t)row * D + ct) = pack8(b0, b1); } }
        } else if (wc == 0) {
#pragma unroll
            for (int ai = 0; ai < 2; ++ai) { if (ai == 1 && u.half) break;
#pragma unroll
                for (int m = 0; m < 4; ++m) { const int row = rbase + ai * 128 + m * 16; const float rs = 1.0f / sqrtf(ssq1[row] * (1.f / D) + EPS); const int t = (row - MP) & 2047; const int pos = (fq & 2) ? (t & 63) : (t >> 6);
                    f32x4 v0 = WACC(ai, 0, m, 0), v1 = WACC(ai, 0, m, 1);
                    if (sample) rope8(v0, v1, ropeB + pos * 8, 16, (fq & 1) ? 1.f : -1.f);
                    *(v4u*)(krope + (size_t)row * 32 + 8 * fq) = pack8(v0, v1);
                    if (!sample) { float* o = out + OUT_KR + (size_t)row * 32 + 8 * fq; __builtin_nontemporal_store(v0, (f32x4*)o); __builtin_nontemporal_store(v1, (f32x4*)(o + 4)); } } }
        }
    }
};
#undef WACC
struct EpiQB { static constexpr bool PERM = true, AFTER_DRAIN = false; bf16* qb; const float* ssq; const float2* ropeB;
    DI void operator()(EPI_ARGS) const {
        asm volatile("" : "+v"(fr), "+v"(fq));
        const int rbase = u.pm * 256 + wr * 64 + fr; const bool sample = u.pm >= 32;
#pragma unroll
        for (int ai = 0; ai < 2; ++ai)
#pragma unroll
            for (int m = 0; m < 4; ++m) { const int row = rbase + ai * 128 + m * 16; const float rs = 1.0f / sqrtf(ssq[row] * (1.f / 256.f) + EPS);
                const int t = (row - MP) & 2047; const int pos = (fq & 2) ? (t & 63) : (t >> 6);
#pragma unroll
                for (int bj = 0; bj < 2; ++bj) { f32x4 v0 = acc[ai][bj][m][0] * rs, v1 = acc[ai][bj][m][1] * rs;
                    if (u.pn == 2 && sample) rope8(v0, v1, ropeB + pos * 8, 16, (fq & 1) ? 1.f : -1.f);
                    *(v4u*)(qb + (size_t)row * 768 + u.pn * 256 + bj * 128 + wc * 32 + 8 * fq) = pack8(v0, v1); } }
    }
};
struct EpiKN { static constexpr bool PERM = true, AFTER_DRAIN = false; bf16* kn; const float* ssq;
    DI void operator()(EPI_ARGS) const {
        asm volatile("" : "+v"(fr), "+v"(fq));
        const int rbase = u.pm * 256 + wr * 64 + fr; const bool lat = u.pm < 64;
#pragma unroll
        for (int ai = 0; ai < 2; ++ai)
#pragma unroll
            for (int m = 0; m < 4; ++m) { const int row = rbase + ai * 128 + m * 16; const float rs = lat ? 1.0f / sqrtf(ssq[row] * (1.f / 256.f) + EPS) : 1.0f;
#pragma unroll
                for (int bj = 0; bj < 2; ++bj) *(v4u*)(kn + (size_t)row * 512 + u.pn * 256 + bj * 128 + wc * 32 + 8 * fq) = pack8(acc[ai][bj][m][0] * rs, acc[ai][bj][m][1] * rs); }
    }
};
struct EpiVT { static constexpr bool PERM = true, AFTER_DRAIN = false; bf16* vt; const float* ssq;
    DI void operator()(EPI_ARGS) const {
        asm volatile("" : "+v"(fr), "+v"(fq));
        const int rbase = u.pm * 256 + wr * 64 + fr; const bool lat = u.pn < 64;
        f32x4 rs[2][2];
#pragma unroll
        for (int bj = 0; bj < 2; ++bj)
#pragma unroll
            for (int n = 0; n < 2; ++n) { const int c = u.pn * 256 + bj * 128 + wc * 32 + 8 * fq + 4 * n;
                if (lat) { const f32x4 q = *(const f32x4*)(ssq + c); rs[bj][n] = (f32x4){1.0f / sqrtf(q.x * (1.f / 256.f) + EPS), 1.0f / sqrtf(q.y * (1.f / 256.f) + EPS), 1.0f / sqrtf(q.z * (1.f / 256.f) + EPS), 1.0f / sqrtf(q.w * (1.f / 256.f) + EPS)}; }
                else rs[bj][n] = (f32x4){1.f, 1.f, 1.f, 1.f}; }
#pragma unroll
        for (int ai = 0; ai < 2; ++ai)
#pragma unroll
            for (int m = 0; m < 4; ++m) { const int row = rbase + ai * 128 + m * 16;
#pragma unroll
                for (int bj = 0; bj < 2; ++bj) *(v4u*)(vt + (size_t)row * MALL + u.pn * 256 + bj * 128 + wc * 32 + 8 * fq) = pack8(acc[ai][bj][m][0] * rs[bj][0], acc[ai][bj][m][1] * rs[bj][1]); }
    }
};
template <bool SECOND> struct EpiMerge { static constexpr bool PERM = true, AFTER_DRAIN = false; bf16* mm; const bf16* g;
    DI void operator()(EPI_ARGS) const {
        asm volatile("" : "+v"(fr), "+v"(fq));
        const int rbase = u.pm * 256 + wr * 64 + fr;
#pragma unroll
        for (int ai = 0; ai < 2; ++ai)
#pragma unroll
            for (int m = 0; m < 4; ++m) { const int row = rbase + ai * 128 + m * 16;
#pragma unroll
                for (int bj = 0; bj < 2; ++bj) { const size_t o = (size_t)row * D + u.pn * 256 + bj * 128 + wc * 32 + 8 * fq;
                    f32x4 g0, g1; unpack8(*(const v4u*)(g + o), g0, g1); f32x4 v0 = acc[ai][bj][m][0] * g0, v1 = acc[ai][bj][m][1] * g1;
                    if (SECOND) { f32x4 p0, p1; unpack8(*(const v4u*)(mm + o), p0, p1); v0 += p0; v1 += p1; }
                    *(v4u*)(mm + o) = pack8(v0, v1); } }
    }
};

struct EpiMergeK { static constexpr bool PERM = true, AFTER_DRAIN = false, MIDK = true; bf16* mm; const bf16* ga; const bf16* gb;
    DI void mid(f32x4 (&acc)[2][2][4][2], const Unit& u, int wr, int wc, int fr, int fq) const {
        asm volatile("" : "+v"(fr), "+v"(fq));
        const int rbase = u.pm * 256 + wr * 64 + fr;
#pragma unroll
        for (int ai = 0; ai < 2; ++ai)
#pragma unroll
            for (int m = 0; m < 4; ++m) { const int row = rbase + ai * 128 + m * 16;
#pragma unroll
                for (int bj = 0; bj < 2; ++bj) { const size_t o = (size_t)row * D + u.pn * 256 + bj * 128 + wc * 32 + 8 * fq;
                    f32x4 a0, a1; unpack8(__builtin_nontemporal_load((const v4u*)(ga + o)), a0, a1);
                    acc[ai][bj][m][0] = acc[ai][bj][m][0] * a0; acc[ai][bj][m][1] = acc[ai][bj][m][1] * a1; } }
    }
    DI void operator()(EPI_ARGS) const {
        asm volatile("" : "+v"(fr), "+v"(fq));
        const int rbase = u.pm * 256 + wr * 64 + fr;
#pragma unroll
        for (int ai = 0; ai < 2; ++ai)
#pragma unroll
            for (int m = 0; m < 4; ++m) { const int row = rbase + ai * 128 + m * 16;
#pragma unroll
                for (int bj = 0; bj < 2; ++bj) { const size_t o = (size_t)row * D + u.pn * 256 + bj * 128 + wc * 32 + 8 * fq;
                    f32x4 b0, b1; unpack8(__builtin_nontemporal_load((const v4u*)(gb + o)), b0, b1);
                    *(v4u*)(mm + o) = pack8(acc[ai][bj][m][0] * b0, acc[ai][bj][m][1] * b1); } }
    }
};
static_assert(pg8::MidK<EpiMergeK>::value && !pg8::MidK<EpiWin>::value, "mid-K hook trait");
#define MFMA32(a, b, c) __builtin_amdgcn_mfma_f32_32x32x16_bf16((a), (b), (c), 0, 0, 0)
#ifndef ATT_RS
#define ATT_RS 16.0f
#endif
template <int DQ>
DI void attn_unit(LAS unsigned char* lds, int tid, int lane,
                  const bf16* qn, int ldqn, const bf16* qr, int ldqr,
                  const bf16* Kb, int ldk, const bf16* Kr, const bf16* Vt,
                  int s0_tok, int s0_n, int s1_tok, int s1_n, bool band, int qtok,
                  float sink_l2, bool has_sink, bf16* outp, int ldo) {
    constexpr int KS = DQ * 2 + 16, VS = 144, BUF = 64 * KS + 64 * VS, NKS = DQ / 16;
    const int r = lane & 31, hh = lane >> 5;
    const int pr = (r & ~12) | ((r & 4) << 1) | ((r & 8) >> 1);
    bf16x8 qf[NKS];
#pragma unroll
    for (int ks = 0; ks < NKS; ++ks) qf[ks] = ks < 4 ? __builtin_nontemporal_load((const bf16x8*)(qn + (size_t)r * ldqn + 16 * ks + 8 * hh)) : __builtin_nontemporal_load((const bf16x8*)(qr + (size_t)r * ldqr + 16 * (ks - 4) + 8 * hh));
    f32x16 ot[2];
#pragma unroll
    for (int i = 0; i < 16; ++i) { ot[0][i] = 0.f; ot[1][i] = 0.f; }
    float mrun = 0.f; f32x16 lacc;
#pragma unroll
    for (int i = 0; i < 16; ++i) lacc[i] = 0.f;
    const int ntile = s0_n + s1_n;
    const int krow = tid >> 3, kch = tid & 7, rrow = tid >> 2, rch = tid & 3;
    v4u kreg, rreg, vreg;
    auto tile_tok = [&](int t) { return t < s0_n ? s0_tok + 64 * t : s1_tok + 64 * (t - s0_n); };
    auto gload = [&](int t) { const int tok0 = tile_tok(t);
        kreg = *(const v4u*)(Kb + (size_t)(tok0 + krow) * ldk + kch * 8);
        if (DQ == 96) { if (tid < 256) rreg = *(const v4u*)(Kr + (size_t)(tok0 + rrow) * 32 + rch * 8); }
        vreg = *(const v4u*)(Vt + (size_t)krow * MALL + tok0 + kch * 8); };
    auto lstore = [&](int b) { LAS unsigned char* kb_ = lds + b * BUF;
        *(LAS v4u*)(kb_ + krow * KS + kch * 16) = kreg;
        if (DQ == 96) { if (tid < 256) *(LAS v4u*)(kb_ + rrow * KS + 128 + rch * 16) = rreg; }
        *(LAS v4u*)(kb_ + 64 * KS + krow * VS + kch * 16) = vreg; };
    gload(0); lstore(0); __syncthreads();
    for (int t = 0; t < ntile; ++t) {
        const bool more = t + 1 < ntile;
        if (more) gload(t + 1);
        LAS unsigned char* kb_ = lds + (t & 1) * BUF; LAS unsigned char* vb_ = kb_ + 64 * KS;
        f32x16 st[2];
#pragma unroll
        for (int kb = 0; kb < 2; ++kb) {
#pragma unroll
            for (int i = 0; i < 16; ++i) st[kb][i] = 0.f;
#pragma unroll
            for (int ks = 0; ks < NKS; ++ks) { const bf16x8 kf = *(const LAS bf16x8*)(kb_ + (32 * kb + pr) * KS + (16 * ks + 8 * hh) * 2); st[kb] = MFMA32(kf, qf[ks], st[kb]); }
        }
        __builtin_amdgcn_sched_barrier(0);
        if (band && t < s0_n) { const int d0 = tile_tok(t) + 8 * hh - (qtok + r);
#pragma unroll
            for (int kb = 0; kb < 2; ++kb)
#pragma unroll
                for (int i = 0; i < 16; ++i) { const int d = d0 + 32 * kb + 16 * (i >> 3) + (i & 7); if (d > 128 || d < -128) st[kb][i] = -1e30f; } }
        float mx;
        { const f32x16& A = st[0]; const f32x16& B = st[1];
          float m0 = fmaxf(fmaxf(A[0], A[1]), A[2]), m1 = fmaxf(fmaxf(A[3], A[4]), A[5]), m2 = fmaxf(fmaxf(A[6], A[7]), A[8]), m3 = fmaxf(fmaxf(A[9], A[10]), A[11]);
          m0 = fmaxf(fmaxf(m0, A[12]), A[13]); m1 = fmaxf(fmaxf(m1, A[14]), A[15]); m2 = fmaxf(fmaxf(m2, B[0]), B[1]); m3 = fmaxf(fmaxf(m3, B[2]), B[3]);
          m0 = fmaxf(fmaxf(m0, B[4]), B[5]); m1 = fmaxf(fmaxf(m1, B[6]), B[7]); m2 = fmaxf(fmaxf(m2, B[8]), B[9]); m3 = fmaxf(fmaxf(m3, B[10]), B[11]);
          m0 = fmaxf(fmaxf(m0, B[12]), B[13]); m1 = fmaxf(fmaxf(m1, B[14]), B[15]); mx = fmaxf(fmaxf(m0, m1), fmaxf(m2, m3)); }
        mx = fmaxf(mx, __shfl_xor(mx, 32));
        { const bool up = mx > mrun + ATT_RS, dn = (t == 0) && (mx < mrun - ATT_RS);
          if (__builtin_amdgcn_ballot_w64(up || dn) != 0ull) {
              if (t == 0) { mrun = (up || dn) ? mx : mrun; }
              else { const float mnew = up ? mx : mrun, alpha = fexp2(mrun - mnew); mrun = mnew; lacc = lacc * alpha; ot[0] = ot[0] * alpha; ot[1] = ot[1] * alpha; } } }
        if (__builtin_amdgcn_ballot_w64(mrun != 0.f) != 0ull) { st[0] = st[0] - mrun; st[1] = st[1] - mrun; }
#pragma unroll
        for (int kb = 0; kb < 2; ++kb)
#pragma unroll
            for (int i = 0; i < 16; ++i) st[kb][i] = fexp2(st[kb][i]);
        lacc = lacc + (st[0] + st[1]);
#pragma unroll
        for (int kb = 0; kb < 2; ++kb)
#pragma unroll
            for (int s = 0; s < 2; ++s) { v4u pw; pw.x = pk2(st[kb][8 * s], st[kb][8 * s + 1]); pw.y = pk2(st[kb][8 * s + 2], st[kb][8 * s + 3]); pw.z = pk2(st[kb][8 * s + 4], st[kb][8 * s + 5]); pw.w = pk2(st[kb][8 * s + 6], st[kb][8 * s + 7]);
                const bf16x8 pf = __builtin_bit_cast(bf16x8, pw);
#pragma unroll
                for (int db = 0; db < 2; ++db) { const bf16x8 vf = *(const LAS bf16x8*)(vb_ + (32 * db + r) * VS + (32 * kb + 16 * s + 8 * hh) * 2); ot[db] = MFMA32(vf, pf, ot[db]); } }
        __builtin_amdgcn_sched_barrier(0);
        if (more) lstore((t + 1) & 1);
        __syncthreads();
    }
    float lrun = ((lacc[0] + lacc[1]) + (lacc[2] + lacc[3])) + ((lacc[4] + lacc[5]) + (lacc[6] + lacc[7])) + (((lacc[8] + lacc[9]) + (lacc[10] + lacc[11])) + ((lacc[12] + lacc[13]) + (lacc[14] + lacc[15])));
    if (has_sink && hh == 0) lrun += fexp2(sink_l2 - mrun);
    const float inv = 1.0f / (lrun + __shfl_xor(lrun, 32));
#pragma unroll
    for (int db = 0; db < 2; ++db)
#pragma unroll
        for (int a4 = 0; a4 < 4; ++a4) { v2u w; w.x = pk2(ot[db][4 * a4] * inv, ot[db][4 * a4 + 1] * inv); w.y = pk2(ot[db][4 * a4 + 2] * inv, ot[db][4 * a4 + 3] * inv);
            *(v2u*)(outp + (size_t)r * ldo + 32 * db + 8 * a4 + 4 * hh) = w; }
}

DI void attn_phase(const Args& a, LAS unsigned char* lds, int tid, int wave, int lane) {
    unsigned char* ws = a.ws;
    const bf16* qa = (const bf16*)(ws + OFF_QA); const bf16* ka = (const bf16*)(ws + OFF_KA); const bf16* vaT = (const bf16*)(ws + OFF_VAT);
    const bf16* qb = (const bf16*)(ws + OFF_QB); const bf16* kn = (const bf16*)(ws + OFF_KN); const bf16* kr = (const bf16*)(ws + OFF_KROPE); const bf16* vbT = (const bf16*)(ws + OFF_VBT);
    bf16* oa = (bf16*)a.out; bf16* ob = oa + 512;
    const float* sink = a.in[15];
    for (int uu = blockIdx.x; uu < 1024; uu += gridDim.x) {
        const int type = uu >> 8, u0 = uu & 255, vu = (u0 & 7) * 32 + (u0 >> 3);
        if (type == 0) {
            const int b = vu >> 6, h = (vu >> 3) & 7, qblk = vu & 7; const int tok = MP + b * 2048 + qblk * 256 + 32 * wave;
            attn_unit<96>(lds, tid, lane, qb + (size_t)tok * 768 + h * 64, 768, qb + (size_t)tok * 768 + 512 + h * 32, 768, kn + h * 64, 512, kr, vbT + (size_t)(h * 64) * MALL,
                          M + b * 512, 8, MP + b * 2048, 32, false, 0, 0.f, false, ob + (size_t)tok * 1024 + h * 64, 1024);
        } else if (type == 1) {
            const int b = vu >> 6, kh = (vu >> 5) & 1, qblk = vu & 31; const int head = kh * 4 + (wave >> 1); const int tok = MP + b * 2048 + qblk * 64 + 32 * (wave & 1);
            const int lo = qblk - 2 < 0 ? 0 : qblk - 2, hi = qblk + 2 > 31 ? 31 : qblk + 2;
            attn_unit<64>(lds, tid, lane, qa + (size_t)tok * 512 + head * 64, 512, nullptr, 0, ka + kh * 64, 128, nullptr, vaT + (size_t)(kh * 64) * MALL,
                          MP + b * 2048 + lo * 64, hi - lo + 1, M + b * 512, 8, true, tok, sink[head] * LOG2E, true, oa + (size_t)tok * 1024 + head * 64, 1024);
        } else if (type == 2) {
            const int b = vu >> 3, kh = (vu >> 2) & 1, qblk = vu & 3; const int head = kh * 4 + (wave >> 1); const int tok = b * 256 + qblk * 64 + 32 * (wave & 1);
            attn_unit<64>(lds, tid, lane, qa + (size_t)tok * 512 + head * 64, 512, nullptr, 0, ka + kh * 64, 128, nullptr, vaT + (size_t)(kh * 64) * MALL,
                          b * 256, 4, 0, 0, false, 0, sink[head] * LOG2E, true, oa + (size_t)tok * 1024 + head * 64, 1024);
        } else {
            const int b = vu >> 3, h = vu & 7; const int tok = b * 256 + 32 * wave;
            attn_unit<96>(lds, tid, lane, qb + (size_t)tok * 768 + h * 64, 768, qb + (size_t)tok * 768 + 512 + h * 32, 768, kn + h * 64, 512, kr, vbT + (size_t)(h * 64) * MALL,
                          b * 256, 4, 0, 0, false, 0, 0.f, false, ob + (size_t)tok * 1024 + h * 64, 1024);
        }
    }
}

__global__ void __launch_bounds__(512, 2) mk_fwd(Args a) {
    extern __shared__ __attribute__((aligned(16))) unsigned char lds_raw[];
    LAS unsigned char* lds = (LAS unsigned char*)lds_raw;
    cg::grid_group grid = cg::this_grid();
    const int tid = threadIdx.x, lane = tid & 63, wave = __builtin_amdgcn_readfirstlane(tid >> 6);
    const int G = gridDim.x, gw = blockIdx.x * 8 + wave, NGW = G * 8, gtid = blockIdx.x * 512 + tid, NT = G * 512;
    unsigned char* ws = a.ws;
    float* mods = (float*)(ws + OFF_MODS); float* ssq_q = (float*)(ws + OFF_SSQQ); float* ssq_kv = (float*)(ws + OFF_SSQKV);
    const float2* ropeA = (const float2*)(ws + OFF_ROPEA); const float2* ropeB = (const float2*)(ws + OFF_ROPEB);
    bf16* H = (bf16*)(ws + OFF_H); bf16* ACT = (bf16*)(ws + OFF_ACT);
    float* xr = a.out;
    const int lo = a.ph_lo, hi = a.ph_hi;
#if defined(TSK)
    const unsigned long long ts_start = __builtin_amdgcn_s_memrealtime(); unsigned long long ts_k = 0;
#endif
    if (hi > 1000) grid.sync();
    volatile LAS unsigned* xst = (volatile LAS unsigned*)(lds + 131072);
    if (tid < 2) xst[tid] = 0u;
    __syncthreads();
    XcdBarrier xbar = xcd_barrier_post((unsigned*)(ws + OFF_BAR), xst);
#ifndef P6M
#define P6M 7
#endif
#ifndef PH_MASK
#define PH_MASK 0x3fff
#endif
#define IN(k) (((PH_MASK >> (k)) & 1) && lo <= (k) && (k) < hi)
#define INX(k) (IN(k) || (k) == 4 || (k) == 10)
#if defined(TSK)
#define SEAM(k) do { if (IN(k) && INX((k) + 1)) xcd_barrier(xbar); if ((k) == TSK) ts_k = __builtin_amdgcn_s_memrealtime(); } while (0)
#else
#define SEAM(k) do { if (IN(k) && INX((k) + 1)) xcd_barrier(xbar); } while (0)
#endif
    if (IN(0)) { p0_misc(a, gtid, NT); p0_ada(a, lds, tid); }
    SEAM(0);
    float* ssq1 = (float*)(ws + OFF_SSQ1); float* ssq2 = (float*)(ws + OFF_SSQ2); float* shW2 = (float*)(ws + OFF_SHW2); float* shW3 = (float*)(ws + OFF_SHW3);
    if (IN(1)) { norm_mod_phase(a.in[0], a.in[1], a.in[10], mods, 0, H, gw, NGW, lane); p0_weights(a, lds, gw, NGW, wave, lane, 0, P0_EARLY); }
    SEAM(1);
    if (IN(2)) { pg8::Gemm g{H, (const bf16*)(ws + OFF_WGU1), M, NGU, D}; pg8::StaticOrder S; S.init(M, NGU, G, (int)blockIdx.x); EpiSwiglu<false> E{ACT, nullptr, nullptr};
        pg8::gemm_phase<EpiSwiglu<false>, pg8::StaticOrder, PG8_ALIGN, PG8_SP2>(lds, g, S, E);
        { const int nwg = (M / 256) * (NGU / 256), rounds = (nwg + G - 1) / G, first_idle = nwg - (rounds - 1) * G;
          const int nidle = G - first_idle;
          if (nidle <= 0) { shw_phase((const bf16*)(ws + OFF_WIN), NINP, mods, 3, shW2, gw, NGW, lane); p0_weights(a, lds, gw, NGW, wave, lane, P0_EARLY, P0_NIT); }
          else if ((int)blockIdx.x >= first_idle) { const int gw2 = ((int)blockIdx.x - first_idle) * 8 + wave, NGW2 = nidle * 8;
              shw_phase((const bf16*)(ws + OFF_WIN), NINP, mods, 3, shW2, gw2, NGW2, lane);
              p0_weights(a, lds, gw2, NGW2, wave, lane, P0_EARLY, P0_NIT); } } }
    SEAM(2);
    if (IN(3)) { pg8::Gemm g{ACT, (const bf16*)(ws + OFF_WD1), M, D, FF}; pg8::StaticOrder S; S.init(M, D, G, (int)blockIdx.x); EpiResid<true, false, false> E{a.in[0], a.in[1], nullptr, nullptr, nullptr, mods, H, a.in[13], ssq1, 2, 0, 4, 0.5f};
        pg8::gemm_phase<EpiResid<true, false, false>, pg8::StaticOrder, PG8_ALIGN, PG8_SP2>(lds, g, S, E); }
    SEAM(3);
    if (IN(5)) { pg8::Gemm g{H, (const bf16*)(ws + OFF_WIN), M, NINP, D}; pg8::StaticOrder S; S.init(M, NINP, G, (int)blockIdx.x);
        EpiWin E{(bf16*)(ws + OFF_QA), (bf16*)(ws + OFF_KA), (bf16*)(ws + OFF_VAT), (bf16*)(ws + OFF_QLAT), (bf16*)(ws + OFF_CKV), (bf16*)(ws + OFF_GA), (bf16*)(ws + OFF_GB), (bf16*)(ws + OFF_KROPE),
                 ssq_q, ssq_kv, a.out, ropeA, ropeB, true, ssq1, shW2};
        pg8::gemm_phase<EpiWin, pg8::StaticOrder, PG8_ALIGN, PG8_SP2>(lds, g, S, E);
        { const int nwg = (M / 256) * (NINP / 256), rounds = (nwg + G - 1) / G, first_idle = nwg - (rounds - 1) * G, nidle = G - first_idle;
          if (nidle <= 0) { ctx_convert(a, gtid, NT); shw_phase((const bf16*)(ws + OFF_WGU2), NGU, mods, 6, shW3, gw, NGW, lane); }
          else if ((int)blockIdx.x >= first_idle) { ctx_convert(a, ((int)blockIdx.x - first_idle) * 512 + tid, nidle * 512);
              shw_phase((const bf16*)(ws + OFF_WGU2), NGU, mods, 6, shW3, ((int)blockIdx.x - first_idle) * 8 + wave, nidle * 8, lane); } }
#if defined(DUP5)
        xcd_barrier(xbar); E.do_ssq = false; pg8::gemm_phase<EpiWin, pg8::StaticOrder, PG8_ALIGN, PG8_SP2>(lds, g, S, E);
#endif
    }
    SEAM(5);
#if defined(DUP6)
    for (int rep6 = 0; rep6 < 2; ++rep6) { if (rep6) xcd_barrier(xbar);
#endif
    if (IN(6)) {
        int K6 = 256; asm volatile("" : "+s"(K6));
#if P6M & 1
        { pg8::Gemm g{(const bf16*)(ws + OFF_QLAT), (const bf16*)(ws + OFF_WUQ), M, 768, K6}; pg8::StaticOrder S; S.init(M, 768, G, (int)blockIdx.x); EpiQB E{(bf16*)(ws + OFF_QB), ssq_q, ropeB};
          pg8::gemm_phase<EpiQB, pg8::StaticOrder, PG8_ALIGN, PG8_SP2>(lds, g, S, E); }
#endif
#if P6M & 2
        { pg8::Gemm g{(const bf16*)(ws + OFF_CKV), (const bf16*)(ws + OFF_WK), MALL, 512, K6}; pg8::StaticOrder S; S.init(MALL, 512, G, (int)((blockIdx.x + 64) % G)); EpiKN E{(bf16*)(ws + OFF_KN), ssq_kv};
          pg8::gemm_phase<EpiKN, pg8::StaticOrder, PG8_ALIGN, PG8_SP2>(lds, g, S, E); }
#endif
#if P6M & 4
        { pg8::Gemm g{(const bf16*)(ws + OFF_WV), (const bf16*)(ws + OFF_CKV), 512, MALL, K6}; pg8::StaticOrder S; S.init(512, MALL, G, (int)((blockIdx.x + 176) % G)); EpiVT E{(bf16*)(ws + OFF_VBT), ssq_kv};
          pg8::gemm_phase<EpiVT, pg8::StaticOrder, PG8_ALIGN, PG8_SP2>(lds, g, S, E); }
#endif
        { const bf16* ckv = (const bf16*)(ws + OFF_CKV); const float* gn = a.in[17]; float* o = a.out + OUT_CKV;
          for (int row = gw; row < MP; row += NGW) { const float rs = 1.0f / sqrtf(ssq_kv[row] * (1.f / 256.f) + EPS); const v2u w = *(const v2u*)(ckv + (size_t)row * 256 + 4 * lane); const f32x4 g4 = *(const f32x4*)(gn + 4 * lane);
              __builtin_nontemporal_store((f32x4){bflo(w.x), bfhi(w.x), bflo(w.y), bfhi(w.y)} * rs * g4, (f32x4*)(o + (size_t)row * 256 + 4 * lane)); } }
    }
#if defined(DUP6)
    }
#endif
    SEAM(6);
    if (IN(7)) attn_phase(a, lds, tid, wave, lane);
#if defined(DUP7)
    xcd_barrier(xbar); attn_phase(a, lds, tid, wave, lane);
#endif
    SEAM(7);
    if (IN(8)) { pg8::Gemm g{(const bf16*)a.out, (const bf16*)(ws + OFF_WOA), M, D, D}; pg8::StaticOrder S; S.init(M, D, G, (int)blockIdx.x); EpiMergeK E{(bf16*)(ws + OFF_MM), (const bf16*)(ws + OFF_GA), (const bf16*)(ws + OFF_GB)};
        pg8::gemm_phase<EpiMergeK, pg8::StaticOrder, PG8_ALIGN, PG8_SP2>(lds, g, S, E); }
    SEAM(8);
    if (IN(9)) { pg8::Gemm g{(const bf16*)(ws + OFF_MM), (const bf16*)(ws + OFF_WOUT), M, D, D}; pg8::StaticOrder S; S.init(M, D, G, (int)blockIdx.x); EpiResid<true, true, false> E{nullptr, nullptr, H, a.in[13], nullptr, mods, H, a.in[23], ssq2, 5, 4, 7, 1.0f};
        pg8::gemm_phase<EpiResid<true, true, false>, pg8::StaticOrder, PG8_ALIGN, PG8_SP2>(lds, g, S, E); }
    SEAM(9);
    if (IN(11)) { pg8::Gemm g{H, (const bf16*)(ws + OFF_WGU2), M, NGU, D}; pg8::StaticOrder S; S.init(M, NGU, G, (int)blockIdx.x); EpiSwiglu<true> E{ACT, ssq2, shW3};
        pg8::gemm_phase<EpiSwiglu<true>, pg8::StaticOrder, PG8_ALIGN, PG8_SP2>(lds, g, S, E); }
    SEAM(11);
    if (IN(12)) { pg8::Gemm g{ACT, (const bf16*)(ws + OFF_WD2), M, D, FF}; pg8::StaticOrder S; S.init(M, D, G, (int)blockIdx.x);
        if (G == 256) { EpiFinal E{H, a.in[23], xr, mods, a.in[26], (float*)(ws + OFF_PARTQ), (unsigned*)(ws + OFF_PCNT), 8, 7, 0.5f};
            pg8::gemm_phase<EpiFinal, pg8::StaticOrder, false, PG8_SP2>(lds, g, S, E); }
        else { EpiResid<false, true, true> E{nullptr, nullptr, H, a.in[23], xr, mods, nullptr, nullptr, nullptr, 8, 7, 0, 0.5f};
            pg8::gemm_phase<EpiResid<false, true, true>, pg8::StaticOrder, PG8_ALIGN, PG8_SP2>(lds, g, S, E);
            xcd_barrier(xbar); final_norm_phase(xr, a.in[26], gw, NGW, lane); } }
#if defined(TSK)
    if (blockIdx.x == 0 && tid == 0) { const unsigned long long t_end = __builtin_amdgcn_s_memrealtime(); const unsigned long long want = 4ull * (ts_k - ts_start); while (__builtin_amdgcn_s_memrealtime() - t_end < want) __builtin_amdgcn_s_sleep(8); }
#endif
#ifdef PROBE_SCALE
    grid.sync();
    { const size_t ranges[6][2] = {{0, (size_t)MP * D}, {(size_t)MP * D, (size_t)M * D}, {OUT_K, OUT_V}, {OUT_V, OUT_CKV}, {OUT_CKV, OUT_KR}, {OUT_KR, OUT_KR + 8192 * 32}};
#pragma unroll
      for (int o = 0; o < 6; ++o) if ((PROBE_SCALE >> o) & 1) for (size_t i = ranges[o][0] + gtid; i < ranges[o][1]; i += NT) a.out[i] *= 1.01f; }
#endif
#undef IN
#undef SEAM
}

constexpr int N_PHASES = 14;
extern "C" void kernel_launch(void* const* d_in, const int* in_sizes, int n_in, void* d_out, int out_size, void* d_ws, size_t ws_size, hipStream_t stream) {
    static int grid = 0;
    if (grid == 0) {
        if (n_in != 27 || ws_size < WS_END) { fprintf(stderr, "kernel_launch: unexpected n_in %d / ws %zu\n", n_in, ws_size); grid = -1; return; }
        int dev = 0, cus = 0, per_cu = 0;
        hipGetDevice(&dev); hipDeviceGetAttribute(&cus, hipDeviceAttributeMultiprocessorCount, dev);
        if (hipFuncSetAttribute((const void*)mk_fwd, hipFuncAttributeMaxDynamicSharedMemorySize, LDS_BYTES) != hipSuccess) { fprintf(stderr, "kernel_launch: hipFuncSetAttribute failed\n"); grid = -1; return; }
        if (hipOccupancyMaxActiveBlocksPerMultiprocessor(&per_cu, (const void*)mk_fwd, 512, LDS_BYTES) != hipSuccess || per_cu < 1) { fprintf(stderr, "kernel_launch: occupancy query gave %d\n", per_cu); per_cu = 1; }
        (void)hipGetLastError();
        grid = cus * 1;
        fprintf(stderr, "kernel_launch: cus %d per_cu %d grid %d\n", cus, per_cu, grid);
    }
    if (grid < 0) return;
    (void)hipMemsetAsync(d_ws, 0, ZERO_BYTES, stream);
    Args a{};
    for (int i = 0; i < 27; ++i) a.in[i] = (const float*)d_in[i];
    a.out = (float*)d_out; a.ws = (unsigned char*)d_ws;
#if MK_N_LAUNCHES == 1
    a.ph_lo = 0; a.ph_hi = N_PHASES;
    void* args[] = {&a};
    hipError_t e = hipLaunchCooperativeKernel((const void*)mk_fwd, dim3(grid), dim3(512), args, LDS_BYTES, stream);
    if (e != hipSuccess) fprintf(stderr, "cooperative launch failed: %s (grid %d)\n", hipGetErrorString(e), grid);
#else
    for (int p = 0; p < N_PHASES; ++p) { a.ph_lo = p; a.ph_hi = p + 1; hipLaunchKernelGGL(mk_fwd, dim3(grid), dim3(512), LDS_BYTES, stream, a); }
#endif
}
```

```cpp
#include <hip/hip_runtime.h>
#include <hip/hip_cooperative_groups.h>
#include <cstdio>
#include <cstdint>
namespace cg = cooperative_groups;
namespace pg8 {
#define PG8_LAS __attribute__((address_space(3)))
typedef unsigned short bf16_t;
typedef short bf16x8 __attribute__((ext_vector_type(8)));
typedef float f32x4 __attribute__((ext_vector_type(4)));
typedef unsigned u32x4 __attribute__((ext_vector_type(4)));
constexpr int BM = 256, BK = 64, HALF = 128, HTB = HALF * BK * 2  , STAGE_BYTES = 8 * HTB, NXCD = 8, WGM = 8;

__host__ __device__ __forceinline__ int lds_byte(int r, int c) { const int st = (r >> 4) * 2 + (c >> 5), rr = r & 15, cc = c & 31, ob = rr * 64 + cc * 2; return st * 1024 + (ob ^ (((ob >> 9) & 1) << 5)); }
__host__ __device__ __forceinline__ void stage_rc(int b, int& R, int& C) { const int st = b / 1024, sb = b % 1024, swz = sb ^ (((sb >> 9) & 1) << 5); R = (st >> 1) * 16 + swz / 64; C = (st & 1) * 32 + (swz % 64) / 2; }
__host__ __device__ __forceinline__ int perm32(int rho) { const int n = rho >> 4, i = rho & 15; return 8 * (i >> 2) + 4 * n + (i & 3); }

struct Unit { int pm, pn, half; };
struct Gemm { const bf16_t* A; const bf16_t* Bt; int M, N, K; };

struct StaticOrder {
    int nM, nN, nwg, G, c;
    __host__ __device__ void init(int M, int N, int G_, int c_) { nM = M / BM; nN = N / BM; nwg = nM * nN; G = G_; c = c_; }
    __host__ __device__ bool next(int i, Unit& u) const { const long L = (long)i * G + c; if (L >= nwg) return false; map(L, u); return true; }
    __host__ __device__ void map(long L, Unit& u) const {
        int wgid = (int)L; { const int q = nwg / NXCD, r = nwg % NXCD, xcd = wgid % NXCD, off = wgid / NXCD; wgid = (xcd < r ? xcd * (q + 1) : r * (q + 1) + (xcd - r) * q) + off; }
        const int nig = WGM * nN, gid = wgid / nig, fm = gid * WGM, gsz = (nM - fm) < WGM ? (nM - fm) : WGM;
        u.pm = fm + ((wgid % nig) % gsz); u.pn = (wgid % nig) / gsz; u.half = 0;
    }
    __device__ __forceinline__ void a_ready(const Unit&) const {}
    __device__ __forceinline__ void done(const Unit&) const {}
};
struct TailOrder : StaticOrder {
    __host__ __device__ bool next(int i, Unit& u) const {
        const int full = nwg / G, rem = nwg - full * G;
        if (rem == 0 || 2 * rem > G || (rem & 7) || (G & 15)) return StaticOrder::next(i, u);
        if (i < full) return StaticOrder::next(i, u);
        if (i > full) return false;
        const int x = c & 7, j = c >> 3;
        if ((j >> 1) >= rem / 8) return false;
        map((long)full * G + 8 * (j >> 1) + x, u); u.half = 1 + (j & 1); return true;
    }
};
__device__ __forceinline__ unsigned cvt_pk_bf16(float lo, float hi) { unsigned r; asm volatile("v_cvt_pk_bf16_f32 %0, %1, %2" : "=v"(r) : "v"(lo), "v"(hi)); return r; }
typedef float f32x2 __attribute__((ext_vector_type(2)));
template <class T, class = void> struct MidK { static constexpr bool value = false; };
template <class T> struct MidK<T, decltype((void)T::MIDK)> { static constexpr bool value = T::MIDK; };
template <class Epi, class Sched, bool ALIGN_EPI = false, bool SP2 = false>
__device__ __forceinline__ void gemm_phase(PG8_LAS unsigned char* lds, const Gemm g, const Sched& S, const Epi& E) {
    const int tid = threadIdx.x, wid = __builtin_amdgcn_readfirstlane(tid >> 6), lane = tid & 63, wr = wid >> 2, wc = wid & 3, fr = lane & 15, fq = lane >> 4;
    const int K = g.K, nt = K / BK;
    unsigned voffA[2], voffB[2];
#pragma unroll
    for (int i = 0; i < 2; ++i) { int R, C; stage_rc(tid * 16 + i * 8192, R, C); const int Rb = Epi::PERM ? ((R & ~31) + perm32(R & 31)) : R;
        voffA[i] = (unsigned)(R * K + C) * 2u; voffB[i] = (unsigned)(Rb * K + C) * 2u; }
    const size_t kstep = (size_t)(BK * 2);
    const size_t hstep = (size_t)HALF * K * 2;
    const size_t tstep = 2 * hstep;
    const unsigned ldsw = (unsigned)wid * 1024u;
    const int aoff = lds_byte(wr * 64 + fr, fq * 8), boff = lds_byte(wc * 32 + fr, fq * 8);
#define PG8_SA(b, h) (((b) * 2 + (h)) * HTB)
#define PG8_SB(b, h) ((4 + (b) * 2 + (h)) * HTB)
#define PG8_STAGE(bufoff, gbase, voff) do { _Pragma("unroll") for (int _i = 0; _i < 2; ++_i) \
        __builtin_amdgcn_global_load_lds((const unsigned*)((const char*)(gbase) + (voff)[_i]), (PG8_LAS unsigned*)(lds + (bufoff) + ldsw + _i * 8192), 16, 0, 0); } while (0)
#define PG8_LDA(dst, b, h) do { _Pragma("unroll") for (int m = 0; m < 4; ++m) _Pragma("unroll") for (int k = 0; k < 2; ++k) dst[m][k] = *(const PG8_LAS bf16x8*)(lds + PG8_SA(b, h) + aoff + m * 2048 + k * 1024); } while (0)
#define PG8_LDB(dst, b, h) do { _Pragma("unroll") for (int n = 0; n < 2; ++n) _Pragma("unroll") for (int k = 0; k < 2; ++k) dst[n][k] = *(const PG8_LAS bf16x8*)(lds + PG8_SB(b, h) + boff + n * 2048 + k * 1024); } while (0)
#define PG8_MMA(ai, bj, At, Bt) do { __builtin_amdgcn_s_setprio(1); _Pragma("unroll") for (int m = 0; m < 4; ++m) _Pragma("unroll") for (int n = 0; n < 2; ++n) _Pragma("unroll") for (int k = 0; k < 2; ++k) \
        acc[ai][bj][m][n] = __builtin_amdgcn_mfma_f32_16x16x32_bf16(Bt[n][k], At[m][k], acc[ai][bj][m][n], 0, 0, 0); __builtin_amdgcn_s_setprio(0); } while (0)
#define PG8_WAIT_V(n) asm volatile("s_waitcnt vmcnt(" #n ")" ::: "memory")
#define PG8_WAIT_L(n) asm volatile("s_waitcnt lgkmcnt(" #n ")" ::: "memory")
#define PG8_BAR __builtin_amdgcn_s_barrier()
#define PG8_SCHED __builtin_amdgcn_sched_barrier(0)
    Unit cur, nxt; int ui = 0;
    if (!S.next(0, cur)) return;
    f32x4 acc[2][2][4][2];
#pragma unroll
    for (int a = 0; a < 2; ++a)
#pragma unroll
        for (int b = 0; b < 2; ++b)
#pragma unroll
            for (int m = 0; m < 4; ++m)
#pragma unroll
                for (int n = 0; n < 2; ++n) acc[a][b][m][n] = (f32x4){0.f, 0.f, 0.f, 0.f};
    bf16x8 At[4][2], B0[2][2], B1[2][2];
    const char* cA = (const char*)g.A + (size_t)cur.pm * tstep + (cur.half == 2 ? hstep : (size_t)0); const char* cB = (const char*)g.Bt + (size_t)cur.pn * tstep;
    S.a_ready(cur);
    if constexpr (SP2) {
        PG8_STAGE(PG8_SB(0, 0), cB, voffB); PG8_STAGE(PG8_SB(0, 1), cB + hstep, voffB); PG8_STAGE(PG8_SA(0, 0), cA, voffA); PG8_STAGE(PG8_SA(0, 1), cA + hstep, voffA);
        if (wr == 1) PG8_BAR;
        PG8_WAIT_V(2); PG8_BAR;
        PG8_STAGE(PG8_SB(1, 0), cB + kstep, voffB); PG8_STAGE(PG8_SA(1, 0), cA + kstep, voffA); PG8_STAGE(PG8_SB(1, 1), cB + hstep + kstep, voffB);
        PG8_WAIT_V(6); PG8_BAR;
    } else {
        PG8_STAGE(PG8_SB(0, 0), cB, voffB); PG8_STAGE(PG8_SA(0, 0), cA, voffA); PG8_STAGE(PG8_SB(0, 1), cB + hstep, voffB); PG8_STAGE(PG8_SA(0, 1), cA + hstep, voffA);
        if (wr == 1) PG8_BAR;
        PG8_WAIT_V(4); PG8_BAR;
        PG8_STAGE(PG8_SB(1, 0), cB + kstep, voffB); PG8_STAGE(PG8_SA(1, 0), cA + kstep, voffA); PG8_STAGE(PG8_SB(1, 1), cB + hstep + kstep, voffB);
        PG8_WAIT_V(6); PG8_BAR;
    }
    for (;;) {
        const bool has_next = S.next(ui + 1, nxt);
        const char* nA = has_next ? (const char*)g.A + (size_t)nxt.pm * tstep + (nxt.half == 2 ? hstep : (size_t)0) : cA; const char* nB = has_next ? (const char*)g.Bt + (size_t)nxt.pn * tstep : cB;
        for (int t = 0; t < nt; t += 2) {
            const bool last = (t == nt - 2);
            const char* a1 = cA + (size_t)(t + 1) * kstep;
            const char* a2 = last ? nA : cA + (size_t)(t + 2) * kstep; const char* b2 = last ? nB : cB + (size_t)(t + 2) * kstep;
            const char* a3 = a2 + kstep; const char* b3 = b2 + kstep;
            if constexpr (MidK<Epi>::value) { if (t == nt / 2) E.mid(acc, cur, wr, wc, fr, fq); }
            if (last && has_next) S.a_ready(nxt);
            if constexpr (SP2) {
            PG8_LDB(B0, 0, 0); PG8_LDB(B1, 0, 1); PG8_SCHED; PG8_LDA(At, 0, 0); PG8_STAGE(PG8_SA(1, 1), a1 + hstep, voffA);
            PG8_WAIT_V(8); PG8_WAIT_L(0); PG8_BAR; PG8_MMA(0, 0, At, B0); PG8_MMA(0, 1, At, B1); PG8_BAR; PG8_SCHED;
            PG8_LDA(At, 0, 1); PG8_STAGE(PG8_SB(0, 0), b2, voffB); PG8_STAGE(PG8_SB(0, 1), b2 + hstep, voffB); PG8_STAGE(PG8_SA(0, 0), a2, voffA);
            PG8_WAIT_V(8); PG8_WAIT_L(0); PG8_BAR; PG8_MMA(1, 0, At, B0); PG8_MMA(1, 1, At, B1); PG8_BAR; PG8_SCHED;
            PG8_LDB(B0, 1, 0); PG8_LDB(B1, 1, 1); PG8_SCHED; PG8_LDA(At, 1, 0); PG8_STAGE(PG8_SA(0, 1), a2 + hstep, voffA);
            PG8_WAIT_V(8); PG8_WAIT_L(0); PG8_BAR; PG8_MMA(0, 0, At, B0); PG8_MMA(0, 1, At, B1); PG8_BAR; PG8_SCHED;
            PG8_LDA(At, 1, 1); PG8_STAGE(PG8_SB(1, 0), b3, voffB); PG8_STAGE(PG8_SB(1, 1), b3 + hstep, voffB); PG8_STAGE(PG8_SA(1, 0), a3, voffA);
            PG8_WAIT_V(8); PG8_WAIT_L(0); PG8_BAR; PG8_MMA(1, 0, At, B0); PG8_MMA(1, 1, At, B1); PG8_BAR; PG8_SCHED;
            } else {
            PG8_LDB(B0, 0, 0); PG8_SCHED; PG8_LDA(At, 0, 0); PG8_STAGE(PG8_SA(1, 1), a1 + hstep, voffA);
            PG8_WAIT_L(8); PG8_BAR; PG8_WAIT_L(0); PG8_MMA(0, 0, At, B0); PG8_BAR; PG8_SCHED;
            PG8_LDB(B1, 0, 1); PG8_STAGE(PG8_SB(0, 0), b2, voffB);
            PG8_BAR; PG8_WAIT_L(0); PG8_MMA(0, 1, At, B1); PG8_BAR;
            PG8_LDA(At, 0, 1); PG8_STAGE(PG8_SA(0, 0), a2, voffA);
            PG8_BAR; PG8_WAIT_L(0); PG8_MMA(1, 0, At, B0); PG8_BAR; PG8_SCHED;
            PG8_STAGE(PG8_SB(0, 1), b2 + hstep, voffB);
            PG8_WAIT_V(6); PG8_BAR; PG8_MMA(1, 1, At, B1); PG8_BAR;
            PG8_LDB(B0, 1, 0); PG8_SCHED; PG8_LDA(At, 1, 0); PG8_STAGE(PG8_SA(0, 1), a2 + hstep, voffA);
            PG8_WAIT_L(8); PG8_BAR; PG8_WAIT_L(0); PG8_MMA(0, 0, At, B0); PG8_BAR; PG8_SCHED;
            PG8_LDB(B1, 1, 1); PG8_STAGE(PG8_SB(1, 0), b3, voffB);
            PG8_BAR; PG8_WAIT_L(0); PG8_MMA(0, 1, At, B1); PG8_BAR;
            PG8_LDA(At, 1, 1); PG8_STAGE(PG8_SA(1, 0), a3, voffA);
            PG8_BAR; PG8_WAIT_L(0); PG8_MMA(1, 0, At, B0); PG8_BAR; PG8_SCHED;
            PG8_STAGE(PG8_SB(1, 1), b3 + hstep, voffB);
            PG8_WAIT_V(6); PG8_BAR; PG8_MMA(1, 1, At, B1); PG8_BAR;
            }
        }
        if constexpr (ALIGN_EPI) { if (wr == 0) PG8_BAR; }
        if constexpr (!Epi::AFTER_DRAIN) { E(acc, cur, wr, wc, fr, fq); S.done(cur); }
        if (!has_next) break;
#pragma unroll
        for (int a = 0; a < 2; ++a)
#pragma unroll
            for (int b = 0; b < 2; ++b)
#pragma unroll
                for (int m = 0; m < 4; ++m)
#pragma unroll
                    for (int n = 0; n < 2; ++n) acc[a][b][m][n] = (f32x4){0.f, 0.f, 0.f, 0.f};
        cur = nxt; cA = nA; cB = nB; ++ui;
        if constexpr (ALIGN_EPI) { if (wr == 1) PG8_BAR; }
    }
    PG8_WAIT_V(0);
    if constexpr (!ALIGN_EPI) { if (wr == 0) PG8_BAR; }
    PG8_BAR;
    if constexpr (Epi::AFTER_DRAIN) { E.fused(acc, cur, wr, wc, fr, fq, lds, wid, lane); S.done(cur); }
#undef PG8_SA
#undef PG8_SB
#undef PG8_STAGE
#undef PG8_LDA
#undef PG8_LDB
#undef PG8_MMA
#undef PG8_WAIT_V
#undef PG8_WAIT_L
#undef PG8_BAR
#undef PG8_SCHED
}
}
#ifndef PG8_SP2
#define PG8_SP2 true
#endif
#ifndef PG8_ALIGN
#define PG8_ALIGN true
#endif
#ifndef MK_N_LAUNCHES
#define MK_N_LAUNCHES 1
#endif
#define DI __device__ __forceinline__
#define LAS __attribute__((address_space(3)))
typedef unsigned short bf16;
typedef unsigned v4u __attribute__((ext_vector_type(4)));
typedef unsigned v2u __attribute__((ext_vector_type(2)));
typedef float f32x4 __attribute__((ext_vector_type(4)));
typedef float f32x16 __attribute__((ext_vector_type(16)));
typedef short bf16x8 __attribute__((ext_vector_type(8)));
using pg8::Unit;

constexpr int D = 1024, MP = 8192, M = 16384, MCTX = 2048, MALL = 18432;
constexpr int FF = 2816, NGU = 5632, NINP = 3584, NMODS = 9216;
constexpr float EPS = 1e-6f, LOG2E = 1.4426950408889634f;
constexpr float A_QS = 0.125f * LOG2E;
constexpr float B_QS = 0.10206207261596575f * LOG2E;
constexpr size_t OUT_K = (size_t)M * D, OUT_V = OUT_K + 8192 * 128, OUT_CKV = OUT_V + 8192 * 128, OUT_KR = OUT_CKV + 8192 * 256;
constexpr size_t MiB = 1u << 20;
constexpr size_t OFF_MODS = 0, OFF_SSQQ = 196608, OFF_SSQKV = 262144, OFF_BAR = 327680, OFF_SSQ1 = 344064, OFF_SSQ2 = 409600, OFF_PCNT = 475136, ZERO_BYTES = 491520, OFF_ROPEA = 524288, OFF_ROPEB = 532480, OFF_SHW2 = 589824, OFF_SHW3 = 663552;
constexpr size_t OFF_WGU1 = 1 * MiB, OFF_WGU2 = 12 * MiB, OFF_WD1 = 23 * MiB, OFF_WD2 = OFF_WD1 + 5767168, OFF_WIN = 34 * MiB, OFF_WOUT = 41 * MiB,
                 OFF_WOA = 43 * MiB, OFF_WOB = 44 * MiB, OFF_WUQ = 45 * MiB, OFF_WK = OFF_WUQ + 393216, OFF_WV = OFF_WK + 262144;
constexpr size_t OFF_H = 46 * MiB, OFF_OA = OFF_H, OFF_OB = OFF_H + 16 * MiB;
constexpr size_t OFF_ACT = 78 * MiB;
constexpr size_t OFF_QA = OFF_ACT, OFF_KA = OFF_QA + 16 * MiB, OFF_VAT = OFF_KA + (size_t)MALL * 128 * 2, OFF_QLAT = OFF_VAT + (size_t)MALL * 128 * 2,
                 OFF_CKV = OFF_QLAT + 8 * MiB, OFF_KROPE = OFF_CKV + 9 * MiB, OFF_QB = OFF_KROPE + (size_t)MALL * 32 * 2 + 131072, OFF_KN = OFF_QB + 24 * MiB;
constexpr size_t OFF_MM = OFF_ACT;
constexpr size_t OFF_GA = 166 * MiB, OFF_GB = 198 * MiB, OFF_VBT = 230 * MiB, OFF_PART1 = 248 * MiB, OFF_PART2 = 249 * MiB, OFF_PARTQ = 250 * MiB, OFF_PARTKV = 250 * MiB + 262144, WS_END = 251 * MiB;
static_assert(OFF_QLAT + 8 * MiB >= OFF_MM + 32 * MiB, "m overlay");
static_assert(OFF_KN + 18 * MiB <= OFF_GA && OFF_WV + 262144 <= OFF_H, "ws map");
constexpr int LDS_BYTES = 147456;

DI unsigned f2bf(float f) { unsigned u = __builtin_bit_cast(unsigned, f); return (u + 0x7fffu + ((u >> 16) & 1u)) >> 16; }
typedef __bf16 hbf16x2 __attribute__((ext_vector_type(2)));
typedef float hf32x2 __attribute__((ext_vector_type(2)));
DI unsigned pk2(float lo, float hi) { const hf32x2 f = {lo, hi}; return __builtin_bit_cast(unsigned, __builtin_convertvector(f, hbf16x2)); }
DI float bflo(unsigned w) { return __builtin_bit_cast(float, w << 16); }
DI float bfhi(unsigned w) { return __builtin_bit_cast(float, w & 0xffff0000u); }
DI float fexp2(float x) { return __builtin_amdgcn_exp2f(x); }
DI float frcp(float x) { return __builtin_amdgcn_rcpf(x); }
DI float sigm(float x) { return frcp(1.f + fexp2(-x * LOG2E)); }
#define LDS_WAIT() asm volatile("s_waitcnt lgkmcnt(0)" ::: "memory")
DI float wave_sum(float v) {
#pragma unroll
    for (int o = 1; o < 64; o <<= 1) v += __shfl_xor(v, o);
    return v;
}
DI float sum16(const float* p) { const f32x4 a = *(const f32x4*)p, b = *(const f32x4*)(p + 4), c = *(const f32x4*)(p + 8), d = *(const f32x4*)(p + 12); const f32x4 t = (a + b) + (c + d); return (t.x + t.y) + (t.z + t.w); }
DI float sum4(const float* p) { const f32x4 a = *(const f32x4*)p; return (a.x + a.y) + (a.z + a.w); }
DI int mod_index(int row) { return row < MP ? 0 : 1 + ((row - MP) >> 11); }

#define XB_TMO      128
#define XB_XCNT(j)  (256  + 64 * (j))
#define XB_XSUB(j)  (1280 + 64 * (j))
#define XB_XGEN(j)  (2304 + 64 * (j))
#define XB_TOP      3328
#define XB_TOPGEN   3392
#define XCD_BAR_WORDS 3456
#define XB_SPIN_CAP (1u << 18)

__device__ __forceinline__ unsigned xb_ld(unsigned* p)              { return __hip_atomic_load(p, __ATOMIC_RELAXED, __HIP_MEMORY_SCOPE_AGENT); }
__device__ __forceinline__ unsigned xb_add(unsigned* p, unsigned v) { return __hip_atomic_fetch_add(p, v, __ATOMIC_RELAXED, __HIP_MEMORY_SCOPE_AGENT); }
__device__ __forceinline__ unsigned xb_xcc_id() { return (unsigned)__builtin_amdgcn_s_getreg((3 << 11) | 20) & 0xFu; }
#define XB_SPIN(cond, bar) do { unsigned _sp = 0; while (cond) { __builtin_amdgcn_s_sleep(1); \
    if ((++_sp & 255u) == 0u) { if (xb_ld(&(bar)[XB_TMO])) break; if (_sp > XB_SPIN_CAP) { atomicAdd(&(bar)[XB_TMO], 1u); break; } } } } while (0)

struct XcdBarrier {
    unsigned* bar; unsigned x;
    volatile LAS unsigned* st;
};

__device__ __forceinline__ XcdBarrier xcd_barrier_post(unsigned* bar, volatile LAS unsigned* st) {
    XcdBarrier b; b.bar = bar; b.x = xb_xcc_id(); b.st = st;
    if (threadIdx.x == 0) (void)xb_add(&bar[XB_XCNT(b.x)], 1u);
    return b;
}
__device__ __forceinline__ void xcd_barrier_complete(unsigned* bar, unsigned x, unsigned& nloc, unsigned& nx) {
    const unsigned G = gridDim.x * gridDim.y * gridDim.z;
    unsigned sum, cnt, mine, sp = 0u;
    for (;;) {
        sum = 0u; cnt = 0u; mine = 0u;
#pragma unroll
        for (unsigned j = 0; j < 16; ++j) { const unsigned c = xb_ld(&bar[XB_XCNT(j)]); sum += c; cnt += (c > 0u) ? 1u : 0u; mine = (j == x) ? c : mine; }
        if (sum == G) break;
        __builtin_amdgcn_s_sleep(1);
        if ((++sp & 255u) == 0u) { if (xb_ld(&bar[XB_TMO])) break; if (sp > XB_SPIN_CAP) { atomicAdd(&bar[XB_TMO], 1u); break; } }
    }
    nloc = mine > 0u ? mine : 1u; nx = cnt > 0u ? cnt : 1u;
}

__device__ __forceinline__ void xcd_barrier(const XcdBarrier& b) {
    asm volatile("s_waitcnt vmcnt(0)" ::: "memory");
    __syncthreads();
    if (threadIdx.x == 0) {
        unsigned* bar = b.bar;
        __builtin_amdgcn_s_waitcnt(0);
        unsigned nloc = b.st[0], nx = b.st[1];
        if (nloc == 0u) { xcd_barrier_complete(bar, b.x, nloc, nx); b.st[0] = nloc; b.st[1] = nx; }
        const unsigned old = xb_add(&bar[XB_XSUB(b.x)], 1u);
        const unsigned gen = old / nloc;
        if (old + 1u == (gen + 1u) * nloc) {
            __builtin_amdgcn_fence(__ATOMIC_RELEASE, "agent");
            asm volatile("s_waitcnt vmcnt(0)" ::: "memory");
            const unsigned og = xb_add(&bar[XB_TOP], 1u);
            const unsigned tg = og / nx;
            if (og + 1u == (tg + 1u) * nx) xb_add(&bar[XB_TOPGEN], 1u);
            else XB_SPIN(xb_ld(&bar[XB_TOPGEN]) == tg, bar);
            __builtin_amdgcn_fence(__ATOMIC_ACQUIRE, "agent");
            xb_add(&bar[XB_XGEN(b.x)], 1u);
            asm volatile("s_waitcnt vmcnt(0)" ::: "memory");
        } else {
            XB_SPIN(xb_ld(&bar[XB_XGEN(b.x)]) == gen, bar);
            __builtin_amdgcn_fence(__ATOMIC_ACQUIRE, "agent");
            asm volatile("s_waitcnt vmcnt(0)" ::: "memory");
        }
    }
    __syncthreads();
}


DI void transpose_item(const float* W, int N, bf16* WT, int K, int k0, int src_n0, int dst_r0, const float* kscale, float sscale, LAS float* scr, int lane, int dk = 0, bool ntst = false) {
    if (src_n0 >= 0) {
        float v[32];
#pragma unroll
        for (int i = 0; i < 32; ++i) v[i] = __builtin_nontemporal_load(W + (size_t)(k0 + 2 * i + (lane >> 5)) * N + src_n0 + (lane & 31));
        if (kscale) {
#pragma unroll
            for (int i = 0; i < 32; ++i) v[i] *= kscale[k0 + 2 * i + (lane >> 5)]; }
#pragma unroll
        for (int i = 0; i < 32; ++i) scr[(2 * i + (lane >> 5)) * 33 + (lane & 31)] = v[i] * sscale;
    } else {
#pragma unroll 8
        for (int i = 0; i < 32; ++i) { const int kk = 2 * i + (lane >> 5); scr[kk * 33 + (lane & 31)] = 0.f; }
    }
    LDS_WAIT(); asm volatile("" ::: "memory");
    const int c = lane & 7;
#pragma unroll
    for (int j = 0; j < 4; ++j) { const int n = (lane >> 3) + 8 * j; const LAS float* s = scr + (8 * c) * 33 + n;
        v4u o; o.x = pk2(s[0 * 33], s[1 * 33]); o.y = pk2(s[2 * 33], s[3 * 33]); o.z = pk2(s[4 * 33], s[5 * 33]); o.w = pk2(s[6 * 33], s[7 * 33]);
        v4u* dp = (v4u*)(WT + (size_t)(dst_r0 + n) * K + k0 + dk + 8 * c);
        if (ntst) __builtin_nontemporal_store(o, dp); else *dp = o; }
    LDS_WAIT(); asm volatile("" ::: "memory");
}

struct Args { const float* in[27]; float* out; unsigned char* ws; int ph_lo, ph_hi; };

constexpr int I_GU = 16 * 176, I_D = 44 * 32, I_IN = 16 * 112, I_OUT = 16 * 32, I_O = 8 * 32, I_UQ = 4 * 24, I_K = 4 * 16;
constexpr int P0_EARLY = I_GU + I_IN, P0_NIT = P0_EARLY + I_GU + 2 * I_D + I_OUT + 2 * I_O + I_UQ + 2 * I_K;
DI void p0_weights(const Args& a, LAS unsigned char* lds, int gw, int NGW, int wave, int lane, int it_lo, int it_hi) {
    LAS float* scr = (LAS float*)(lds + wave * 16384);
    unsigned char* ws = a.ws;
    for (int it = it_lo + gw; it < it_hi; it += NGW) {
        int r = it;
        if (r < I_GU) { const int w = 0; const int kb = r / 176, nb = r % 176, R0 = 32 * nb;
            const int pn = R0 >> 8, half = (R0 >> 7) & 1, j = R0 & 127;
            transpose_item(a.in[w ? 24 : 11], NGU, (bf16*)(ws + (w ? OFF_WGU2 : OFF_WGU1)), 1024, 64 * kb, half * FF + 128 * pn + j, R0, nullptr, 1.f, scr, lane); continue; }
        r -= I_GU;
        if (r < I_IN) { const int kb = r / 112, nb = r % 112, R0 = 32 * nb;
            const int gq = R0 - 1280; const int src = R0 < 1280 ? R0 : (R0 < 3328 ? (((gq >> 7) & 1) ? 2336 : 1312) + 128 * (gq >> 8) + (gq & 127) : (R0 == 3328 ? 1280 : -1));
            transpose_item(a.in[14], 3360, (bf16*)(ws + OFF_WIN), 1024, 64 * kb, src, R0, nullptr, 1.f, scr, lane); continue; }
        r -= I_IN;
        if (r < I_GU) { const int w = 1; const int kb = r / 176, nb = r % 176, R0 = 32 * nb;
            const int pn = R0 >> 8, half = (R0 >> 7) & 1, j = R0 & 127;
            transpose_item(a.in[w ? 24 : 11], NGU, (bf16*)(ws + (w ? OFF_WGU2 : OFF_WGU1)), 1024, 64 * kb, half * FF + 128 * pn + j, R0, nullptr, 1.f, scr, lane, 0, true); continue; }
        r -= I_GU;
        if (r < I_D) { const int kb = r / 32, nb = r % 32;
            transpose_item(a.in[12], 1024, (bf16*)(ws + OFF_WD1), FF, 64 * kb, 32 * nb, 32 * nb, nullptr, 1.f, scr, lane); continue; }
        r -= I_D;
        if (r < I_D) { const int kb = r / 32, nb = r % 32;
            transpose_item(a.in[25], 1024, (bf16*)(ws + OFF_WD2), FF, 64 * kb, 32 * nb, 32 * nb, nullptr, 1.f, scr, lane, 0, true); continue; }
        r -= I_D;
        if (r < I_OUT) { const int kb = r / 32, nb = r % 32; transpose_item(a.in[22], 1024, (bf16*)(ws + OFF_WOUT), 1024, 64 * kb, 32 * nb, 32 * nb, nullptr, 1.f, scr, lane, 0, true); continue; }
        r -= I_OUT;
        if (r < 2 * I_O) { const int w = r >= I_O; r -= w * I_O; const int kb = r / 32, nb = r % 32;
            transpose_item(a.in[w ? 21 : 20], 1024, (bf16*)(ws + OFF_WOA), 1024, 64 * kb, 32 * nb, 32 * nb, nullptr, 1.f, scr, lane, w ? 512 : 0, true); continue; }
        r -= 2 * I_O;
        if (r < I_UQ) { const int kb = r / 24, nb = r % 24, R0 = 32 * nb;
            const int src = R0 < 512 ? (R0 >> 6) * 96 + (R0 & 63) : ((R0 - 512) >> 5) * 96 + 64;
            transpose_item(a.in[18], 768, (bf16*)(ws + OFF_WUQ), 256, 64 * kb, src, R0, a.in[16], B_QS, scr, lane, 0, true); continue; }
        r -= I_UQ;
        { const int w = r >= I_K; r -= w * I_K; const int kb = r / 16, nb = r % 16, R0 = 32 * nb;
            const int src = (R0 >> 6) * 128 + (R0 & 63) + (w ? 64 : 0);
            transpose_item(a.in[19], 1024, (bf16*)(ws + (w ? OFF_WV : OFF_WK)), 256, 64 * kb, src, R0, a.in[17], 1.f, scr, lane, 0, true); }
    }
}
DI void p0_ada(const Args& a, LAS unsigned char* lds, int tid) {
    LAS float* sc = (LAS float*)lds;
    LAS float* red = (LAS float*)(lds + 4096);
    float* mods = (float*)(a.ws + OFF_MODS);
    const float* adaw = a.in[8];
    for (int it = blockIdx.x; it < 256; it += gridDim.x) {
        const int cgp = it & 31, ks = it >> 5;
        __syncthreads();
        for (int i = tid; i < 640; i += 512) { const int v = i >> 7, k = ks * 128 + (i & 127); const float c = v == 0 ? a.in[7][k] : a.in[6][(v - 1) * 1024 + k]; sc[i] = c * sigm(c); }
        __syncthreads();
        const int colq = tid % 72, kl = tid / 72;
        if (kl < 7) {
            f32x4 acc[5];
#pragma unroll
            for (int v = 0; v < 5; ++v) acc[v] = (f32x4){0.f, 0.f, 0.f, 0.f};
            f32x4 w[19];
#pragma unroll
            for (int q = 0; q < 19; ++q) { const int k = kl + 7 * q; w[q] = k < 128 ? __builtin_nontemporal_load((const f32x4*)(adaw + (size_t)(ks * 128 + k) * NMODS + cgp * 288 + colq * 4)) : (f32x4){0.f, 0.f, 0.f, 0.f}; }
#pragma unroll
            for (int q = 0; q < 19; ++q) { const int k = kl + 7 * q; if (k < 128) {
#pragma unroll
                for (int v = 0; v < 5; ++v) acc[v] += w[q] * sc[v * 128 + k]; } }
#pragma unroll
            for (int v = 0; v < 5; ++v) *(LAS f32x4*)(red + (kl * 5 + v) * 288 + colq * 4) = acc[v];
        }
        __syncthreads();
        for (int i = tid; i < 1440; i += 512) { const int v = i / 288, cc = i % 288; float s = 0.f;
#pragma unroll
            for (int q = 0; q < 7; ++q) s += red[(q * 5 + v) * 288 + cc];
            const int col = cgp * 288 + cc; if (ks == 0) s += a.in[9][col];
            atomicAdd(mods + v * NMODS + col, s); }
    }
    __syncthreads();
}
DI void ctx_convert(const Args& a, int gtid, int NT) {
    unsigned char* ws = a.ws;
    bf16* ka = (bf16*)(ws + OFF_KA) + (size_t)M * 128; bf16* vaT = (bf16*)(ws + OFF_VAT); bf16* ckv = (bf16*)(ws + OFF_CKV) + (size_t)M * 256; bf16* kr = (bf16*)(ws + OFF_KROPE) + (size_t)M * 32;
    for (int i = gtid; i < MCTX * 128; i += NT) ka[i] = (bf16)f2bf(a.in[2][i]);
    for (int i = gtid; i < MCTX * 128; i += NT) { const int f = i >> 11, tk = i & 2047; vaT[(size_t)f * MALL + M + tk] = (bf16)f2bf(a.in[3][tk * 128 + f]); }
    for (int i = gtid; i < MCTX * 256; i += NT) ckv[i] = (bf16)f2bf(a.in[4][i] / a.in[17][i & 255]);
    for (int i = gtid; i < MCTX * 32; i += NT) kr[i] = (bf16)f2bf(a.in[5][i]);
}
DI void p0_misc(const Args& a, int gtid, int NT) {
    unsigned char* ws = a.ws;
    float2* ra = (float2*)(ws + OFF_ROPEA); float2* rb = (float2*)(ws + OFF_ROPEB);
    for (int i = gtid; i < 1024; i += NT) { const int pos = i >> 4, fi = i & 15; const float inv = 1.0f / powf(10000.f, (float)(2 * fi) / 32.f); const float ang = (float)pos * inv; ra[i] = make_float2(cosf(ang), sinf(ang)); }
    for (int i = gtid; i < 512; i += NT) { const int pos = i >> 3, fi = i & 7; const float inv = 1.0f / powf(10000.f, (float)(2 * fi) / 16.f); const float ang = (float)pos * inv; rb[i] = make_float2(cosf(ang), sinf(ang)); }
}

DI void norm_mod_phase(const float* xa, const float* xb, const float* gain, const float* mods, int s, bf16* h, int gw, int NGW, int lane) {
    for (int row = gw; row < M; row += NGW) {
        const float* xr = row < MP ? xa + (size_t)row * D : xb + (size_t)(row - MP) * D;
        f32x4 v[4]; float ss = 0.f;
#pragma unroll
        for (int j = 0; j < 4; ++j) { v[j] = *(const f32x4*)(xr + 4 * (64 * j + lane)); ss += (v[j].x * v[j].x + v[j].y * v[j].y) + (v[j].z * v[j].z + v[j].w * v[j].w); }
        const float rstd = 1.0f / sqrtf(wave_sum(ss) * (1.f / D) + EPS);
        const float* sh = mods + mod_index(row) * NMODS + (3 * s) * D; const float* sc = sh + D;
#pragma unroll
        for (int j = 0; j < 4; ++j) { const int c = 4 * (64 * j + lane); const f32x4 g = *(const f32x4*)(gain + c), s4 = *(const f32x4*)(sh + c), c4 = *(const f32x4*)(sc + c);
            const f32x4 o = (v[j] * rstd * g) * (c4 + 1.0f) + s4; v2u w; w.x = pk2(o.x, o.y); w.y = pk2(o.z, o.w); *(v2u*)(h + (size_t)row * D + c) = w; }
    }
}
DI void shw_phase(const bf16* WT, int nrows, const float* mods, int shslot, float* shW, int gw, int NGW, int lane) {
    for (int n = gw; n < nrows; n += NGW) {
        const v4u w0 = *(const v4u*)(WT + (size_t)n * D + 16 * lane), w1 = *(const v4u*)(WT + (size_t)n * D + 16 * lane + 8);
        f32x4 a0, a1, a2, a3; { f32x4 t0, t1; a0 = (f32x4){bflo(w0.x), bfhi(w0.x), bflo(w0.y), bfhi(w0.y)}; a1 = (f32x4){bflo(w0.z), bfhi(w0.z), bflo(w0.w), bfhi(w0.w)};
            a2 = (f32x4){bflo(w1.x), bfhi(w1.x), bflo(w1.y), bfhi(w1.y)}; a3 = (f32x4){bflo(w1.z), bfhi(w1.z), bflo(w1.w), bfhi(w1.w)}; }
#pragma unroll
        for (int b = 0; b < 5; ++b) { const float* sh = mods + b * NMODS + shslot * D + 16 * lane;
            const f32x4 p = a0 * *(const f32x4*)(sh) + a1 * *(const f32x4*)(sh + 4) + a2 * *(const f32x4*)(sh + 8) + a3 * *(const f32x4*)(sh + 12);
            const float sum = wave_sum((p.x + p.y) + (p.z + p.w)); if (lane == 0) shW[b * nrows + n] = sum; }
    }
}
DI void final_norm_phase(float* x, const float* gain, int gw, int NGW, int lane) {
    for (int row = gw; row < M; row += NGW) {
        float* xr = x + (size_t)row * D; f32x4 v[4]; float ss = 0.f;
#pragma unroll
        for (int j = 0; j < 4; ++j) { v[j] = *(const f32x4*)(xr + 4 * (64 * j + lane)); ss += (v[j].x * v[j].x + v[j].y * v[j].y) + (v[j].z * v[j].z + v[j].w * v[j].w); }
        const float rstd = 1.0f / sqrtf(wave_sum(ss) * (1.f / D) + EPS);
#pragma unroll
        for (int j = 0; j < 4; ++j) { const int c = 4 * (64 * j + lane); *(f32x4*)(xr + c) = v[j] * rstd * *(const f32x4*)(gain + c); }
    }
}
#define EPI_ARGS const f32x4 (&acc)[2][2][4][2], const Unit& u, int wr, int wc, int fr, int fq
DI v4u pack8(const f32x4& a, const f32x4& b) { v4u w; w.x = pk2(a.x, a.y); w.y = pk2(a.z, a.w); w.z = pk2(b.x, b.y); w.w = pk2(b.z, b.w); return w; }
DI void unpack8(const v4u& w, f32x4& a, f32x4& b) { a = (f32x4){bflo(w.x), bfhi(w.x), bflo(w.y), bfhi(w.y)}; b = (f32x4){bflo(w.z), bfhi(w.z), bflo(w.w), bfhi(w.w)}; }
DI f32x4 shx4(const f32x4& v, int m) { return (f32x4){__shfl_xor(v.x, m), __shfl_xor(v.y, m), __shfl_xor(v.z, m), __shfl_xor(v.w, m)}; }
DI void rope8(f32x4& v0, f32x4& v1, const float2* cs, int xm, float sgn) {
    const f32x4 p0 = shx4(v0, xm), p1 = shx4(v1, xm);
    const f32x4 t0 = *(const f32x4*)(cs), t1 = *(const f32x4*)(cs + 2), t2 = *(const f32x4*)(cs + 4), t3 = *(const f32x4*)(cs + 6);
    v0 = (f32x4){v0.x * t0.x + sgn * p0.x * t0.y, v0.y * t0.z + sgn * p0.y * t0.w, v0.z * t1.x + sgn * p0.z * t1.y, v0.w * t1.z + sgn * p0.w * t1.w};
    v1 = (f32x4){v1.x * t2.x + sgn * p1.x * t2.y, v1.y * t2.z + sgn * p1.y * t2.w, v1.z * t3.x + sgn * p1.z * t3.y, v1.w * t3.z + sgn * p1.w * t3.w};
}

template <bool NORM> struct EpiSwiglu { static constexpr bool PERM = true, AFTER_DRAIN = false; bf16* O; const float* ssq; const float* shW;
    DI void operator()(EPI_ARGS) const {
        asm volatile("" : "+v"(fr), "+v"(fq));
        const int row0 = u.pm * 256 + (u.half == 2 ? 128 : 0) + wr * 64 + fr, col0 = u.pn * 128 + wc * 32 + 8 * fq;
        f32x4 sw[2][2];
        if (NORM) { const float* sp = shW + mod_index(u.pm * 256) * NGU + u.pn * 256 + wc * 32 + 8 * fq;
#pragma unroll
            for (int bj = 0; bj < 2; ++bj)
#pragma unroll
                for (int n = 0; n < 2; ++n) sw[bj][n] = *(const f32x4*)(sp + bj * 128 + 4 * n); }
#pragma unroll
        for (int ai = 0; ai < 2; ++ai) { if (ai == 1 && u.half) break;
#pragma unroll
            for (int m = 0; m < 4; ++m) { f32x4 o[2]; const int row = row0 + ai * 128 + m * 16;
                float rs = 1.f; if (NORM) rs = 1.0f / sqrtf(ssq[row] * (1.f / D) + EPS);
#pragma unroll
                for (int n = 0; n < 2; ++n) { f32x4 g = acc[ai][0][m][n], uu = acc[ai][1][m][n];
                    if (NORM) { g = g * rs + sw[0][n]; uu = uu * rs + sw[1][n]; }
#pragma unroll
                    for (int j = 0; j < 4; ++j) o[n][j] = g[j] * sigm(g[j]) * uu[j]; }
                *(v4u*)(O + (size_t)row * FF + col0) = pack8(o[0], o[1]); } }
    }
};
DI f32x4 gsafe(const f32x4& g) { f32x4 r; for (int j = 0; j < 4; ++j) r[j] = fabsf(g[j]) < 1e-20f ? 1e-20f : g[j]; return r; }
template <bool NEXT, bool RECON, bool WRITE_X> struct EpiResid { static constexpr bool PERM = false, AFTER_DRAIN = false;
    const float* inA; const float* inB; const bf16* hin; const float* gain_prev; float* out; const float* mods; bf16* hn; const float* gain; float* ssq; int gslot; int scprev; int scslot; float coef;
    DI void operator()(EPI_ARGS) const {
        asm volatile("" : "+v"(fr), "+v"(fq));
        const int row0 = u.pm * 256 + wr * 64 + fr, col0 = u.pn * 256 + wc * 32 + 4 * fq;
        const float* mb = mods + mod_index(u.pm * 256) * NMODS; const float* gate = mb + gslot * D;
        f32x4 gv[2][2], gg[2][2], rg[2][2];
#pragma unroll
        for (int bj = 0; bj < 2; ++bj)
#pragma unroll
            for (int n = 0; n < 2; ++n) { const int c = col0 + bj * 128 + n * 16; gv[bj][n] = *(const f32x4*)(gate + c) * coef;
                if (NEXT) gg[bj][n] = gsafe(*(const f32x4*)(gain + c) * (*(const f32x4*)(mb + scslot * D + c) + 1.0f));
                if (RECON) { const f32x4 g = gsafe(*(const f32x4*)(gain_prev + c) * (*(const f32x4*)(mb + scprev * D + c) + 1.0f)); rg[bj][n] = (f32x4){1.0f / g.x, 1.0f / g.y, 1.0f / g.z, 1.0f / g.w}; } }
#pragma unroll
        for (int ai = 0; ai < 2; ++ai)
#pragma unroll
            for (int m = 0; m < 4; ++m) { const int row = row0 + ai * 128 + m * 16;
                const float* ip = row < MP ? inA + (size_t)row * D : inB + (size_t)(row - MP) * D; float s = 0.f;
#pragma unroll
                for (int bj = 0; bj < 2; ++bj)
#pragma unroll
                    for (int n = 0; n < 2; ++n) { const int c = col0 + bj * 128 + n * 16; f32x4 xin;
                        if (RECON) { const v2u w = *(const v2u*)(hin + (size_t)row * D + c); xin = (f32x4){bflo(w.x), bfhi(w.x), bflo(w.y), bfhi(w.y)} * rg[bj][n]; }
                        else xin = __builtin_nontemporal_load((const f32x4*)(ip + c));
                        const f32x4 x = xin + gv[bj][n] * acc[ai][bj][m][n];
                        if (WRITE_X) *(f32x4*)(out + (size_t)row * D + c) = x;
                        if (NEXT) { s += (x.x * x.x + x.y * x.y) + (x.z * x.z + x.w * x.w); const f32x4 y = x * gg[bj][n]; v2u w; w.x = pk2(y.x, y.y); w.y = pk2(y.z, y.w); *(v2u*)(hn + (size_t)row * D + c) = w; } }
                if (NEXT) { s += __shfl_xor(s, 16); s += __shfl_xor(s, 32); if (fq == 0) atomicAdd(ssq + row, s); } }
    }
};
struct EpiFinal { static constexpr bool PERM = false, AFTER_DRAIN = true; const bf16* hin; const float* gain_prev; float* out; const float* mods; const float* fgain; float* xbuf; unsigned* cnt; int gslot; int scprev; float coef;
    DI void operator()(EPI_ARGS) const {}
    DI void fused(f32x4 (&acc)[2][2][4][2], const Unit& u, int wr, int wc, int fr, int fq, LAS unsigned char* lds, int wid, int lane) const {
        const int tid = wid * 64 + lane;
        const int row0 = u.pm * 256 + wr * 64 + fr, col0 = u.pn * 256 + wc * 32 + 4 * fq;
        const float* gate = mods + mod_index(u.pm * 256) * NMODS + gslot * D;
        LAS float* P = (LAS float*)lds; LAS float* S = (LAS float*)(lds + 4096);
        f32x4 gv[2][2], rg[2][2]; const float* mb = mods + mod_index(u.pm * 256) * NMODS;
#pragma unroll
        for (int bj = 0; bj < 2; ++bj)
#pragma unroll
            for (int n = 0; n < 2; ++n) { const int c = col0 + bj * 128 + n * 16; gv[bj][n] = *(const f32x4*)(gate + c) * coef;
                const f32x4 g = gsafe(*(const f32x4*)(gain_prev + c) * (*(const f32x4*)(mb + scprev * D + c) + 1.0f)); rg[bj][n] = (f32x4){1.0f / g.x, 1.0f / g.y, 1.0f / g.z, 1.0f / g.w}; }
#pragma unroll
        for (int ai = 0; ai < 2; ++ai)
#pragma unroll
            for (int m = 0; m < 4; ++m) { const int row = row0 + ai * 128 + m * 16; const bf16* ip = hin + (size_t)row * D; float s = 0.f;
#pragma unroll
                for (int bj = 0; bj < 2; ++bj)
#pragma unroll
                    for (int n = 0; n < 2; ++n) { const v2u w = __builtin_nontemporal_load((const v2u*)(ip + col0 + bj * 128 + n * 16)); const f32x4 x = (f32x4){bflo(w.x), bfhi(w.x), bflo(w.y), bfhi(w.y)} * rg[bj][n] + gv[bj][n] * acc[ai][bj][m][n]; acc[ai][bj][m][n] = x; s += (x.x * x.x + x.y * x.y) + (x.z * x.z + x.w * x.w); }
                s += __shfl_xor(s, 16); s += __shfl_xor(s, 32);
                if (fq == 0) P[(ai * 128 + wr * 64 + m * 16 + fr) * 4 + wc] = s; }
        LDS_WAIT(); __syncthreads();
        if (tid < 256) { const f32x4 p = *(const LAS f32x4*)(P + tid * 4);
            __hip_atomic_store(xbuf + (size_t)(u.pm * 256 + tid) * 4 + u.pn, (p.x + p.y) + (p.z + p.w), __ATOMIC_RELAXED, __HIP_MEMORY_SCOPE_AGENT);
            asm volatile("s_waitcnt vmcnt(0)" ::: "memory");
            if (lane == 0) __hip_atomic_fetch_add(cnt + 64 * u.pm, 1u, __ATOMIC_RELAXED, __HIP_MEMORY_SCOPE_AGENT); }
        if (wid == 0) { unsigned sp = 0;
            while ((unsigned)__builtin_amdgcn_readfirstlane(__hip_atomic_load(cnt + 64 * u.pm, __ATOMIC_RELAXED, __HIP_MEMORY_SCOPE_AGENT)) < 16u) { __builtin_amdgcn_s_sleep(2); if (++sp > (1u << 22)) break; }
            __builtin_amdgcn_fence(__ATOMIC_ACQUIRE, "agent"); }
        asm volatile("s_waitcnt vmcnt(0) lgkmcnt(0)" ::: "memory"); __syncthreads();
        if (tid < 256) { const float* xp = xbuf + (size_t)(u.pm * 256 + tid) * 4; float t = 0.f;
#pragma unroll
            for (int q = 0; q < 4; ++q) t += __hip_atomic_load(xp + q, __ATOMIC_RELAXED, __HIP_MEMORY_SCOPE_AGENT);
            S[tid] = 1.0f / sqrtf(t * (1.f / D) + EPS); }
        LDS_WAIT(); __syncthreads();
        f32x4 fg[2][2];
#pragma unroll
        for (int bj = 0; bj < 2; ++bj)
#pragma unroll
            for (int n = 0; n < 2; ++n) fg[bj][n] = *(const f32x4*)(fgain + col0 + bj * 128 + n * 16);
#pragma unroll
        for (int ai = 0; ai < 2; ++ai)
#pragma unroll
            for (int m = 0; m < 4; ++m) { const int rl = ai * 128 + wr * 64 + m * 16 + fr; const float rs = S[rl]; float* op = out + (size_t)(u.pm * 256 + rl) * D;
#pragma unroll
                for (int bj = 0; bj < 2; ++bj)
#pragma unroll
                    for (int n = 0; n < 2; ++n) __builtin_nontemporal_store(acc[ai][bj][m][n] * rs * fg[bj][n], (f32x4*)(op + col0 + bj * 128 + n * 16)); }
    }
};
struct EpiWin { static constexpr bool PERM = true, AFTER_DRAIN = false;
    bf16 *qa, *ka, *vaT, *qlat, *ckv, *ga, *gb, *krope; float *ssq_q, *ssq_kv; float* out; const float2* ropeA; const float2* ropeB; bool do_ssq; const float* ssq1; const float* shW;
    DI void operator()(EPI_ARGS) const {
        asm volatile("" : "+v"(fr), "+v"(fq));
        const int pn = u.pn; const bool sample = u.pm >= 32;
        const int rbase = u.pm * 256 + (u.half == 2 ? 128 : 0) + wr * 64 + fr;
        f32x4 sw[2][2]; { const float* sp = shW + mod_index(u.pm * 256) * NINP + pn * 256 + wc * 32 + 8 * fq;
#pragma unroll
            for (int bj = 0; bj < 2; ++bj)
#pragma unroll
                for (int n = 0; n < 2; ++n) sw[bj][n] = *(const f32x4*)(sp + bj * 128 + 4 * n); }
#define WACC(ai, bj, m, n) (acc[ai][bj][m][n] * rs + sw[bj][n])
        if (pn < 3) {
#pragma unroll
            for (int ai = 0; ai < 2; ++ai) { if (ai == 1 && u.half) break;
#pragma unroll
                for (int m = 0; m < 4; ++m) { const int row = rbase + ai * 128 + m * 16; const float rs = 1.0f / sqrtf(ssq1[row] * (1.f / D) + EPS); const int t = (row - MP) & 2047; const int pos = (wc & 1) ? (t & 63) : (t >> 6);
                    const float2* cs = ropeA + pos * 16 + 8 * (fq & 1); const float sgn = (fq & 2) ? 1.f : -1.f;
#pragma unroll
                    for (int bj = 0; bj < 2; ++bj) { f32x4 v0 = WACC(ai, bj, m, 0), v1 = WACC(ai, bj, m, 1); const int cl = bj * 128 + wc * 32 + 8 * fq;
                        if (pn < 2) { if (sample) rope8(v0, v1, cs, 32, sgn); v0 = v0 * A_QS; v1 = v1 * A_QS; *(v4u*)(qa + (size_t)row * 512 + pn * 256 + cl) = pack8(v0, v1); }
                        else if (bj == 0) { if (sample) rope8(v0, v1, cs, 32, sgn); *(v4u*)(ka + (size_t)row * 128 + cl) = pack8(v0, v1);
                            if (!sample) { float* o = out + OUT_K + (size_t)row * 128 + cl; __builtin_nontemporal_store(v0, (f32x4*)o); __builtin_nontemporal_store(v1, (f32x4*)(o + 4)); } }
                        else { const int c = cl - 128;
#pragma unroll
                            for (int j = 0; j < 4; ++j) { vaT[(size_t)(c + j) * MALL + row] = (bf16)f2bf(v0[j]); vaT[(size_t)(c + 4 + j) * MALL + row] = (bf16)f2bf(v1[j]); }
                            if (!sample) { float* o = out + OUT_V + (size_t)row * 128 + c; __builtin_nontemporal_store(v0, (f32x4*)o); __builtin_nontemporal_store(v1, (f32x4*)(o + 4)); } } } } }
        } else if (pn < 5) {
            bf16* dst = pn == 3 ? qlat : ckv; float* ssq = pn == 3 ? ssq_q : ssq_kv;
#pragma unroll
            for (int ai = 0; ai < 2; ++ai) { if (ai == 1 && u.half) break;
#pragma unroll
                for (int m = 0; m < 4; ++m) { const int row = rbase + ai * 128 + m * 16; const float rs = 1.0f / sqrtf(ssq1[row] * (1.f / D) + EPS); float s = 0.f;
#pragma unroll
                    for (int bj = 0; bj < 2; ++bj) { const f32x4 v0 = WACC(ai, bj, m, 0), v1 = WACC(ai, bj, m, 1);
                        s += (v0.x * v0.x + v0.y * v0.y) + (v0.z * v0.z + v0.w * v0.w) + (v1.x * v1.x + v1.y * v1.y) + (v1.z * v1.z + v1.w * v1.w);
                        *(v4u*)(dst + (size_t)row * 256 + bj * 128 + wc * 32 + 8 * fq) = pack8(v0, v1); }
                    s += __shfl_xor(s, 16); s += __shfl_xor(s, 32);
                    if (fq == 0 && do_ssq) atomicAdd(ssq + row, s); } }
        } else if (pn < 13) {
            const int ct = (pn - 5) * 128 + wc * 32 + 8 * fq;
#pragma unroll
            for (int ai = 0; ai < 2; ++ai) { if (ai == 1 && u.half) break;
#pragma unroll
                for (int m = 0; m < 4; ++m) { const int row = rbase + ai * 128 + m * 16; const float rs = 1.0f / sqrtf(ssq1[row] * (1.f / D) + EPS);
                    f32x4 r0, r1, b0, b1;
                    { const f32x4 a0 = WACC(ai, 0, m, 0), a1 = WACC(ai, 0, m, 1), c0 = WACC(ai, 1, m, 0), c1 = WACC(ai, 1, m, 1);
#pragma unroll
                      for (int j = 0; j < 4; ++j) { b0[j] = sigm(c0[j]); b1[j] = sigm(c1[j]); r0[j] = sigm(a0[j]) * frcp(fmaxf(b0[j], 1e-30f)); r1[j] = sigm(a1[j]) * frcp(fmaxf(b1[j], 1e-30f)); } }
                    *(v4u*)(ga + (size_t)row * D + ct) = pack8(r0, r1); *(v4u*)(gb + (size_t)row * D + ct) = pack8(b0, b1); } }
        } else if (wc == 0) {
#pragma unroll
            for (int ai = 0; ai < 2; ++ai) { if (ai == 1 && u.half) break;
#pragma unroll
                for (int m = 0; m < 4; ++m) { const int row = rbase + ai * 128 + m * 16; const float rs = 1.0f / sqrtf(ssq1[row] * (1.f / D) + EPS); const int t = (row - MP) & 2047; const int pos = (fq & 2) ? (t & 63) : (t >> 6);
                    f32x4 v0 = WACC(ai, 0, m, 0), v1 = WACC(ai, 0, m, 1);
                    if (sample) rope8(v0, v1, ropeB + pos * 8, 16, (fq & 1) ? 1.f : -1.f);
                    *(v4u*)(krope + (size_t)row * 32 + 8 * fq) = pack8(v0, v1);
                    if (!sample) { float* o = out + OUT_KR + (size_t)row * 32 + 8 * fq; __builtin_nontemporal_store(v0, (f32x4*)o); __builtin_nontemporal_store(v1, (f32x4*)(o + 4)); } } }
        }
    }
};
#undef WACC
struct EpiQB { static constexpr bool PERM = true, AFTER_DRAIN = false; bf16* qb; const float* ssq; const float2* ropeB;
    DI void operator()(EPI_ARGS) const {
        asm volatile("" : "+v"(fr), "+v"(fq));
        const int rbase = u.pm * 256 + wr * 64 + fr; const bool sample = u.pm >= 32;
#pragma unroll
        for (int ai = 0; ai < 2; ++ai)
#pragma unroll
            for (int m = 0; m < 4; ++m) { const int row = rbase + ai * 128 + m * 16; const float rs = 1.0f / sqrtf(ssq[row] * (1.f / 256.f) + EPS);
                const int t = (row - MP) & 2047; const int pos = (fq & 2) ? (t & 63) : (t >> 6);
#pragma unroll
                for (int bj = 0; bj < 2; ++bj) { f32x4 v0 = acc[ai][bj][m][0] * rs, v1 = acc[ai][bj][m][1] * rs;
                    if (u.pn == 2 && sample) rope8(v0, v1, ropeB + pos * 8, 16, (fq & 1) ? 1.f : -1.f);
                    *(v4u*)(qb + (size_t)row * 768 + u.pn * 256 + bj * 128 + wc * 32 + 8 * fq) = pack8(v0, v1); } }
    }
};
struct EpiKN { static constexpr bool PERM = true, AFTER_DRAIN = false; bf16* kn; const float* ssq;
    DI void operator()(EPI_ARGS) const {
        asm volatile("" : "+v"(fr), "+v"(fq));
        const int rbase = u.pm * 256 + wr * 64 + fr; const bool lat = u.pm < 64;
#pragma unroll
        for (int ai = 0; ai < 2; ++ai)
#pragma unroll
            for (int m = 0; m < 4; ++m) { const int row = rbase + ai * 128 + m * 16; const float rs = lat ? 1.0f / sqrtf(ssq[row] * (1.f / 256.f) + EPS) : 1.0f;
#pragma unroll
                for (int bj = 0; bj < 2; ++bj) *(v4u*)(kn + (size_t)row * 512 + u.pn * 256 + bj * 128 + wc * 32 + 8 * fq) = pack8(acc[ai][bj][m][0] * rs, acc[ai][bj][m][1] * rs); }
    }
};
struct EpiVT { static constexpr bool PERM = true, AFTER_DRAIN = false; bf16* vt; const float* ssq;
    DI void operator()(EPI_ARGS) const {
        asm volatile("" : "+v"(fr), "+v"(fq));
        const int rbase = u.pm * 256 + wr * 64 + fr; const bool lat = u.pn < 64;
        f32x4 rs[2][2];
#pragma unroll
        for (int bj = 0; bj < 2; ++bj)
#pragma unroll
            for (int n = 0; n < 2; ++n) { const int c = u.pn * 256 + bj * 128 + wc * 32 + 8 * fq + 4 * n;
                if (lat) { const f32x4 q = *(const f32x4*)(ssq + c); rs[bj][n] = (f32x4){1.0f / sqrtf(q.x * (1.f / 256.f) + EPS), 1.0f / sqrtf(q.y * (1.f / 256.f) + EPS), 1.0f / sqrtf(q.z * (1.f / 256.f) + EPS), 1.0f / sqrtf(q.w * (1.f / 256.f) + EPS)}; }
                else rs[bj][n] = (f32x4){1.f, 1.f, 1.f, 1.f}; }
#pragma unroll
        for (int ai = 0; ai < 2; ++ai)
#pragma unroll
            for (int m = 0; m < 4; ++m) { const int row = rbase + ai * 128 + m * 16;
#pragma unroll
                for (int bj = 0; bj < 2; ++bj) *(v4u*)(vt + (size_t)row * MALL + u.pn * 256 + bj * 128 + wc * 32 + 8 * fq) = pack8(acc[ai][bj][m][0] * rs[bj][0], acc[ai][bj][m][1] * rs[bj][1]); }
    }
};
template <bool SECOND> struct EpiMerge { static constexpr bool PERM = true, AFTER_DRAIN = false; bf16* mm; const bf16* g;
    DI void operator()(EPI_ARGS) const {
        asm volatile("" : "+v"(fr), "+v"(fq));
        const int rbase = u.pm * 256 + wr * 64 + fr;
#pragma unroll
        for (int ai = 0; ai < 2; ++ai)
#pragma unroll
            for (int m = 0; m < 4; ++m) { const int row = rbase + ai * 128 + m * 16;
#pragma unroll
                for (int bj = 0; bj < 2; ++bj) { const size_t o = (size_t)row * D + u.pn * 256 + bj * 128 + wc * 32 + 8 * fq;
                    f32x4 g0, g1; unpack8(*(const v4u*)(g + o), g0, g1); f32x4 v0 = acc[ai][bj][m][0] * g0, v1 = acc[ai][bj][m][1] * g1;
                    if (SECOND) { f32x4 p0, p1; unpack8(*(const v4u*)(mm + o), p0, p1); v0 += p0; v1 += p1; }
                    *(v4u*)(mm + o) = pack8(v0, v1); } }
    }
};

struct EpiMergeK { static constexpr bool PERM = true, AFTER_DRAIN = false, MIDK = true; bf16* mm; const bf16* ga; const bf16* gb;
    DI void mid(f32x4 (&acc)[2][2][4][2], const Unit& u, int wr, int wc, int fr, int fq) const {
        asm volatile("" : "+v"(fr), "+v"(fq));
        const int rbase = u.pm * 256 + wr * 64 + fr;
#pragma unroll
        for (int ai = 0; ai < 2; ++ai)
#pragma unroll
            for (int m = 0; m < 4; ++m) { const int row = rbase + ai * 128 + m * 16;
#pragma unroll
                for (int bj = 0; bj < 2; ++bj) { const size_t o = (size_t)row * D + u.pn * 256 + bj * 128 + wc * 32 + 8 * fq;
                    f32x4 a0, a1; unpack8(__builtin_nontemporal_load((const v4u*)(ga + o)), a0, a1);
                    acc[ai][bj][m][0] = acc[ai][bj][m][0] * a0; acc[ai][bj][m][1] = acc[ai][bj][m][1] * a1; } }
    }
    DI void operator()(EPI_ARGS) const {
        asm volatile("" : "+v"(fr), "+v"(fq));
        const int rbase = u.pm * 256 + wr * 64 + fr;
#pragma unroll
        for (int ai = 0; ai < 2; ++ai)
#pragma unroll
            for (int m = 0; m < 4; ++m) { const int row = rbase + ai * 128 + m * 16;
#pragma unroll
                for (int bj = 0; bj < 2; ++bj) { const size_t o = (size_t)row * D + u.pn * 256 + bj * 128 + wc * 32 + 8 * fq;
                    f32x4 b0, b1; unpack8(__builtin_nontemporal_load((const v4u*)(gb + o)), b0, b1);
                    *(v4u*)(mm + o) = pack8(acc[ai][bj][m][0] * b0, acc[ai][bj][m][1] * b1); } }
    }
};
static_assert(pg8::MidK<EpiMergeK>::value && !pg8::MidK<EpiWin>::value, "mid-K hook trait");
#define MFMA32(a, b, c) __builtin_amdgcn_mfma_f32_32x32x16_bf16((a), (b), (c), 0, 0, 0)
#ifndef ATT_RS
#define ATT_RS 16.0f
#endif
template <int DQ>
DI void attn_unit(LAS unsigned char* lds, int tid, int lane,
                  const bf16* qn, int ldqn, const bf16* qr, int ldqr,
                  const bf16* Kb, int ldk, const bf16* Kr, const bf16* Vt,
                  int s0_tok, int s0_n, int s1_tok, int s1_n, bool band, int qtok,
                  float sink_l2, bool has_sink, bf16* outp, int ldo) {
    constexpr int KS = DQ * 2 + 16, VS = 144, BUF = 64 * KS + 64 * VS, NKS = DQ / 16;
    const int r = lane & 31, hh = lane >> 5;
    const int pr = (r & ~12) | ((r & 4) << 1) | ((r & 8) >> 1);
    bf16x8 qf[NKS];
#pragma unroll
    for (int ks = 0; ks < NKS; ++ks) qf[ks] = ks < 4 ? __builtin_nontemporal_load((const bf16x8*)(qn + (size_t)r * ldqn + 16 * ks + 8 * hh)) : __builtin_nontemporal_load((const bf16x8*)(qr + (size_t)r * ldqr + 16 * (ks - 4) + 8 * hh));
    f32x16 ot[2];
#pragma unroll
    for (int i = 0; i < 16; ++i) { ot[0][i] = 0.f; ot[1][i] = 0.f; }
    float mrun = 0.f; f32x16 lacc;
#pragma unroll
    for (int i = 0; i < 16; ++i) lacc[i] = 0.f;
    const int ntile = s0_n + s1_n;
    const int krow = tid >> 3, kch = tid & 7, rrow = tid >> 2, rch = tid & 3;
    v4u kreg, rreg, vreg;
    auto tile_tok = [&](int t) { return t < s0_n ? s0_tok + 64 * t : s1_tok + 64 * (t - s0_n); };
    auto gload = [&](int t) { const int tok0 = tile_tok(t);
        kreg = *(const v4u*)(Kb + (size_t)(tok0 + krow) * ldk + kch * 8);
        if (DQ == 96) { if (tid < 256) rreg = *(const v4u*)(Kr + (size_t)(tok0 + rrow) * 32 + rch * 8); }
        vreg = *(const v4u*)(Vt + (size_t)krow * MALL + tok0 + kch * 8); };
    auto lstore = [&](int b) { LAS unsigned char* kb_ = lds + b * BUF;
        *(LAS v4u*)(kb_ + krow * KS + kch * 16) = kreg;
        if (DQ == 96) { if (tid < 256) *(LAS v4u*)(kb_ + rrow * KS + 128 + rch * 16) = rreg; }
        *(LAS v4u*)(kb_ + 64 * KS + krow * VS + kch * 16) = vreg; };
    gload(0); lstore(0); __syncthreads();
    for (int t = 0; t < ntile; ++t) {
        const bool more = t + 1 < ntile;
        if (more) gload(t + 1);
        LAS unsigned char* kb_ = lds + (t & 1) * BUF; LAS unsigned char* vb_ = kb_ + 64 * KS;
        f32x16 st[2];
#pragma unroll
        for (int kb = 0; kb < 2; ++kb) {
#pragma unroll
            for (int i = 0; i < 16; ++i) st[kb][i] = 0.f;
#pragma unroll
            for (int ks = 0; ks < NKS; ++ks) { const bf16x8 kf = *(const LAS bf16x8*)(kb_ + (32 * kb + pr) * KS + (16 * ks + 8 * hh) * 2); st[kb] = MFMA32(kf, qf[ks], st[kb]); }
        }
        __builtin_amdgcn_sched_barrier(0);
        if (band && t < s0_n) { const int d0 = tile_tok(t) + 8 * hh - (qtok + r);
#pragma unroll
            for (int kb = 0; kb < 2; ++kb)
#pragma unroll
                for (int i = 0; i < 16; ++i) { const int d = d0 + 32 * kb + 16 * (i >> 3) + (i & 7); if (d > 128 || d < -128) st[kb][i] = -1e30f; } }
        float mx;
        { const f32x16& A = st[0]; const f32x16& B = st[1];
          float m0 = fmaxf(fmaxf(A[0], A[1]), A[2]), m1 = fmaxf(fmaxf(A[3], A[4]), A[5]), m2 = fmaxf(fmaxf(A[6], A[7]), A[8]), m3 = fmaxf(fmaxf(A[9], A[10]), A[11]);
          m0 = fmaxf(fmaxf(m0, A[12]), A[13]); m1 = fmaxf(fmaxf(m1, A[14]), A[15]); m2 = fmaxf(fmaxf(m2, B[0]), B[1]); m3 = fmaxf(fmaxf(m3, B[2]), B[3]);
          m0 = fmaxf(fmaxf(m0, B[4]), B[5]); m1 = fmaxf(fmaxf(m1, B[6]), B[7]); m2 = fmaxf(fmaxf(m2, B[8]), B[9]); m3 = fmaxf(fmaxf(m3, B[10]), B[11]);
          m0 = fmaxf(fmaxf(m0, B[12]), B[13]); m1 = fmaxf(fmaxf(m1, B[14]), B[15]); mx = fmaxf(fmaxf(m0, m1), fmaxf(m2, m3)); }
        mx = fmaxf(mx, __shfl_xor(mx, 32));
        { const bool up = mx > mrun + ATT_RS, dn = (t == 0) && (mx < mrun - ATT_RS);
          if (__builtin_amdgcn_ballot_w64(up || dn) != 0ull) {
              if (t == 0) { mrun = (up || dn) ? mx : mrun; }
              else { const float mnew = up ? mx : mrun, alpha = fexp2(mrun - mnew); mrun = mnew; lacc = lacc * alpha; ot[0] = ot[0] * alpha; ot[1] = ot[1] * alpha; } } }
        if (__builtin_amdgcn_ballot_w64(mrun != 0.f) != 0ull) { st[0] = st[0] - mrun; st[1] = st[1] - mrun; }
#pragma unroll
        for (int kb = 0; kb < 2; ++kb)
#pragma unroll
            for (int i = 0; i < 16; ++i) st[kb][i] = fexp2(st[kb][i]);
        lacc = lacc + (st[0] + st[1]);
#pragma unroll
        for (int kb = 0; kb < 2; ++kb)
#pragma unroll
            for (int s = 0; s < 2; ++s) { v4u pw; pw.x = pk2(st[kb][8 * s], st[kb][8 * s + 1]); pw.y = pk2(st[kb][8 * s + 2], st[kb][8 * s + 3]); pw.z = pk2(st[kb][8 * s + 4], st[kb][8 * s + 5]); pw.w = pk2(st[kb][8 * s + 6], st[kb][8 * s + 7]);
                const bf16x8 pf = __builtin_bit_cast(bf16x8, pw);
#pragma unroll
                for (int db = 0; db < 2; ++db) { const bf16x8 vf = *(const LAS bf16x8*)(vb_ + (32 * db + r) * VS + (32 * kb + 16 * s + 8 * hh) * 2); ot[db] = MFMA32(vf, pf, ot[db]); } }
        __builtin_amdgcn_sched_barrier(0);
        if (more) lstore((t + 1) & 1);
        __syncthreads();
    }
    float lrun = ((lacc[0] + lacc[1]) + (lacc[2] + lacc[3])) + ((lacc[4] + lacc[5]) + (lacc[6] + lacc[7])) + (((lacc[8] + lacc[9]) + (lacc[10] + lacc[11])) + ((lacc[12] + lacc[13]) + (lacc[14] + lacc[15])));
    if (has_sink && hh == 0) lrun += fexp2(sink_l2 - mrun);
    const float inv = 1.0f / (lrun + __shfl_xor(lrun, 32));
#pragma unroll
    for (int db = 0; db < 2; ++db)
#pragma unroll
        for (int a4 = 0; a4 < 4; ++a4) { v2u w; w.x = pk2(ot[db][4 * a4] * inv, ot[db][4 * a4 + 1] * inv); w.y = pk2(ot[db][4 * a4 + 2] * inv, ot[db][4 * a4 + 3] * inv);
            *(v2u*)(outp + (size_t)r * ldo + 32 * db + 8 * a4 + 4 * hh) = w; }
}

DI void attn_phase(const Args& a, LAS unsigned char* lds, int tid, int wave, int lane) {
    unsigned char* ws = a.ws;
    const bf16* qa = (const bf16*)(ws + OFF_QA); const bf16* ka = (const bf16*)(ws + OFF_KA); const bf16* vaT = (const bf16*)(ws + OFF_VAT);
    const bf16* qb = (const bf16*)(ws + OFF_QB); const bf16* kn = (const bf16*)(ws + OFF_KN); const bf16* kr = (const bf16*)(ws + OFF_KROPE); const bf16* vbT = (const bf16*)(ws + OFF_VBT);
    bf16* oa = (bf16*)a.out; bf16* ob = oa + 512;
    const float* sink = a.in[15];
    for (int uu = blockIdx.x; uu < 1024; uu += gridDim.x) {
        const int type = uu >> 8, u0 = uu & 255, vu = (u0 & 7) * 32 + (u0 >> 3);
        if (type == 0) {
            const int b = vu >> 6, h = (vu >> 3) & 7, qblk = vu & 7; const int tok = MP + b * 2048 + qblk * 256 + 32 * wave;
            attn_unit<96>(lds, tid, lane, qb + (size_t)tok * 768 + h * 64, 768, qb + (size_t)tok * 768 + 512 + h * 32, 768, kn + h * 64, 512, kr, vbT + (size_t)(h * 64) * MALL,
                          M + b * 512, 8, MP + b * 2048, 32, false, 0, 0.f, false, ob + (size_t)tok * 1024 + h * 64, 1024);
        } else if (type == 1) {
            const int b = vu >> 6, kh = (vu >> 5) & 1, qblk = vu & 31; const int head = kh * 4 + (wave >> 1); const int tok = MP + b * 2048 + qblk * 64 + 32 * (wave & 1);
            const int lo = qblk - 2 < 0 ? 0 : qblk - 2, hi = qblk + 2 > 31 ? 31 : qblk + 2;
            attn_unit<64>(lds, tid, lane, qa + (size_t)tok * 512 + head * 64, 512, nullptr, 0, ka + kh * 64, 128, nullptr, vaT + (size_t)(kh * 64) * MALL,
                          MP + b * 2048 + lo * 64, hi - lo + 1, M + b * 512, 8, true, tok, sink[head] * LOG2E, true, oa + (size_t)tok * 1024 + head * 64, 1024);
        } else if (type == 2) {
            const int b = vu >> 3, kh = (vu >> 2) & 1, qblk = vu & 3; const int head = kh * 4 + (wave >> 1); const int tok = b * 256 + qblk * 64 + 32 * (wave & 1);
            attn_unit<64>(lds, tid, lane, qa + (size_t)tok * 512 + head * 64, 512, nullptr, 0, ka + kh * 64, 128, nullptr, vaT + (size_t)(kh * 64) * MALL,
                          b * 256, 4, 0, 0, false, 0, sink[head] * LOG2E, true, oa + (size_t)tok * 1024 + head * 64, 1024);
        } else {
            const int b = vu >> 3, h = vu & 7; const int tok = b * 256 + 32 * wave;
            attn_unit<96>(lds, tid, lane, qb + (size_t)tok * 768 + h * 64, 768, qb + (size_t)tok * 768 + 512 + h * 32, 768, kn + h * 64, 512, kr, vbT + (size_t)(h * 64) * MALL,
                          b * 256, 4, 0, 0, false, 0, 0.f, false, ob + (size_t)tok * 1024 + h * 64, 1024);
        }
    }
}

__global__ void __launch_bounds__(512, 2) mk_fwd(Args a) {
    extern __shared__ __attribute__((aligned(16))) unsigned char lds_raw[];
    LAS unsigned char* lds = (LAS unsigned char*)lds_raw;
    cg::grid_group grid = cg::this_grid();
    const int tid = threadIdx.x, lane = tid & 63, wave = __builtin_amdgcn_readfirstlane(tid >> 6);
    const int G = gridDim.x, gw = blockIdx.x * 8 + wave, NGW = G * 8, gtid = blockIdx.x * 512 + tid, NT = G * 512;
    unsigned char* ws = a.ws;
    float* mods = (float*)(ws + OFF_MODS); float* ssq_q = (float*)(ws + OFF_SSQQ); float* ssq_kv = (float*)(ws + OFF_SSQKV);
    const float2* ropeA = (const float2*)(ws + OFF_ROPEA); const float2* ropeB = (const float2*)(ws + OFF_ROPEB);
    bf16* H = (bf16*)(ws + OFF_H); bf16* ACT = (bf16*)(ws + OFF_ACT);
    float* xr = a.out;
    const int lo = a.ph_lo, hi = a.ph_hi;
#if defined(TSK)
    const unsigned long long ts_start = __builtin_amdgcn_s_memrealtime(); unsigned long long ts_k = 0;
#endif
    if (hi > 1000) grid.sync();
    volatile LAS unsigned* xst = (volatile LAS unsigned*)(lds + 131072);
    if (tid < 2) xst[tid] = 0u;
    __syncthreads();
    XcdBarrier xbar = xcd_barrier_post((unsigned*)(ws + OFF_BAR), xst);
#ifndef P6M
#define P6M 7
#endif
#ifndef PH_MASK
#define PH_MASK 0x3fff
#endif
#define IN(k) (((PH_MASK >> (k)) & 1) && lo <= (k) && (k) < hi)
#define INX(k) (IN(k) || (k) == 4 || (k) == 10)
#if defined(TSK)
#define SEAM(k) do { if (IN(k) && INX((k) + 1)) xcd_barrier(xbar); if ((k) == TSK) ts_k = __builtin_amdgcn_s_memrealtime(); } while (0)
#else
#define SEAM(k) do { if (IN(k) && INX((k) + 1)) xcd_barrier(xbar); } while (0)
#endif
    if (IN(0)) { p0_misc(a, gtid, NT); p0_ada(a, lds, tid); }
    SEAM(0);
    float* ssq1 = (float*)(ws + OFF_SSQ1); float* ssq2 = (float*)(ws + OFF_SSQ2); float* shW2 = (float*)(ws + OFF_SHW2); float* shW3 = (float*)(ws + OFF_SHW3);
    if (IN(1)) { norm_mod_phase(a.in[0], a.in[1], a.in[10], mods, 0, H, gw, NGW, lane); p0_weights(a, lds, gw, NGW, wave, lane, 0, P0_EARLY); }
    SEAM(1);
    if (IN(2)) { pg8::Gemm g{H, (const bf16*)(ws + OFF_WGU1), M, NGU, D}; pg8::StaticOrder S; S.init(M, NGU, G, (int)blockIdx.x); EpiSwiglu<false> E{ACT, nullptr, nullptr};
        pg8::gemm_phase<EpiSwiglu<false>, pg8::StaticOrder, PG8_ALIGN, PG8_SP2>(lds, g, S, E);
        { const int nwg = (M / 256) * (NGU / 256), rounds = (nwg + G - 1) / G, first_idle = nwg - (rounds - 1) * G;
          const int nidle = G - first_idle;
          if (nidle <= 0) { shw_phase((const bf16*)(ws + OFF_WIN), NINP, mods, 3, shW2, gw, NGW, lane); p0_weights(a, lds, gw, NGW, wave, lane, P0_EARLY, P0_NIT); }
          else if ((int)blockIdx.x >= first_idle) { const int gw2 = ((int)blockIdx.x - first_idle) * 8 + wave, NGW2 = nidle * 8;
              shw_phase((const bf16*)(ws + OFF_WIN), NINP, mods, 3, shW2, gw2, NGW2, lane);
              p0_weights(a, lds, gw2, NGW2, wave, lane, P0_EARLY, P0_NIT); } } }
    SEAM(2);
    if (IN(3)) { pg8::Gemm g{ACT, (const bf16*)(ws + OFF_WD1), M, D, FF}; pg8::StaticOrder S; S.init(M, D, G, (int)blockIdx.x); EpiResid<true, false, false> E{a.in[0], a.in[1], nullptr, nullptr, nullptr, mods, H, a.in[13], ssq1, 2, 0, 4, 0.5f};
        pg8::gemm_phase<EpiResid<true, false, false>, pg8::StaticOrder, PG8_ALIGN, PG8_SP2>(lds, g, S, E); }
    SEAM(3);
    if (IN(5)) { pg8::Gemm g{H, (const bf16*)(ws + OFF_WIN), M, NINP, D}; pg8::StaticOrder S; S.init(M, NINP, G, (int)blockIdx.x);
        EpiWin E{(bf16*)(ws + OFF_QA), (bf16*)(ws + OFF_KA), (bf16*)(ws + OFF_VAT), (bf16*)(ws + OFF_QLAT), (bf16*)(ws + OFF_CKV), (bf16*)(ws + OFF_GA), (bf16*)(ws + OFF_GB), (bf16*)(ws + OFF_KROPE),
                 ssq_q, ssq_kv, a.out, ropeA, ropeB, true, ssq1, shW2};
        pg8::gemm_phase<EpiWin, pg8::StaticOrder, PG8_ALIGN, PG8_SP2>(lds, g, S, E);
        { const int nwg = (M / 256) * (NINP / 256), rounds = (nwg + G - 1) / G, first_idle = nwg - (rounds - 1) * G, nidle = G - first_idle;
          if (nidle <= 0) { ctx_convert(a, gtid, NT); shw_phase((const bf16*)(ws + OFF_WGU2), NGU, mods, 6, shW3, gw, NGW, lane); }
          else if ((int)blockIdx.x >= first_idle) { ctx_convert(a, ((int)blockIdx.x - first_idle) * 512 + tid, nidle * 512);
              shw_phase((const bf16*)(ws + OFF_WGU2), NGU, mods, 6, shW3, ((int)blockIdx.x - first_idle) * 8 + wave, nidle * 8, lane); } }
#if defined(DUP5)
        xcd_barrier(xbar); E.do_ssq = false; pg8::gemm_phase<EpiWin, pg8::StaticOrder, PG8_ALIGN, PG8_SP2>(lds, g, S, E);
#endif
    }
    SEAM(5);
#if defined(DUP6)
    for (int rep6 = 0; rep6 < 2; ++rep6) { if (rep6) xcd_barrier(xbar);
#endif
    if (IN(6)) {
        int K6 = 256; asm volatile("" : "+s"(K6));
#if P6M & 1
        { pg8::Gemm g{(const bf16*)(ws + OFF_QLAT), (const bf16*)(ws + OFF_WUQ), M, 768, K6}; pg8::StaticOrder S; S.init(M, 768, G, (int)blockIdx.x); EpiQB E{(bf16*)(ws + OFF_QB), ssq_q, ropeB};
          pg8::gemm_phase<EpiQB, pg8::StaticOrder, PG8_ALIGN, PG8_SP2>(lds, g, S, E); }
#endif
#if P6M & 2
        { pg8::Gemm g{(const bf16*)(ws + OFF_CKV), (const bf16*)(ws + OFF_WK), MALL, 512, K6}; pg8::StaticOrder S; S.init(MALL, 512, G, (int)((blockIdx.x + 64) % G)); EpiKN E{(bf16*)(ws + OFF_KN), ssq_kv};
          pg8::gemm_phase<EpiKN, pg8::StaticOrder, PG8_ALIGN, PG8_SP2>(lds, g, S, E); }
#endif
#if P6M & 4
        { pg8::Gemm g{(const bf16*)(ws + OFF_WV), (const bf16*)(ws + OFF_CKV), 512, MALL, K6}; pg8::StaticOrder S; S.init(512, MALL, G, (int)((blockIdx.x + 176) % G)); EpiVT E{(bf16*)(ws + OFF_VBT), ssq_kv};
          pg8::gemm_phase<EpiVT, pg8::StaticOrder, PG8_ALIGN, PG8_SP2>(lds, g, S, E); }
#endif
        { const bf16* ckv = (const bf16*)(ws + OFF_CKV); const float* gn = a.in[17]; float* o = a.out + OUT_CKV;
          for (int row = gw; row < MP; row += NGW) { const float rs = 1.0f / sqrtf(ssq_kv[row] * (1.f / 256.f) + EPS); const v2u w = *(const v2u*)(ckv + (size_t)row * 256 + 4 * lane); const f32x4 g4 = *(const f32x4*)(gn + 4 * lane);
              __builtin_nontemporal_store((f32x4){bflo(w.x), bfhi(w.x), bflo(w.y), bfhi(w.y)} * rs * g4, (f32x4*)(o + (size_t)row * 256 + 4 * lane)); } }
    }
#if defined(DUP6)
    }
#endif
    SEAM(6);
    if (IN(7)) attn_phase(a, lds, tid, wave, lane);
#if defined(DUP7)
    xcd_barrier(xbar); attn_phase(a, lds, tid, wave, lane);
#endif
    SEAM(7);
    if (IN(8)) { pg8::Gemm g{(const bf16*)a.out, (const bf16*)(ws + OFF_WOA), M, D, D}; pg8::StaticOrder S; S.init(M, D, G, (int)blockIdx.x); EpiMergeK E{(bf16*)(ws + OFF_MM), (const bf16*)(ws + OFF_GA), (const bf16*)(ws + OFF_GB)};
        pg8::gemm_phase<EpiMergeK, pg8::StaticOrder, PG8_ALIGN, PG8_SP2>(lds, g, S, E); }
    SEAM(8);
    if (IN(9)) { pg8::Gemm g{(const bf16*)(ws + OFF_MM), (const bf16*)(ws + OFF_WOUT), M, D, D}; pg8::StaticOrder S; S.init(M, D, G, (int)blockIdx.x); EpiResid<true, true, false> E{nullptr, nullptr, H, a.in[13], nullptr, mods, H, a.in[23], ssq2, 5, 4, 7, 1.0f};
        pg8::gemm_phase<EpiResid<true, true, false>, pg8::StaticOrder, PG8_ALIGN, PG8_SP2>(lds, g, S, E); }
    SEAM(9);
    if (IN(11)) { pg8::Gemm g{H, (const bf16*)(ws + OFF_WGU2), M, NGU, D}; pg8::StaticOrder S; S.init(M, NGU, G, (int)blockIdx.x); EpiSwiglu<true> E{ACT, ssq2, shW3};
        pg8::gemm_phase<EpiSwiglu<true>, pg8::StaticOrder, PG8_ALIGN, PG8_SP2>(lds, g, S, E); }
    SEAM(11);
    if (IN(12)) { pg8::Gemm g{ACT, (const bf16*)(ws + OFF_WD2), M, D, FF}; pg8::StaticOrder S; S.init(M, D, G, (int)blockIdx.x);
        if (G == 256) { EpiFinal E{H, a.in[23], xr, mods, a.in[26], (float*)(ws + OFF_PARTQ), (unsigned*)(ws + OFF_PCNT), 8, 7, 0.5f};
            pg8::gemm_phase<EpiFinal, pg8::StaticOrder, false, PG8_SP2>(lds, g, S, E); }
        else { EpiResid<false, true, true> E{nullptr, nullptr, H, a.in[23], xr, mods, nullptr, nullptr, nullptr, 8, 7, 0, 0.5f};
            pg8::gemm_phase<EpiResid<false, true, true>, pg8::StaticOrder, PG8_ALIGN, PG8_SP2>(lds, g, S, E);
            xcd_barrier(xbar); final_norm_phase(xr, a.in[26], gw, NGW, lane); } }
#if defined(TSK)
    if (blockIdx.x == 0 && tid == 0) { const unsigned long long t_end = __builtin_amdgcn_s_memrealtime(); const unsigned long long want = 4ull * (ts_k - ts_start); while (__builtin_amdgcn_s_memrealtime() - t_end < want) __builtin_amdgcn_s_sleep(8); }
#endif
#ifdef PROBE_SCALE
    grid.sync();
    { const size_t ranges[6][2] = {{0, (size_t)MP * D}, {(size_t)MP * D, (size_t)M * D}, {OUT_K, OUT_V}, {OUT_V, OUT_CKV}, {OUT_CKV, OUT_KR}, {OUT_KR, OUT_KR + 8192 * 32}};
#pragma unroll
      for (int o = 0; o < 6; ++o) if ((PROBE_SCALE >> o) & 1) for (size_t i = ranges[o][0] + gtid; i < ranges[o][1]; i += NT) a.out[i] *= 1.01f; }
#endif
#undef IN
#undef SEAM
}

constexpr int N_PHASES = 14;
extern "C" void kernel_launch(void* const* d_in, const int* in_sizes, int n_in, void* d_out, int out_size, void* d_ws, size_t ws_size, hipStream_t stream) {
    static int grid = 0;
    if (grid == 0) {
        if (n_in != 27 || ws_size < WS_END) { fprintf(stderr, "kernel_launch: unexpected n_in %d / ws %zu\n", n_in, ws_size); grid = -1; return; }
        int dev = 0, cus = 0, per_cu = 0;
        hipGetDevice(&dev); hipDeviceGetAttribute(&cus, hipDeviceAttributeMultiprocessorCount, dev);
        if (hipFuncSetAttribute((const void*)mk_fwd, hipFuncAttributeMaxDynamicSharedMemorySize, LDS_BYTES) != hipSuccess) { fprintf(stderr, "kernel_launch: hipFuncSetAttribute failed\n"); grid = -1; return; }
        if (hipOccupancyMaxActiveBlocksPerMultiprocessor(&per_cu, (const void*)mk_fwd, 512, LDS_BYTES) != hipSuccess || per_cu < 1) { fprintf(stderr, "kernel_launch: occupancy query gave %d\n", per_cu); per_cu = 1; }
        (void)hipGetLastError();
        grid = cus * 1;
        fprintf(stderr, "kernel_launch: cus %d per_cu %d grid %d\n", cus, per_cu, grid);
    }
    if (grid < 0) return;
    (void)hipMemsetAsync(d_ws, 0, ZERO_BYTES, stream);
    Args a{};
    for (int i = 0; i < 27; ++i) a.in[i] = (const float*)d_in[i];
    a.out = (float*)d_out; a.ws = (unsigned char*)d_ws;
#if MK_N_LAUNCHES == 1
    a.ph_lo = 0; a.ph_hi = N_PHASES;
    void* args[] = {&a};
    hipError_t e = hipLaunchCooperativeKernel((const void*)mk_fwd, dim3(grid), dim3(512), args, LDS_BYTES, stream);
    if (e != hipSuccess) fprintf(stderr, "cooperative launch failed: %s (grid %d)\n", hipGetErrorString(e), grid);
#else
    for (int p = 0; p < N_PHASES; ++p) { a.ph_lo = p; a.ph_hi = p + 1; hipLaunchKernelGGL(mk_fwd, dim3(grid), dim3(512), LDS_BYTES, stream, a); }
#endif
}
```

```cpp
#include <hip/hip_runtime.h>
#include <hip/hip_cooperative_groups.h>
#include <cstdio>
#include <cstdint>
namespace cg = cooperative_groups;
namespace pg8 {
#define PG8_LAS __attribute__((address_space(3)))
typedef unsigned short bf16_t;
typedef short bf16x8 __attribute__((ext_vector_type(8)));
typedef float f32x4 __attribute__((ext_vector_type(4)));
typedef unsigned u32x4 __attribute__((ext_vector_type(4)));
constexpr int BM = 256, BK = 64, HALF = 128, HTB = HALF * BK * 2  , STAGE_BYTES = 8 * HTB, NXCD = 8, WGM = 8;

__host__ __device__ __forceinline__ int lds_byte(int r, int c) { const int st = (r >> 4) * 2 + (c >> 5), rr = r & 15, cc = c & 31, ob = rr * 64 + cc * 2; return st * 1024 + (ob ^ (((ob >> 9) & 1) << 5)); }
__host__ __device__ __forceinline__ void stage_rc(int b, int& R, int& C) { const int st = b / 1024, sb = b % 1024, swz = sb ^ (((sb >> 9) & 1) << 5); R = (st >> 1) * 16 + swz / 64; C = (st & 1) * 32 + (swz % 64) / 2; }
__host__ __device__ __forceinline__ int perm32(int rho) { const int n = rho >> 4, i = rho & 15; return 8 * (i >> 2) + 4 * n + (i & 3); }

struct Unit { int pm, pn, half; };
struct Gemm { const bf16_t* A; const bf16_t* Bt; int M, N, K; };

struct StaticOrder {
    int nM, nN, nwg, G, c;
    __host__ __device__ void init(int M, int N, int G_, int c_) { nM = M / BM; nN = N / BM; nwg = nM * nN; G = G_; c = c_; }
    __host__ __device__ bool next(int i, Unit& u) const { const long L = (long)i * G + c; if (L >= nwg) return false; map(L, u); return true; }
    __host__ __device__ void map(long L, Unit& u) const {
        int wgid = (int)L; { const int q = nwg / NXCD, r = nwg % NXCD, xcd = wgid % NXCD, off = wgid / NXCD; wgid = (xcd < r ? xcd * (q + 1) : r * (q + 1) + (xcd - r) * q) + off; }
        const int nig = WGM * nN, gid = wgid / nig, fm = gid * WGM, gsz = (nM - fm) < WGM ? (nM - fm) : WGM;
        u.pm = fm + ((wgid % nig) % gsz); u.pn = (wgid % nig) / gsz; u.half = 0;
    }
    __device__ __forceinline__ void a_ready(const Unit&) const {}
    __device__ __forceinline__ void done(const Unit&) const {}
};
struct TailOrder : StaticOrder {
    __host__ __device__ bool next(int i, Unit& u) const {
        const int full = nwg / G, rem = nwg - full * G;
        if (rem == 0 || 2 * rem > G || (rem & 7) || (G & 15)) return StaticOrder::next(i, u);
        if (i < full) return StaticOrder::next(i, u);
        if (i > full) return false;
        const int x = c & 7, j = c >> 3;
        if ((j >> 1) >= rem / 8) return false;
        map((long)full * G + 8 * (j >> 1) + x, u); u.half = 1 + (j & 1); return true;
    }
};
__device__ __forceinline__ unsigned cvt_pk_bf16(float lo, float hi) { unsigned r; asm volatile("v_cvt_pk_bf16_f32 %0, %1, %2" : "=v"(r) : "v"(lo), "v"(hi)); return r; }
typedef float f32x2 __attribute__((ext_vector_type(2)));
template <class T, class = void> struct MidK { static constexpr bool value = false; };
template <class T> struct MidK<T, decltype((void)T::MIDK)> { static constexpr bool value = T::MIDK; };
template <class Epi, class Sched, bool ALIGN_EPI = false, bool SP2 = false, int A_AUX = 0>
__device__ __forceinline__ void gemm_phase(PG8_LAS unsigned char* lds, const Gemm g, const Sched& S, const Epi& E) {
    const int tid = threadIdx.x, wid = __builtin_amdgcn_readfirstlane(tid >> 6), lane = tid & 63, wr = wid >> 2, wc = wid & 3, fr = lane & 15, fq = lane >> 4;
    const int K = g.K, nt = K / BK;
    unsigned voffA[2], voffB[2];
#pragma unroll
    for (int i = 0; i < 2; ++i) { int R, C; stage_rc(tid * 16 + i * 8192, R, C); const int Rb = Epi::PERM ? ((R & ~31) + perm32(R & 31)) : R;
        voffA[i] = (unsigned)(R * K + C) * 2u; voffB[i] = (unsigned)(Rb * K + C) * 2u; }
    const size_t kstep = (size_t)(BK * 2);
    const size_t hstep = (size_t)HALF * K * 2;
    const size_t tstep = 2 * hstep;
    const unsigned ldsw = (unsigned)wid * 1024u;
    const int aoff = lds_byte(wr * 64 + fr, fq * 8), boff = lds_byte(wc * 32 + fr, fq * 8);
#define PG8_SA(b, h) (((b) * 2 + (h)) * HTB)
#define PG8_SB(b, h) ((4 + (b) * 2 + (h)) * HTB)
#define PG8_STAGE(bufoff, gbase, voff) do { _Pragma("unroll") for (int _i = 0; _i < 2; ++_i) \
        __builtin_amdgcn_global_load_lds((const unsigned*)((const char*)(gbase) + (voff)[_i]), (PG8_LAS unsigned*)(lds + (bufoff) + ldsw + _i * 8192), 16, 0, 0); } while (0)
#define PG8_STAGEA(bufoff, gbase, voff) do { _Pragma("unroll") for (int _i = 0; _i < 2; ++_i) \
        __builtin_amdgcn_global_load_lds((const unsigned*)((const char*)(gbase) + (voff)[_i]), (PG8_LAS unsigned*)(lds + (bufoff) + ldsw + _i * 8192), 16, 0, A_AUX); } while (0)
#define PG8_LDA(dst, b, h) do { _Pragma("unroll") for (int m = 0; m < 4; ++m) _Pragma("unroll") for (int k = 0; k < 2; ++k) dst[m][k] = *(const PG8_LAS bf16x8*)(lds + PG8_SA(b, h) + aoff + m * 2048 + k * 1024); } while (0)
#define PG8_LDB(dst, b, h) do { _Pragma("unroll") for (int n = 0; n < 2; ++n) _Pragma("unroll") for (int k = 0; k < 2; ++k) dst[n][k] = *(const PG8_LAS bf16x8*)(lds + PG8_SB(b, h) + boff + n * 2048 + k * 1024); } while (0)
#define PG8_MMA(ai, bj, At, Bt) do { __builtin_amdgcn_s_setprio(1); _Pragma("unroll") for (int m = 0; m < 4; ++m) _Pragma("unroll") for (int n = 0; n < 2; ++n) _Pragma("unroll") for (int k = 0; k < 2; ++k) \
        acc[ai][bj][m][n] = __builtin_amdgcn_mfma_f32_16x16x32_bf16(Bt[n][k], At[m][k], acc[ai][bj][m][n], 0, 0, 0); __builtin_amdgcn_s_setprio(0); } while (0)
#define PG8_WAIT_V(n) asm volatile("s_waitcnt vmcnt(" #n ")" ::: "memory")
#define PG8_WAIT_L(n) asm volatile("s_waitcnt lgkmcnt(" #n ")" ::: "memory")
#define PG8_BAR __builtin_amdgcn_s_barrier()
#define PG8_SCHED __builtin_amdgcn_sched_barrier(0)
    Unit cur, nxt; int ui = 0;
    if (!S.next(0, cur)) return;
    f32x4 acc[2][2][4][2];
#pragma unroll
    for (int a = 0; a < 2; ++a)
#pragma unroll
        for (int b = 0; b < 2; ++b)
#pragma unroll
            for (int m = 0; m < 4; ++m)
#pragma unroll
                for (int n = 0; n < 2; ++n) acc[a][b][m][n] = (f32x4){0.f, 0.f, 0.f, 0.f};
    bf16x8 At[4][2], B0[2][2], B1[2][2];
    const char* cA = (const char*)g.A + (size_t)cur.pm * tstep + (cur.half == 2 ? hstep : (size_t)0); const char* cB = (const char*)g.Bt + (size_t)cur.pn * tstep;
    S.a_ready(cur);
    if constexpr (SP2) {
        PG8_STAGE(PG8_SB(0, 0), cB, voffB); PG8_STAGE(PG8_SB(0, 1), cB + hstep, voffB); PG8_STAGEA(PG8_SA(0, 0), cA, voffA); PG8_STAGEA(PG8_SA(0, 1), cA + hstep, voffA);
        if (wr == 1) PG8_BAR;
        PG8_WAIT_V(2); PG8_BAR;
        PG8_STAGE(PG8_SB(1, 0), cB + kstep, voffB); PG8_STAGEA(PG8_SA(1, 0), cA + kstep, voffA); PG8_STAGE(PG8_SB(1, 1), cB + hstep + kstep, voffB);
        PG8_WAIT_V(6); PG8_BAR;
    } else {
        PG8_STAGE(PG8_SB(0, 0), cB, voffB); PG8_STAGEA(PG8_SA(0, 0), cA, voffA); PG8_STAGE(PG8_SB(0, 1), cB + hstep, voffB); PG8_STAGEA(PG8_SA(0, 1), cA + hstep, voffA);
        if (wr == 1) PG8_BAR;
        PG8_WAIT_V(4); PG8_BAR;
        PG8_STAGE(PG8_SB(1, 0), cB + kstep, voffB); PG8_STAGEA(PG8_SA(1, 0), cA + kstep, voffA); PG8_STAGE(PG8_SB(1, 1), cB + hstep + kstep, voffB);
        PG8_WAIT_V(6); PG8_BAR;
    }
    for (;;) {
        const bool has_next = S.next(ui + 1, nxt);
        const char* nA = has_next ? (const char*)g.A + (size_t)nxt.pm * tstep + (nxt.half == 2 ? hstep : (size_t)0) : cA; const char* nB = has_next ? (const char*)g.Bt + (size_t)nxt.pn * tstep : cB;
        for (int t = 0; t < nt; t += 2) {
            const bool last = (t == nt - 2);
            const char* a1 = cA + (size_t)(t + 1) * kstep;
            const char* a2 = last ? nA : cA + (size_t)(t + 2) * kstep; const char* b2 = last ? nB : cB + (size_t)(t + 2) * kstep;
            const char* a3 = a2 + kstep; const char* b3 = b2 + kstep;
            if constexpr (MidK<Epi>::value) { if (t == nt / 2) E.mid(acc, cur, wr, wc, fr, fq); }
            if (last && has_next) S.a_ready(nxt);
            if constexpr (SP2) {
            PG8_LDB(B0, 0, 0); PG8_LDB(B1, 0, 1); PG8_SCHED; PG8_LDA(At, 0, 0); PG8_STAGEA(PG8_SA(1, 1), a1 + hstep, voffA);
            PG8_WAIT_V(8); PG8_WAIT_L(0); PG8_BAR; PG8_MMA(0, 0, At, B0); PG8_MMA(0, 1, At, B1); PG8_BAR; PG8_SCHED;
            PG8_LDA(At, 0, 1); PG8_STAGE(PG8_SB(0, 0), b2, voffB); PG8_STAGE(PG8_SB(0, 1), b2 + hstep, voffB); PG8_STAGEA(PG8_SA(0, 0), a2, voffA);
            PG8_WAIT_V(8); PG8_WAIT_L(0); PG8_BAR; PG8_MMA(1, 0, At, B0); PG8_MMA(1, 1, At, B1); PG8_BAR; PG8_SCHED;
            PG8_LDB(B0, 1, 0); PG8_LDB(B1, 1, 1); PG8_SCHED; PG8_LDA(At, 1, 0); PG8_STAGEA(PG8_SA(0, 1), a2 + hstep, voffA);
            PG8_WAIT_V(8); PG8_WAIT_L(0); PG8_BAR; PG8_MMA(0, 0, At, B0); PG8_MMA(0, 1, At, B1); PG8_BAR; PG8_SCHED;
            PG8_LDA(At, 1, 1); PG8_STAGE(PG8_SB(1, 0), b3, voffB); PG8_STAGE(PG8_SB(1, 1), b3 + hstep, voffB); PG8_STAGEA(PG8_SA(1, 0), a3, voffA);
            PG8_WAIT_V(8); PG8_WAIT_L(0); PG8_BAR; PG8_MMA(1, 0, At, B0); PG8_MMA(1, 1, At, B1); PG8_BAR; PG8_SCHED;
            } else {
            PG8_LDB(B0, 0, 0); PG8_SCHED; PG8_LDA(At, 0, 0); PG8_STAGEA(PG8_SA(1, 1), a1 + hstep, voffA);
            PG8_WAIT_L(8); PG8_BAR; PG8_WAIT_L(0); PG8_MMA(0, 0, At, B0); PG8_BAR; PG8_SCHED;
            PG8_LDB(B1, 0, 1); PG8_STAGE(PG8_SB(0, 0), b2, voffB);
            PG8_BAR; PG8_WAIT_L(0); PG8_MMA(0, 1, At, B1); PG8_BAR;
            PG8_LDA(At, 0, 1); PG8_STAGEA(PG8_SA(0, 0), a2, voffA);
            PG8_BAR; PG8_WAIT_L(0); PG8_MMA(1, 0, At, B0); PG8_BAR; PG8_SCHED;
            PG8_STAGE(PG8_SB(0, 1), b2 + hstep, voffB);
            PG8_WAIT_V(6); PG8_BAR; PG8_MMA(1, 1, At, B1); PG8_BAR;
            PG8_LDB(B0, 1, 0); PG8_SCHED; PG8_LDA(At, 1, 0); PG8_STAGEA(PG8_SA(0, 1), a2 + hstep, voffA);
            PG8_WAIT_L(8); PG8_BAR; PG8_WAIT_L(0); PG8_MMA(0, 0, At, B0); PG8_BAR; PG8_SCHED;
            PG8_LDB(B1, 1, 1); PG8_STAGE(PG8_SB(1, 0), b3, voffB);
            PG8_BAR; PG8_WAIT_L(0); PG8_MMA(0, 1, At, B1); PG8_BAR;
            PG8_LDA(At, 1, 1); PG8_STAGEA(PG8_SA(1, 0), a3, voffA);
            PG8_BAR; PG8_WAIT_L(0); PG8_MMA(1, 0, At, B0); PG8_BAR; PG8_SCHED;
            PG8_STAGE(PG8_SB(1, 1), b3 + hstep, voffB);
            PG8_WAIT_V(6); PG8_BAR; PG8_MMA(1, 1, At, B1); PG8_BAR;
            }
        }
        if constexpr (ALIGN_EPI) { if (wr == 0) PG8_BAR; }
        if constexpr (!Epi::AFTER_DRAIN) { E(acc, cur, wr, wc, fr, fq); S.done(cur); }
        if (!has_next) break;
#pragma unroll
        for (int a = 0; a < 2; ++a)
#pragma unroll
            for (int b = 0; b < 2; ++b)
#pragma unroll
                for (int m = 0; m < 4; ++m)
#pragma unroll
                    for (int n = 0; n < 2; ++n) acc[a][b][m][n] = (f32x4){0.f, 0.f, 0.f, 0.f};
        cur = nxt; cA = nA; cB = nB; ++ui;
        if constexpr (ALIGN_EPI) { if (wr == 1) PG8_BAR; }
    }
    PG8_WAIT_V(0);
    if constexpr (!ALIGN_EPI) { if (wr == 0) PG8_BAR; }
    PG8_BAR;
    if constexpr (Epi::AFTER_DRAIN) { E.fused(acc, cur, wr, wc, fr, fq, lds, wid, lane); S.done(cur); }
#undef PG8_SA
#undef PG8_SB
#undef PG8_STAGE
#undef PG8_STAGEA
#undef PG8_LDA
#undef PG8_LDB
#undef PG8_MMA
#undef PG8_WAIT_V
#undef PG8_WAIT_L
#undef PG8_BAR
#undef PG8_SCHED
}
}
#ifndef PG8_SP2
#define PG8_SP2 true
#endif
#ifndef PG8_ALIGN
#define PG8_ALIGN true
#endif
#ifndef MK_N_LAUNCHES
#define MK_N_LAUNCHES 1
#endif
#define DI __device__ __forceinline__
#define LAS __attribute__((address_space(3)))
typedef unsigned short bf16;
typedef unsigned v4u __attribute__((ext_vector_type(4)));
typedef unsigned v2u __attribute__((ext_vector_type(2)));
typedef float f32x4 __attribute__((ext_vector_type(4)));
typedef float f32x16 __attribute__((ext_vector_type(16)));
typedef short bf16x8 __attribute__((ext_vector_type(8)));
using pg8::Unit;

constexpr int D = 1024, MP = 8192, M = 16384, MCTX = 2048, MALL = 18432;
constexpr int FF = 2816, NGU = 5632, NINP = 3584, NMODS = 9216;
constexpr float EPS = 1e-6f, LOG2E = 1.4426950408889634f;
constexpr float A_QS = 0.125f * LOG2E;
constexpr float B_QS = 0.10206207261596575f * LOG2E;
constexpr size_t OUT_K = (size_t)M * D, OUT_V = OUT_K + 8192 * 128, OUT_CKV = OUT_V + 8192 * 128, OUT_KR = OUT_CKV + 8192 * 256;
constexpr size_t MiB = 1u << 20;
constexpr size_t OFF_MODS = 0, OFF_SSQQ = 196608, OFF_SSQKV = 262144, OFF_BAR = 327680, OFF_SSQ1 = 344064, OFF_SSQ2 = 409600, OFF_PCNT = 475136, ZERO_BYTES = 491520, OFF_ROPEA = 524288, OFF_ROPEB = 532480, OFF_SHW2 = 589824, OFF_SHW3 = 663552;
constexpr size_t OFF_WGU1 = 1 * MiB, OFF_WGU2 = 12 * MiB, OFF_WD1 = 23 * MiB, OFF_WD2 = OFF_WD1 + 5767168, OFF_WIN = 34 * MiB, OFF_WOUT = 41 * MiB,
                 OFF_WOA = 43 * MiB, OFF_WOB = 44 * MiB, OFF_WUQ = 45 * MiB, OFF_WK = OFF_WUQ + 393216, OFF_WV = OFF_WK + 262144;
constexpr size_t OFF_H = 46 * MiB, OFF_OA = OFF_H, OFF_OB = OFF_H + 16 * MiB;
constexpr size_t OFF_ACT = 78 * MiB;
constexpr size_t OFF_QA = OFF_ACT, OFF_KA = OFF_QA + 16 * MiB, OFF_VAT = OFF_KA + (size_t)MALL * 128 * 2, OFF_QLAT = OFF_VAT + (size_t)MALL * 128 * 2,
                 OFF_CKV = OFF_QLAT + 8 * MiB, OFF_KROPE = OFF_CKV + 9 * MiB, OFF_QB = OFF_KROPE + (size_t)MALL * 32 * 2 + 131072, OFF_KN = OFF_QB + 24 * MiB;
constexpr size_t OFF_MM = OFF_ACT;
constexpr size_t OFF_GA = 166 * MiB, OFF_GB = 198 * MiB, OFF_VBT = 230 * MiB, OFF_PART1 = 248 * MiB, OFF_PART2 = 249 * MiB, OFF_PARTQ = 250 * MiB, OFF_PARTKV = 250 * MiB + 262144, WS_END = 251 * MiB;
static_assert(OFF_QLAT + 8 * MiB >= OFF_MM + 32 * MiB, "m overlay");
static_assert(OFF_KN + 18 * MiB <= OFF_GA && OFF_WV + 262144 <= OFF_H, "ws map");
constexpr int LDS_BYTES = 147456;

DI unsigned f2bf(float f) { unsigned u = __builtin_bit_cast(unsigned, f); return (u + 0x7fffu + ((u >> 16) & 1u)) >> 16; }
typedef __bf16 hbf16x2 __attribute__((ext_vector_type(2)));
typedef float hf32x2 __attribute__((ext_vector_type(2)));
DI unsigned pk2(float lo, float hi) { const hf32x2 f = {lo, hi}; return __builtin_bit_cast(unsigned, __builtin_convertvector(f, hbf16x2)); }
DI float bflo(unsigned w) { return __builtin_bit_cast(float, w << 16); }
DI float bfhi(unsigned w) { return __builtin_bit_cast(float, w & 0xffff0000u); }
DI float fexp2(float x) { return __builtin_amdgcn_exp2f(x); }
DI float frcp(float x) { return __builtin_amdgcn_rcpf(x); }
DI float sigm(float x) { return frcp(1.f + fexp2(-x * LOG2E)); }
#define LDS_WAIT() asm volatile("s_waitcnt lgkmcnt(0)" ::: "memory")
DI float wave_sum(float v) {
#pragma unroll
    for (int o = 1; o < 64; o <<= 1) v += __shfl_xor(v, o);
    return v;
}
DI float sum16(const float* p) { const f32x4 a = *(const f32x4*)p, b = *(const f32x4*)(p + 4), c = *(const f32x4*)(p + 8), d = *(const f32x4*)(p + 12); const f32x4 t = (a + b) + (c + d); return (t.x + t.y) + (t.z + t.w); }
DI float sum4(const float* p) { const f32x4 a = *(const f32x4*)p; return (a.x + a.y) + (a.z + a.w); }
DI int mod_index(int row) { return row < MP ? 0 : 1 + ((row - MP) >> 11); }

#define XB_TMO      128
#define XB_XCNT(j)  (256  + 64 * (j))
#define XB_XSUB(j)  (1280 + 64 * (j))
#define XB_XGEN(j)  (2304 + 64 * (j))
#define XB_TOP      3328
#define XB_TOPGEN   3392
#define XCD_BAR_WORDS 3456
#define XB_SPIN_CAP (1u << 18)

__device__ __forceinline__ unsigned xb_ld(unsigned* p)              { return __hip_atomic_load(p, __ATOMIC_RELAXED, __HIP_MEMORY_SCOPE_AGENT); }
__device__ __forceinline__ unsigned xb_add(unsigned* p, unsigned v) { return __hip_atomic_fetch_add(p, v, __ATOMIC_RELAXED, __HIP_MEMORY_SCOPE_AGENT); }
__device__ __forceinline__ unsigned xb_xcc_id() { return (unsigned)__builtin_amdgcn_s_getreg((3 << 11) | 20) & 0xFu; }
#define XB_SPIN(cond, bar) do { unsigned _sp = 0; while (cond) { __builtin_amdgcn_s_sleep(1); \
    if ((++_sp & 255u) == 0u) { if (xb_ld(&(bar)[XB_TMO])) break; if (_sp > XB_SPIN_CAP) { atomicAdd(&(bar)[XB_TMO], 1u); break; } } } } while (0)

struct XcdBarrier {
    unsigned* bar; unsigned x;
    volatile LAS unsigned* st;
};

__device__ __forceinline__ XcdBarrier xcd_barrier_post(unsigned* bar, volatile LAS unsigned* st) {
    XcdBarrier b; b.bar = bar; b.x = xb_xcc_id(); b.st = st;
    if (threadIdx.x == 0) (void)xb_add(&bar[XB_XCNT(b.x)], 1u);
    return b;
}
__device__ __forceinline__ void xcd_barrier_complete(unsigned* bar, unsigned x, unsigned& nloc, unsigned& nx) {
    const unsigned G = gridDim.x * gridDim.y * gridDim.z;
    unsigned sum, cnt, mine, sp = 0u;
    for (;;) {
        sum = 0u; cnt = 0u; mine = 0u;
#pragma unroll
        for (unsigned j = 0; j < 16; ++j) { const unsigned c = xb_ld(&bar[XB_XCNT(j)]); sum += c; cnt += (c > 0u) ? 1u : 0u; mine = (j == x) ? c : mine; }
        if (sum == G) break;
        __builtin_amdgcn_s_sleep(1);
        if ((++sp & 255u) == 0u) { if (xb_ld(&bar[XB_TMO])) break; if (sp > XB_SPIN_CAP) { atomicAdd(&bar[XB_TMO], 1u); break; } }
    }
    nloc = mine > 0u ? mine : 1u; nx = cnt > 0u ? cnt : 1u;
}

__device__ __forceinline__ void xcd_barrier(const XcdBarrier& b) {
    asm volatile("s_waitcnt vmcnt(0)" ::: "memory");
    __syncthreads();
    if (threadIdx.x == 0) {
        unsigned* bar = b.bar;
        __builtin_amdgcn_s_waitcnt(0);
        unsigned nloc = b.st[0], nx = b.st[1];
        if (nloc == 0u) { xcd_barrier_complete(bar, b.x, nloc, nx); b.st[0] = nloc; b.st[1] = nx; }
        const unsigned old = xb_add(&bar[XB_XSUB(b.x)], 1u);
        const unsigned gen = old / nloc;
        if (old + 1u == (gen + 1u) * nloc) {
            __builtin_amdgcn_fence(__ATOMIC_RELEASE, "agent");
            asm volatile("s_waitcnt vmcnt(0)" ::: "memory");
            const unsigned og = xb_add(&bar[XB_TOP], 1u);
            const unsigned tg = og / nx;
            if (og + 1u == (tg + 1u) * nx) xb_add(&bar[XB_TOPGEN], 1u);
            else XB_SPIN(xb_ld(&bar[XB_TOPGEN]) == tg, bar);
            __builtin_amdgcn_fence(__ATOMIC_ACQUIRE, "agent");
            xb_add(&bar[XB_XGEN(b.x)], 1u);
            asm volatile("s_waitcnt vmcnt(0)" ::: "memory");
        } else {
            XB_SPIN(xb_ld(&bar[XB_XGEN(b.x)]) == gen, bar);
            __builtin_amdgcn_fence(__ATOMIC_ACQUIRE, "agent");
            asm volatile("s_waitcnt vmcnt(0)" ::: "memory");
        }
    }
    __syncthreads();
}


DI void transpose_item(const float* W, int N, bf16* WT, int K, int k0, int src_n0, int dst_r0, const float* kscale, float sscale, LAS float* scr, int lane, int dk = 0, bool ntst = false) {
    if (src_n0 >= 0) {
        float v[32];
#pragma unroll
        for (int i = 0; i < 32; ++i) v[i] = __builtin_nontemporal_load(W + (size_t)(k0 + 2 * i + (lane >> 5)) * N + src_n0 + (lane & 31));
        if (kscale) {
#pragma unroll
            for (int i = 0; i < 32; ++i) v[i] *= kscale[k0 + 2 * i + (lane >> 5)]; }
#pragma unroll
        for (int i = 0; i < 32; ++i) scr[(2 * i + (lane >> 5)) * 33 + (lane & 31)] = v[i] * sscale;
    } else {
#pragma unroll 8
        for (int i = 0; i < 32; ++i) { const int kk = 2 * i + (lane >> 5); scr[kk * 33 + (lane & 31)] = 0.f; }
    }
    LDS_WAIT(); asm volatile("" ::: "memory");
    const int c = lane & 7;
#pragma unroll
    for (int j = 0; j < 4; ++j) { const int n = (lane >> 3) + 8 * j; const LAS float* s = scr + (8 * c) * 33 + n;
        v4u o; o.x = pk2(s[0 * 33], s[1 * 33]); o.y = pk2(s[2 * 33], s[3 * 33]); o.z = pk2(s[4 * 33], s[5 * 33]); o.w = pk2(s[6 * 33], s[7 * 33]);
        v4u* dp = (v4u*)(WT + (size_t)(dst_r0 + n) * K + k0 + dk + 8 * c);
        if (ntst) __builtin_nontemporal_store(o, dp); else *dp = o; }
    LDS_WAIT(); asm volatile("" ::: "memory");
}

struct Args { const float* in[27]; float* out; unsigned char* ws; int ph_lo, ph_hi; };

constexpr int I_GU = 16 * 176, I_D = 44 * 32, I_IN = 16 * 112, I_OUT = 16 * 32, I_O = 8 * 32, I_UQ = 4 * 24, I_K = 4 * 16;
constexpr int P0_EARLY = I_GU + I_IN, P0_NIT = P0_EARLY + I_GU + 2 * I_D + I_OUT + 2 * I_O + I_UQ + 2 * I_K;
DI void p0_weights(const Args& a, LAS unsigned char* lds, int gw, int NGW, int wave, int lane, int it_lo, int it_hi) {
    LAS float* scr = (LAS float*)(lds + wave * 16384);
    unsigned char* ws = a.ws;
    for (int it = it_lo + gw; it < it_hi; it += NGW) {
        int r = it;
        if (r < I_GU) { const int w = 0; const int kb = r / 176, nb = r % 176, R0 = 32 * nb;
            const int pn = R0 >> 8, half = (R0 >> 7) & 1, j = R0 & 127;
            transpose_item(a.in[w ? 24 : 11], NGU, (bf16*)(ws + (w ? OFF_WGU2 : OFF_WGU1)), 1024, 64 * kb, half * FF + 128 * pn + j, R0, nullptr, half ? (1.0f / LOG2E) : LOG2E, scr, lane); continue; }
        r -= I_GU;
        if (r < I_IN) { const int kb = r / 112, nb = r % 112, R0 = 32 * nb;
            const int gq = R0 - 1280; const int src = R0 < 1280 ? R0 : (R0 < 3328 ? (((gq >> 7) & 1) ? 2336 : 1312) + 128 * (gq >> 8) + (gq & 127) : (R0 == 3328 ? 1280 : -1));
            transpose_item(a.in[14], 3360, (bf16*)(ws + OFF_WIN), 1024, 64 * kb, src, R0, nullptr, 1.f, scr, lane); continue; }
        r -= I_IN;
        if (r < I_GU) { const int w = 1; const int kb = r / 176, nb = r % 176, R0 = 32 * nb;
            const int pn = R0 >> 8, half = (R0 >> 7) & 1, j = R0 & 127;
            transpose_item(a.in[w ? 24 : 11], NGU, (bf16*)(ws + (w ? OFF_WGU2 : OFF_WGU1)), 1024, 64 * kb, half * FF + 128 * pn + j, R0, nullptr, half ? (1.0f / LOG2E) : LOG2E, scr, lane, 0, true); continue; }
        r -= I_GU;
        if (r < I_D) { const int kb = r / 32, nb = r % 32;
            transpose_item(a.in[12], 1024, (bf16*)(ws + OFF_WD1), FF, 64 * kb, 32 * nb, 32 * nb, nullptr, 1.f, scr, lane); continue; }
        r -= I_D;
        if (r < I_D) { const int kb = r / 32, nb = r % 32;
            transpose_item(a.in[25], 1024, (bf16*)(ws + OFF_WD2), FF, 64 * kb, 32 * nb, 32 * nb, nullptr, 1.f, scr, lane, 0, true); continue; }
        r -= I_D;
        if (r < I_OUT) { const int kb = r / 32, nb = r % 32; transpose_item(a.in[22], 1024, (bf16*)(ws + OFF_WOUT), 1024, 64 * kb, 32 * nb, 32 * nb, nullptr, 1.f, scr, lane, 0, true); continue; }
        r -= I_OUT;
        if (r < 2 * I_O) { const int w = r >= I_O; r -= w * I_O; const int kb = r / 32, nb = r % 32;
            transpose_item(a.in[w ? 21 : 20], 1024, (bf16*)(ws + OFF_WOA), 1024, 64 * kb, 32 * nb, 32 * nb, nullptr, 1.f, scr, lane, w ? 512 : 0, true); continue; }
        r -= 2 * I_O;
        if (r < I_UQ) { const int kb = r / 24, nb = r % 24, R0 = 32 * nb;
            const int src = R0 < 512 ? (R0 >> 6) * 96 + (R0 & 63) : ((R0 - 512) >> 5) * 96 + 64;
            transpose_item(a.in[18], 768, (bf16*)(ws + OFF_WUQ), 256, 64 * kb, src, R0, a.in[16], B_QS, scr, lane, 0, true); continue; }
        r -= I_UQ;
        { const int w = r >= I_K; r -= w * I_K; const int kb = r / 16, nb = r % 16, R0 = 32 * nb;
            const int src = (R0 >> 6) * 128 + (R0 & 63) + (w ? 64 : 0);
            transpose_item(a.in[19], 1024, (bf16*)(ws + (w ? OFF_WV : OFF_WK)), 256, 64 * kb, src, R0, a.in[17], 1.f, scr, lane, 0, true); }
    }
}
DI void p0_ada(const Args& a, LAS unsigned char* lds, int tid) {
    LAS float* sc = (LAS float*)lds;
    LAS float* red = (LAS float*)(lds + 4096);
    float* mods = (float*)(a.ws + OFF_MODS);
    const float* adaw = a.in[8];
    for (int it = blockIdx.x; it < 256; it += gridDim.x) {
        const int cgp = it & 31, ks = it >> 5;
        __syncthreads();
        for (int i = tid; i < 640; i += 512) { const int v = i >> 7, k = ks * 128 + (i & 127); const float c = v == 0 ? a.in[7][k] : a.in[6][(v - 1) * 1024 + k]; sc[i] = c * sigm(c); }
        __syncthreads();
        const int colq = tid % 72, kl = tid / 72;
        if (kl < 7) {
            f32x4 acc[5];
#pragma unroll
            for (int v = 0; v < 5; ++v) acc[v] = (f32x4){0.f, 0.f, 0.f, 0.f};
            f32x4 w[19];
#pragma unroll
            for (int q = 0; q < 19; ++q) { const int k = kl + 7 * q; w[q] = k < 128 ? __builtin_nontemporal_load((const f32x4*)(adaw + (size_t)(ks * 128 + k) * NMODS + cgp * 288 + colq * 4)) : (f32x4){0.f, 0.f, 0.f, 0.f}; }
#pragma unroll
            for (int q = 0; q < 19; ++q) { const int k = kl + 7 * q; if (k < 128) {
#pragma unroll
                for (int v = 0; v < 5; ++v) acc[v] += w[q] * sc[v * 128 + k]; } }
#pragma unroll
            for (int v = 0; v < 5; ++v) *(LAS f32x4*)(red + (kl * 5 + v) * 288 + colq * 4) = acc[v];
        }
        __syncthreads();
        for (int i = tid; i < 1440; i += 512) { const int v = i / 288, cc = i % 288; float s = 0.f;
#pragma unroll
            for (int q = 0; q < 7; ++q) s += red[(q * 5 + v) * 288 + cc];
            const int col = cgp * 288 + cc; if (ks == 0) s += a.in[9][col];
            atomicAdd(mods + v * NMODS + col, s); }
    }
    __syncthreads();
}
DI void ctx_convert(const Args& a, int gtid, int NT) {
    unsigned char* ws = a.ws;
    bf16* ka = (bf16*)(ws + OFF_KA) + (size_t)M * 128; bf16* vaT = (bf16*)(ws + OFF_VAT); bf16* ckv = (bf16*)(ws + OFF_CKV) + (size_t)M * 256; bf16* kr = (bf16*)(ws + OFF_KROPE) + (size_t)M * 32;
    for (int i = gtid; i < MCTX * 128; i += NT) ka[i] = (bf16)f2bf(a.in[2][i]);
    for (int i = gtid; i < MCTX * 128; i += NT) { const int f = i >> 11, tk = i & 2047; vaT[(size_t)f * MALL + M + tk] = (bf16)f2bf(a.in[3][tk * 128 + f]); }
    for (int i = gtid; i < MCTX * 256; i += NT) ckv[i] = (bf16)f2bf(a.in[4][i] / a.in[17][i & 255]);
    for (int i = gtid; i < MCTX * 32; i += NT) kr[i] = (bf16)f2bf(a.in[5][i]);
}
DI void p0_misc(const Args& a, int gtid, int NT) {
    unsigned char* ws = a.ws;
    float2* ra = (float2*)(ws + OFF_ROPEA); float2* rb = (float2*)(ws + OFF_ROPEB);
    for (int i = gtid; i < 1024; i += NT) { const int pos = i >> 4, fi = i & 15; const float inv = 1.0f / powf(10000.f, (float)(2 * fi) / 32.f); const float ang = (float)pos * inv; ra[i] = make_float2(cosf(ang), sinf(ang)); }
    for (int i = gtid; i < 512; i += NT) { const int pos = i >> 3, fi = i & 7; const float inv = 1.0f / powf(10000.f, (float)(2 * fi) / 16.f); const float ang = (float)pos * inv; rb[i] = make_float2(cosf(ang), sinf(ang)); }
}

DI void norm_mod_phase(const float* xa, const float* xb, const float* gain, const float* mods, int s, bf16* h, int gw, int NGW, int lane) {
    for (int row = gw; row < M; row += NGW) {
        const float* xr = row < MP ? xa + (size_t)row * D : xb + (size_t)(row - MP) * D;
        f32x4 v[4]; float ss = 0.f;
#pragma unroll
        for (int j = 0; j < 4; ++j) { v[j] = *(const f32x4*)(xr + 4 * (64 * j + lane)); ss += (v[j].x * v[j].x + v[j].y * v[j].y) + (v[j].z * v[j].z + v[j].w * v[j].w); }
        const float rstd = 1.0f / sqrtf(wave_sum(ss) * (1.f / D) + EPS);
        const float* sh = mods + mod_index(row) * NMODS + (3 * s) * D; const float* sc = sh + D;
#pragma unroll
        for (int j = 0; j < 4; ++j) { const int c = 4 * (64 * j + lane); const f32x4 g = *(const f32x4*)(gain + c), s4 = *(const f32x4*)(sh + c), c4 = *(const f32x4*)(sc + c);
            const f32x4 o = (v[j] * rstd * g) * (c4 + 1.0f) + s4; v2u w; w.x = pk2(o.x, o.y); w.y = pk2(o.z, o.w); *(v2u*)(h + (size_t)row * D + c) = w; }
    }
}
DI void shw_phase(const bf16* WT, int nrows, const float* mods, int shslot, float* shW, int gw, int NGW, int lane) {
    for (int n = gw; n < nrows; n += NGW) {
        const v4u w0 = *(const v4u*)(WT + (size_t)n * D + 16 * lane), w1 = *(const v4u*)(WT + (size_t)n * D + 16 * lane + 8);
        f32x4 a0, a1, a2, a3; { f32x4 t0, t1; a0 = (f32x4){bflo(w0.x), bfhi(w0.x), bflo(w0.y), bfhi(w0.y)}; a1 = (f32x4){bflo(w0.z), bfhi(w0.z), bflo(w0.w), bfhi(w0.w)};
            a2 = (f32x4){bflo(w1.x), bfhi(w1.x), bflo(w1.y), bfhi(w1.y)}; a3 = (f32x4){bflo(w1.z), bfhi(w1.z), bflo(w1.w), bfhi(w1.w)}; }
#pragma unroll
        for (int b = 0; b < 5; ++b) { const float* sh = mods + b * NMODS + shslot * D + 16 * lane;
            const f32x4 p = a0 * *(const f32x4*)(sh) + a1 * *(const f32x4*)(sh + 4) + a2 * *(const f32x4*)(sh + 8) + a3 * *(const f32x4*)(sh + 12);
            const float sum = wave_sum((p.x + p.y) + (p.z + p.w)); if (lane == 0) shW[b * nrows + n] = sum; }
    }
}
DI void final_norm_phase(float* x, const float* gain, int gw, int NGW, int lane) {
    for (int row = gw; row < M; row += NGW) {
        float* xr = x + (size_t)row * D; f32x4 v[4]; float ss = 0.f;
#pragma unroll
        for (int j = 0; j < 4; ++j) { v[j] = *(const f32x4*)(xr + 4 * (64 * j + lane)); ss += (v[j].x * v[j].x + v[j].y * v[j].y) + (v[j].z * v[j].z + v[j].w * v[j].w); }
        const float rstd = 1.0f / sqrtf(wave_sum(ss) * (1.f / D) + EPS);
#pragma unroll
        for (int j = 0; j < 4; ++j) { const int c = 4 * (64 * j + lane); *(f32x4*)(xr + c) = v[j] * rstd * *(const f32x4*)(gain + c); }
    }
}
#define EPI_ARGS const f32x4 (&acc)[2][2][4][2], const Unit& u, int wr, int wc, int fr, int fq
DI v4u pack8(const f32x4& a, const f32x4& b) { v4u w; w.x = pk2(a.x, a.y); w.y = pk2(a.z, a.w); w.z = pk2(b.x, b.y); w.w = pk2(b.z, b.w); return w; }
DI void unpack8(const v4u& w, f32x4& a, f32x4& b) { a = (f32x4){bflo(w.x), bfhi(w.x), bflo(w.y), bfhi(w.y)}; b = (f32x4){bflo(w.z), bfhi(w.z), bflo(w.w), bfhi(w.w)}; }
DI f32x4 shx4(const f32x4& v, int m) { return (f32x4){__shfl_xor(v.x, m), __shfl_xor(v.y, m), __shfl_xor(v.z, m), __shfl_xor(v.w, m)}; }
DI void rope8(f32x4& v0, f32x4& v1, const float2* cs, int xm, float sgn) {
    const f32x4 p0 = shx4(v0, xm), p1 = shx4(v1, xm);
    const f32x4 t0 = *(const f32x4*)(cs), t1 = *(const f32x4*)(cs + 2), t2 = *(const f32x4*)(cs + 4), t3 = *(const f32x4*)(cs + 6);
    v0 = (f32x4){v0.x * t0.x + sgn * p0.x * t0.y, v0.y * t0.z + sgn * p0.y * t0.w, v0.z * t1.x + sgn * p0.z * t1.y, v0.w * t1.z + sgn * p0.w * t1.w};
    v1 = (f32x4){v1.x * t2.x + sgn * p1.x * t2.y, v1.y * t2.z + sgn * p1.y * t2.w, v1.z * t3.x + sgn * p1.z * t3.y, v1.w * t3.z + sgn * p1.w * t3.w};
}

template <bool NORM> struct EpiSwiglu { static constexpr bool PERM = true, AFTER_DRAIN = false; bf16* O; const float* ssq; const float* shW;
    DI void operator()(EPI_ARGS) const {
        asm volatile("" : "+v"(fr), "+v"(fq));
        const int row0 = u.pm * 256 + (u.half == 2 ? 128 : 0) + wr * 64 + fr, col0 = u.pn * 128 + wc * 32 + 8 * fq;
        f32x4 sw[2][2];
        if (NORM) { const float* sp = shW + mod_index(u.pm * 256) * NGU + u.pn * 256 + wc * 32 + 8 * fq;
#pragma unroll
            for (int bj = 0; bj < 2; ++bj)
#pragma unroll
                for (int n = 0; n < 2; ++n) sw[bj][n] = *(const f32x4*)(sp + bj * 128 + 4 * n); }
#pragma unroll
        for (int ai = 0; ai < 2; ++ai) { if (ai == 1 && u.half) break;
#pragma unroll
            for (int m = 0; m < 4; ++m) { f32x4 o[2]; const int row = row0 + ai * 128 + m * 16;
                float rs = 1.f; if (NORM) rs = 1.0f / sqrtf(ssq[row] * (1.f / D) + EPS);
#pragma unroll
                for (int n = 0; n < 2; ++n) { f32x4 g = acc[ai][0][m][n], uu = acc[ai][1][m][n];
                    if (NORM) { g = g * rs + sw[0][n]; uu = uu * rs + sw[1][n]; }
#pragma unroll
                    for (int j = 0; j < 4; ++j) o[n][j] = g[j] * frcp(1.f + fexp2(-g[j])) * uu[j]; }
                *(v4u*)(O + (size_t)row * FF + col0) = pack8(o[0], o[1]); } }
    }
};
DI f32x4 gsafe(const f32x4& g) { f32x4 r; for (int j = 0; j < 4; ++j) r[j] = fabsf(g[j]) < 1e-20f ? 1e-20f : g[j]; return r; }
template <bool NEXT, bool RECON, bool WRITE_X> struct EpiResid { static constexpr bool PERM = false, AFTER_DRAIN = false;
    const float* inA; const float* inB; const bf16* hin; const float* gain_prev; float* out; const float* mods; bf16* hn; const float* gain; float* ssq; int gslot; int scprev; int scslot; float coef;
    DI void operator()(EPI_ARGS) const {
        asm volatile("" : "+v"(fr), "+v"(fq));
        const int row0 = u.pm * 256 + wr * 64 + fr, col0 = u.pn * 256 + wc * 32 + 4 * fq;
        const float* mb = mods + mod_index(u.pm * 256) * NMODS; const float* gate = mb + gslot * D;
        f32x4 gv[2][2], gg[2][2], rg[2][2];
#pragma unroll
        for (int bj = 0; bj < 2; ++bj)
#pragma unroll
            for (int n = 0; n < 2; ++n) { const int c = col0 + bj * 128 + n * 16; gv[bj][n] = *(const f32x4*)(gate + c) * coef;
                if (NEXT) gg[bj][n] = gsafe(*(const f32x4*)(gain + c) * (*(const f32x4*)(mb + scslot * D + c) + 1.0f));
                if (RECON) { const f32x4 g = gsafe(*(const f32x4*)(gain_prev + c) * (*(const f32x4*)(mb + scprev * D + c) + 1.0f)); rg[bj][n] = (f32x4){1.0f / g.x, 1.0f / g.y, 1.0f / g.z, 1.0f / g.w}; } }
#pragma unroll
        for (int ai = 0; ai < 2; ++ai)
#pragma unroll
            for (int m = 0; m < 4; ++m) { const int row = row0 + ai * 128 + m * 16;
                const float* ip = row < MP ? inA + (size_t)row * D : inB + (size_t)(row - MP) * D; float s = 0.f;
#pragma unroll
                for (int bj = 0; bj < 2; ++bj)
#pragma unroll
                    for (int n = 0; n < 2; ++n) { const int c = col0 + bj * 128 + n * 16; f32x4 xin;
                        if (RECON) { const v2u w = *(const v2u*)(hin + (size_t)row * D + c); xin = (f32x4){bflo(w.x), bfhi(w.x), bflo(w.y), bfhi(w.y)} * rg[bj][n]; }
                        else xin = __builtin_nontemporal_load((const f32x4*)(ip + c));
                        const f32x4 x = xin + gv[bj][n] * acc[ai][bj][m][n];
                        if (WRITE_X) *(f32x4*)(out + (size_t)row * D + c) = x;
                        if (NEXT) { s += (x.x * x.x + x.y * x.y) + (x.z * x.z + x.w * x.w); const f32x4 y = x * gg[bj][n]; v2u w; w.x = pk2(y.x, y.y); w.y = pk2(y.z, y.w); *(v2u*)(hn + (size_t)row * D + c) = w; } }
                if (NEXT) { s += __shfl_xor(s, 16); s += __shfl_xor(s, 32); if (fq == 0) atomicAdd(ssq + row, s); } }
    }
};
struct EpiFinal { static constexpr bool PERM = false, AFTER_DRAIN = true; const bf16* hin; const float* gain_prev; float* out; const float* mods; const float* fgain; float* xbuf; unsigned* cnt; int gslot; int scprev; float coef;
    DI void operator()(EPI_ARGS) const {}
    DI void fused(f32x4 (&acc)[2][2][4][2], const Unit& u, int wr, int wc, int fr, int fq, LAS unsigned char* lds, int wid, int lane) const {
        const int tid = wid * 64 + lane;
        const int row0 = u.pm * 256 + wr * 64 + fr, col0 = u.pn * 256 + wc * 32 + 4 * fq;
        const float* gate = mods + mod_index(u.pm * 256) * NMODS + gslot * D;
        LAS float* P = (LAS float*)lds; LAS float* S = (LAS float*)(lds + 4096);
        f32x4 gv[2][2], rg[2][2]; const float* mb = mods + mod_index(u.pm * 256) * NMODS;
#pragma unroll
        for (int bj = 0; bj < 2; ++bj)
#pragma unroll
            for (int n = 0; n < 2; ++n) { const int c = col0 + bj * 128 + n * 16; gv[bj][n] = *(const f32x4*)(gate + c) * coef;
                const f32x4 g = gsafe(*(const f32x4*)(gain_prev + c) * (*(const f32x4*)(mb + scprev * D + c) + 1.0f)); rg[bj][n] = (f32x4){1.0f / g.x, 1.0f / g.y, 1.0f / g.z, 1.0f / g.w}; }
#pragma unroll
        for (int ai = 0; ai < 2; ++ai)
#pragma unroll
            for (int m = 0; m < 4; ++m) { const int row = row0 + ai * 128 + m * 16; const bf16* ip = hin + (size_t)row * D; float s = 0.f;
#pragma unroll
                for (int bj = 0; bj < 2; ++bj)
#pragma unroll
                    for (int n = 0; n < 2; ++n) { const v2u w = __builtin_nontemporal_load((const v2u*)(ip + col0 + bj * 128 + n * 16)); const f32x4 x = (f32x4){bflo(w.x), bfhi(w.x), bflo(w.y), bfhi(w.y)} * rg[bj][n] + gv[bj][n] * acc[ai][bj][m][n]; acc[ai][bj][m][n] = x; s += (x.x * x.x + x.y * x.y) + (x.z * x.z + x.w * x.w); }
                s += __shfl_xor(s, 16); s += __shfl_xor(s, 32);
                if (fq == 0) P[(ai * 128 + wr * 64 + m * 16 + fr) * 4 + wc] = s; }
        LDS_WAIT(); __syncthreads();
        if (tid < 256) { const f32x4 p = *(const LAS f32x4*)(P + tid * 4);
            __hip_atomic_store(xbuf + (size_t)(u.pm * 256 + tid) * 4 + u.pn, (p.x + p.y) + (p.z + p.w), __ATOMIC_RELAXED, __HIP_MEMORY_SCOPE_AGENT);
            asm volatile("s_waitcnt vmcnt(0)" ::: "memory");
            if (lane == 0) __hip_atomic_fetch_add(cnt + 64 * u.pm, 1u, __ATOMIC_RELAXED, __HIP_MEMORY_SCOPE_AGENT); }
        if (wid == 0) { unsigned sp = 0;
            while ((unsigned)__builtin_amdgcn_readfirstlane(__hip_atomic_load(cnt + 64 * u.pm, __ATOMIC_RELAXED, __HIP_MEMORY_SCOPE_AGENT)) < 16u) { __builtin_amdgcn_s_sleep(2); if (++sp > (1u << 22)) break; }
            __builtin_amdgcn_fence(__ATOMIC_ACQUIRE, "agent"); }
        asm volatile("s_waitcnt vmcnt(0) lgkmcnt(0)" ::: "memory"); __syncthreads();
        if (tid < 256) { const float* xp = xbuf + (size_t)(u.pm * 256 + tid) * 4; float t = 0.f;
#pragma unroll
            for (int q = 0; q < 4; ++q) t += __hip_atomic_load(xp + q, __ATOMIC_RELAXED, __HIP_MEMORY_SCOPE_AGENT);
            S[tid] = 1.0f / sqrtf(t * (1.f / D) + EPS); }
        LDS_WAIT(); __syncthreads();
        f32x4 fg[2][2];
#pragma unroll
        for (int bj = 0; bj < 2; ++bj)
#pragma unroll
            for (int n = 0; n < 2; ++n) fg[bj][n] = *(const f32x4*)(fgain + col0 + bj * 128 + n * 16);
#pragma unroll
        for (int ai = 0; ai < 2; ++ai)
#pragma unroll
            for (int m = 0; m < 4; ++m) { const int rl = ai * 128 + wr * 64 + m * 16 + fr; const float rs = S[rl]; float* op = out + (size_t)(u.pm * 256 + rl) * D;
#pragma unroll
                for (int bj = 0; bj < 2; ++bj)
#pragma unroll
                    for (int n = 0; n < 2; ++n) __builtin_nontemporal_store(acc[ai][bj][m][n] * rs * fg[bj][n], (f32x4*)(op + col0 + bj * 128 + n * 16)); }
    }
};
struct EpiWin { static constexpr bool PERM = true, AFTER_DRAIN = false;
    bf16 *qa, *ka, *vaT, *qlat, *ckv, *ga, *gb, *krope; float *ssq_q, *ssq_kv; float* out; const float2* ropeA; const float2* ropeB; bool do_ssq; const float* ssq1; const float* shW;
    DI void operator()(EPI_ARGS) const {
        asm volatile("" : "+v"(fr), "+v"(fq));
        const int pn = u.pn; const bool sample = u.pm >= 32;
        const int rbase = u.pm * 256 + (u.half == 2 ? 128 : 0) + wr * 64 + fr;
        f32x4 sw[2][2]; { const float* sp = shW + mod_index(u.pm * 256) * NINP + pn * 256 + wc * 32 + 8 * fq;
#pragma unroll
            for (int bj = 0; bj < 2; ++bj)
#pragma unroll
                for (int n = 0; n < 2; ++n) sw[bj][n] = *(const f32x4*)(sp + bj * 128 + 4 * n); }
#define WACC(ai, bj, m, n) (acc[ai][bj][m][n] * rs + sw[bj][n])
        if (pn < 3) {
#pragma unroll
            for (int ai = 0; ai < 2; ++ai) { if (ai == 1 && u.half) break;
#pragma unroll
                for (int m = 0; m < 4; ++m) { const int row = rbase + ai * 128 + m * 16; const float rs = 1.0f / sqrtf(ssq1[row] * (1.f / D) + EPS); const int t = (row - MP) & 2047; const int pos = (wc & 1) ? (t & 63) : (t >> 6);
                    const float2* cs = ropeA + pos * 16 + 8 * (fq & 1); const float sgn = (fq & 2) ? 1.f : -1.f;
#pragma unroll
                    for (int bj = 0; bj < 2; ++bj) { f32x4 v0 = WACC(ai, bj, m, 0), v1 = WACC(ai, bj, m, 1); const int cl = bj * 128 + wc * 32 + 8 * fq;
                        if (pn < 2) { if (sample) rope8(v0, v1, cs, 32, sgn); v0 = v0 * A_QS; v1 = v1 * A_QS; *(v4u*)(qa + (size_t)row * 512 + pn * 256 + cl) = pack8(v0, v1); }
                        else if (bj == 0) { if (sample) rope8(v0, v1, cs, 32, sgn); *(v4u*)(ka + (size_t)row * 128 + cl) = pack8(v0, v1);
                            if (!sample) { float* o = out + OUT_K + (size_t)row * 128 + cl; __builtin_nontemporal_store(v0, (f32x4*)o); __builtin_nontemporal_store(v1, (f32x4*)(o + 4)); } }
                        else { const int c = cl - 128;
#pragma unroll
                            for (int j = 0; j < 4; ++j) { vaT[(size_t)(c + j) * MALL + row] = (bf16)f2bf(v0[j]); vaT[(size_t)(c + 4 + j) * MALL + row] = (bf16)f2bf(v1[j]); }
                            if (!sample) { float* o = out + OUT_V + (size_t)row * 128 + c; __builtin_nontemporal_store(v0, (f32x4*)o); __builtin_nontemporal_store(v1, (f32x4*)(o + 4)); } } } } }
        } else if (pn < 5) {
            bf16* dst = pn == 3 ? qlat : ckv; float* ssq = pn == 3 ? ssq_q : ssq_kv;
#pragma unroll
            for (int ai = 0; ai < 2; ++ai) { if (ai == 1 && u.half) break;
#pragma unroll
                for (int m = 0; m < 4; ++m) { const int row = rbase + ai * 128 + m * 16; const float rs = 1.0f / sqrtf(ssq1[row] * (1.f / D) + EPS); float s = 0.f;
#pragma unroll
                    for (int bj = 0; bj < 2; ++bj) { const f32x4 v0 = WACC(ai, bj, m, 0), v1 = WACC(ai, bj, m, 1);
                        s += (v0.x * v0.x + v0.y * v0.y) + (v0.z * v0.z + v0.w * v0.w) + (v1.x * v1.x + v1.y * v1.y) + (v1.z * v1.z + v1.w * v1.w);
                        *(v4u*)(dst + (size_t)row * 256 + bj * 128 + wc * 32 + 8 * fq) = pack8(v0, v1); }
                    s += __shfl_xor(s, 16); s += __shfl_xor(s, 32);
                    if (fq == 0 && do_ssq) atomicAdd(ssq + row, s); } }
        } else if (pn < 13) {
            const int ct = (pn - 5) * 128 + wc * 32 + 8 * fq;
#pragma unroll
            for (int ai = 0; ai < 2; ++ai) { if (ai == 1 && u.half) break;
#pragma unroll
                for (int m = 0; m < 4; ++m) { const int row = rbase + ai * 128 + m * 16; const float rs = 1.0f / sqrtf(ssq1[row] * (1.f / D) + EPS);
                    f32x4 r0, r1, b0, b1;
                    { const f32x4 a0 = WACC(ai, 0, m, 0), a1 = WACC(ai, 0, m, 1), c0 = WACC(ai, 1, m, 0), c1 = WACC(ai, 1, m, 1);
#pragma unroll
                      for (int j = 0; j < 4; ++j) {
                          const float ea0 = fexp2(-a0[j] * LOG2E), ea1 = fexp2(-a1[j] * LOG2E), eb0 = fminf(fexp2(-c0[j] * LOG2E), 1e30f), eb1 = fminf(fexp2(-c1[j] * LOG2E), 1e30f);
                          b0[j] = frcp(1.f + eb0); b1[j] = frcp(1.f + eb1); r0[j] = (1.f + eb0) * frcp(1.f + ea0); r1[j] = (1.f + eb1) * frcp(1.f + ea1); } }
                    *(v4u*)(ga + (size_t)row * D + ct) = pack8(r0, r1); *(v4u*)(gb + (size_t)row * D + ct) = pack8(b0, b1); } }
        } else if (wc == 0) {
#pragma unroll
            for (int ai = 0; ai < 2; ++ai) { if (ai == 1 && u.half) break;
#pragma unroll
                for (int m = 0; m < 4; ++m) { const int row = rbase + ai * 128 + m * 16; const float rs = 1.0f / sqrtf(ssq1[row] * (1.f / D) + EPS); const int t = (row - MP) & 2047; const int pos = (fq & 2) ? (t & 63) : (t >> 6);
                    f32x4 v0 = WACC(ai, 0, m, 0), v1 = WACC(ai, 0, m, 1);
                    if (sample) rope8(v0, v1, ropeB + pos * 8, 16, (fq & 1) ? 1.f : -1.f);
                    *(v4u*)(krope + (size_t)row * 32 + 8 * fq) = pack8(v0, v1);
                    if (!sample) { float* o = out + OUT_KR + (size_t)row * 32 + 8 * fq; __builtin_nontemporal_store(v0, (f32x4*)o); __builtin_nontemporal_store(v1, (f32x4*)(o + 4)); } } }
        }
    }
};
#undef WACC
struct EpiQB { static constexpr bool PERM = true, AFTER_DRAIN = false; bf16* qb; const float* ssq; const float2* ropeB;
    DI void operator()(EPI_ARGS) const {
        asm volatile("" : "+v"(fr), "+v"(fq));
        const int rbase = u.pm * 256 + wr * 64 + fr; const bool sample = u.pm >= 32;
#pragma unroll
        for (int ai = 0; ai < 2; ++ai)
#pragma unroll
            for (int m = 0; m < 4; ++m) { const int row = rbase + ai * 128 + m * 16; const float rs = 1.0f / sqrtf(ssq[row] * (1.f / 256.f) + EPS);
                const int t = (row - MP) & 2047; const int pos = (fq & 2) ? (t & 63) : (t >> 6);
#pragma unroll
                for (int bj = 0; bj < 2; ++bj) { f32x4 v0 = acc[ai][bj][m][0] * rs, v1 = acc[ai][bj][m][1] * rs;
                    if (u.pn == 2 && sample) rope8(v0, v1, ropeB + pos * 8, 16, (fq & 1) ? 1.f : -1.f);
                    *(v4u*)(qb + (size_t)row * 768 + u.pn * 256 + bj * 128 + wc * 32 + 8 * fq) = pack8(v0, v1); } }
    }
};
struct EpiKN { static constexpr bool PERM = true, AFTER_DRAIN = false; bf16* kn; const float* ssq;
    DI void operator()(EPI_ARGS) const {
        asm volatile("" : "+v"(fr), "+v"(fq));
        const int rbase = u.pm * 256 + wr * 64 + fr; const bool lat = u.pm < 64;
#pragma unroll
        for (int ai = 0; ai < 2; ++ai)
#pragma unroll
            for (int m = 0; m < 4; ++m) { const int row = rbase + ai * 128 + m * 16; const float rs = lat ? 1.0f / sqrtf(ssq[row] * (1.f / 256.f) + EPS) : 1.0f;
#pragma unroll
                for (int bj = 0; bj < 2; ++bj) *(v4u*)(kn + (size_t)row * 512 + u.pn * 256 + bj * 128 + wc * 32 + 8 * fq) = pack8(acc[ai][bj][m][0] * rs, acc[ai][bj][m][1] * rs); }
    }
};
struct EpiVT { static constexpr bool PERM = true, AFTER_DRAIN = false; bf16* vt; const float* ssq;
    DI void operator()(EPI_ARGS) const {
        asm volatile("" : "+v"(fr), "+v"(fq));
        const int rbase = u.pm * 256 + wr * 64 + fr; const bool lat = u.pn < 64;
        f32x4 rs[2][2];
#pragma unroll
        for (int bj = 0; bj < 2; ++bj)
#pragma unroll
            for (int n = 0; n < 2; ++n) { const int c = u.pn * 256 + bj * 128 + wc * 32 + 8 * fq + 4 * n;
                if (lat) { const f32x4 q = *(const f32x4*)(ssq + c); rs[bj][n] = (f32x4){1.0f / sqrtf(q.x * (1.f / 256.f) + EPS), 1.0f / sqrtf(q.y * (1.f / 256.f) + EPS), 1.0f / sqrtf(q.z * (1.f / 256.f) + EPS), 1.0f / sqrtf(q.w * (1.f / 256.f) + EPS)}; }
                else rs[bj][n] = (f32x4){1.f, 1.f, 1.f, 1.f}; }
#pragma unroll
        for (int ai = 0; ai < 2; ++ai)
#pragma unroll
            for (int m = 0; m < 4; ++m) { const int row = rbase + ai * 128 + m * 16;
#pragma unroll
                for (int bj = 0; bj < 2; ++bj) *(v4u*)(vt + (size_t)row * MALL + u.pn * 256 + bj * 128 + wc * 32 + 8 * fq) = pack8(acc[ai][bj][m][0] * rs[bj][0], acc[ai][bj][m][1] * rs[bj][1]); }
    }
};
template <bool SECOND> struct EpiMerge { static constexpr bool PERM = true, AFTER_DRAIN = false; bf16* mm; const bf16* g;
    DI void operator()(EPI_ARGS) const {
        asm volatile("" : "+v"(fr), "+v"(fq));
        const int rbase = u.pm * 256 + wr * 64 + fr;
#pragma unroll
        for (int ai = 0; ai < 2; ++ai)
#pragma unroll
            for (int m = 0; m < 4; ++m) { const int row = rbase + ai * 128 + m * 16;
#pragma unroll
                for (int bj = 0; bj < 2; ++bj) { const size_t o = (size_t)row * D + u.pn * 256 + bj * 128 + wc * 32 + 8 * fq;
                    f32x4 g0, g1; unpack8(*(const v4u*)(g + o), g0, g1); f32x4 v0 = acc[ai][bj][m][0] * g0, v1 = acc[ai][bj][m][1] * g1;
                    if (SECOND) { f32x4 p0, p1; unpack8(*(const v4u*)(mm + o), p0, p1); v0 += p0; v1 += p1; }
                    *(v4u*)(mm + o) = pack8(v0, v1); } }
    }
};

struct EpiMergeK { static constexpr bool PERM = true, AFTER_DRAIN = false, MIDK = true; bf16* mm; const bf16* ga; const bf16* gb;
    DI void mid(f32x4 (&acc)[2][2][4][2], const Unit& u, int wr, int wc, int fr, int fq) const {
        asm volatile("" : "+v"(fr), "+v"(fq));
        const int rbase = u.pm * 256 + wr * 64 + fr;
#pragma unroll
        for (int ai = 0; ai < 2; ++ai)
#pragma unroll
            for (int m = 0; m < 4; ++m) { const int row = rbase + ai * 128 + m * 16;
#pragma unroll
                for (int bj = 0; bj < 2; ++bj) { const size_t o = (size_t)row * D + u.pn * 256 + bj * 128 + wc * 32 + 8 * fq;
                    f32x4 a0, a1; unpack8(__builtin_nontemporal_load((const v4u*)(ga + o)), a0, a1);
                    acc[ai][bj][m][0] = acc[ai][bj][m][0] * a0; acc[ai][bj][m][1] = acc[ai][bj][m][1] * a1; } }
    }
    DI void operator()(EPI_ARGS) const {
        asm volatile("" : "+v"(fr), "+v"(fq));
        const int rbase = u.pm * 256 + wr * 64 + fr;
#pragma unroll
        for (int ai = 0; ai < 2; ++ai)
#pragma unroll
            for (int m = 0; m < 4; ++m) { const int row = rbase + ai * 128 + m * 16;
#pragma unroll
                for (int bj = 0; bj < 2; ++bj) { const size_t o = (size_t)row * D + u.pn * 256 + bj * 128 + wc * 32 + 8 * fq;
                    f32x4 b0, b1; unpack8(__builtin_nontemporal_load((const v4u*)(gb + o)), b0, b1);
                    *(v4u*)(mm + o) = pack8(acc[ai][bj][m][0] * b0, acc[ai][bj][m][1] * b1); } }
    }
};
static_assert(pg8::MidK<EpiMergeK>::value && !pg8::MidK<EpiWin>::value, "mid-K hook trait");
#define MFMA32(a, b, c) __builtin_amdgcn_mfma_f32_32x32x16_bf16((a), (b), (c), 0, 0, 0)
#ifndef ATT_RS
#define ATT_RS 16.0f
#endif
template <int DQ>
DI void attn_unit(LAS unsigned char* lds, int tid, int lane,
                  const bf16* qn, int ldqn, const bf16* qr, int ldqr,
                  const bf16* Kb, int ldk, const bf16* Kr, const bf16* Vt,
                  int s0_tok, int s0_n, int s1_tok, int s1_n, bool band, int qtok,
                  float sink_l2, bool has_sink, bf16* outp, int ldo) {
    constexpr int KS = DQ * 2 + 16, VS = 144, BUF = 64 * KS + 64 * VS, NKS = DQ / 16;
    const int r = lane & 31, hh = lane >> 5;
    const int pr = (r & ~12) | ((r & 4) << 1) | ((r & 8) >> 1);
    bf16x8 qf[NKS];
#pragma unroll
    for (int ks = 0; ks < NKS; ++ks) qf[ks] = ks < 4 ? __builtin_nontemporal_load((const bf16x8*)(qn + (size_t)r * ldqn + 16 * ks + 8 * hh)) : __builtin_nontemporal_load((const bf16x8*)(qr + (size_t)r * ldqr + 16 * (ks - 4) + 8 * hh));
    f32x16 ot[2];
#pragma unroll
    for (int i = 0; i < 16; ++i) { ot[0][i] = 0.f; ot[1][i] = 0.f; }
    float mrun = 0.f; f32x16 lacc;
#pragma unroll
    for (int i = 0; i < 16; ++i) lacc[i] = 0.f;
    const int ntile = s0_n + s1_n;
    const int krow = tid >> 3, kch = tid & 7, rrow = tid >> 2, rch = tid & 3;
    v4u kreg, rreg, vreg;
    auto tile_tok = [&](int t) { return t < s0_n ? s0_tok + 64 * t : s1_tok + 64 * (t - s0_n); };
    auto gload = [&](int t) { const int tok0 = tile_tok(t);
        kreg = *(const v4u*)(Kb + (size_t)(tok0 + krow) * ldk + kch * 8);
        if (DQ == 96) { if (tid < 256) rreg = *(const v4u*)(Kr + (size_t)(tok0 + rrow) * 32 + rch * 8); }
        vreg = *(const v4u*)(Vt + (size_t)krow * MALL + tok0 + kch * 8); };
    auto lstore = [&](int b) { LAS unsigned char* kb_ = lds + b * BUF;
        *(LAS v4u*)(kb_ + krow * KS + kch * 16) = kreg;
        if (DQ == 96) { if (tid < 256) *(LAS v4u*)(kb_ + rrow * KS + 128 + rch * 16) = rreg; }
        *(LAS v4u*)(kb_ + 64 * KS + krow * VS + kch * 16) = vreg; };
    gload(0); lstore(0); __syncthreads();
    for (int t = 0; t < ntile; ++t) {
        const bool more = t + 1 < ntile;
        if (more) gload(t + 1);
        LAS unsigned char* kb_ = lds + (t & 1) * BUF; LAS unsigned char* vb_ = kb_ + 64 * KS;
        f32x16 st[2];
#pragma unroll
        for (int kb = 0; kb < 2; ++kb) {
#pragma unroll
            for (int i = 0; i < 16; ++i) st[kb][i] = 0.f;
#pragma unroll
            for (int ks = 0; ks < NKS; ++ks) { const bf16x8 kf = *(const LAS bf16x8*)(kb_ + (32 * kb + pr) * KS + (16 * ks + 8 * hh) * 2); st[kb] = MFMA32(kf, qf[ks], st[kb]); }
        }
        __builtin_amdgcn_sched_barrier(0);
        if (band && t < s0_n) { const int d0 = tile_tok(t) + 8 * hh - (qtok + r);
#pragma unroll
            for (int kb = 0; kb < 2; ++kb)
#pragma unroll
                for (int i = 0; i < 16; ++i) { const int d = d0 + 32 * kb + 16 * (i >> 3) + (i & 7); if (d > 128 || d < -128) st[kb][i] = -1e30f; } }
        float mx;
        { const f32x16& A = st[0]; const f32x16& B = st[1];
          float m0 = fmaxf(fmaxf(A[0], A[1]), A[2]), m1 = fmaxf(fmaxf(A[3], A[4]), A[5]), m2 = fmaxf(fmaxf(A[6], A[7]), A[8]), m3 = fmaxf(fmaxf(A[9], A[10]), A[11]);
          m0 = fmaxf(fmaxf(m0, A[12]), A[13]); m1 = fmaxf(fmaxf(m1, A[14]), A[15]); m2 = fmaxf(fmaxf(m2, B[0]), B[1]); m3 = fmaxf(fmaxf(m3, B[2]), B[3]);
          m0 = fmaxf(fmaxf(m0, B[4]), B[5]); m1 = fmaxf(fmaxf(m1, B[6]), B[7]); m2 = fmaxf(fmaxf(m2, B[8]), B[9]); m3 = fmaxf(fmaxf(m3, B[10]), B[11]);
          m0 = fmaxf(fmaxf(m0, B[12]), B[13]); m1 = fmaxf(fmaxf(m1, B[14]), B[15]); mx = fmaxf(fmaxf(m0, m1), fmaxf(m2, m3)); }
        mx = fmaxf(mx, __shfl_xor(mx, 32));
        { const bool up = mx > mrun + ATT_RS, dn = (t == 0) && (mx < mrun - ATT_RS);
          if (__builtin_amdgcn_ballot_w64(up || dn) != 0ull) {
              if (t == 0) { mrun = (up || dn) ? mx : mrun; }
              else { const float mnew = up ? mx : mrun, alpha = fexp2(mrun - mnew); mrun = mnew; lacc = lacc * alpha; ot[0] = ot[0] * alpha; ot[1] = ot[1] * alpha; } } }
        if (__builtin_amdgcn_ballot_w64(mrun != 0.f) != 0ull) { st[0] = st[0] - mrun; st[1] = st[1] - mrun; }
#pragma unroll
        for (int kb = 0; kb < 2; ++kb)
#pragma unroll
            for (int i = 0; i < 16; ++i) st[kb][i] = fexp2(st[kb][i]);
        lacc = lacc + (st[0] + st[1]);
#pragma unroll
        for (int kb = 0; kb < 2; ++kb)
#pragma unroll
            for (int s = 0; s < 2; ++s) { v4u pw; pw.x = pk2(st[kb][8 * s], st[kb][8 * s + 1]); pw.y = pk2(st[kb][8 * s + 2], st[kb][8 * s + 3]); pw.z = pk2(st[kb][8 * s + 4], st[kb][8 * s + 5]); pw.w = pk2(st[kb][8 * s + 6], st[kb][8 * s + 7]);
                const bf16x8 pf = __builtin_bit_cast(bf16x8, pw);
#pragma unroll
                for (int db = 0; db < 2; ++db) { const bf16x8 vf = *(const LAS bf16x8*)(vb_ + (32 * db + r) * VS + (32 * kb + 16 * s + 8 * hh) * 2); ot[db] = MFMA32(vf, pf, ot[db]); } }
        __builtin_amdgcn_sched_barrier(0);
        if (more) lstore((t + 1) & 1);
        __syncthreads();
    }
    float lrun = ((lacc[0] + lacc[1]) + (lacc[2] + lacc[3])) + ((lacc[4] + lacc[5]) + (lacc[6] + lacc[7])) + (((lacc[8] + lacc[9]) + (lacc[10] + lacc[11])) + ((lacc[12] + lacc[13]) + (lacc[14] + lacc[15])));
    if (has_sink && hh == 0) lrun += fexp2(sink_l2 - mrun);
    const float inv = 1.0f / (lrun + __shfl_xor(lrun, 32));
#pragma unroll
    for (int db = 0; db < 2; ++db)
#pragma unroll
        for (int a4 = 0; a4 < 4; ++a4) { v2u w; w.x = pk2(ot[db][4 * a4] * inv, ot[db][4 * a4 + 1] * inv); w.y = pk2(ot[db][4 * a4 + 2] * inv, ot[db][4 * a4 + 3] * inv);
            *(v2u*)(outp + (size_t)r * ldo + 32 * db + 8 * a4 + 4 * hh) = w; }
}

DI void attn_phase(const Args& a, LAS unsigned char* lds, int tid, int wave, int lane) {
    unsigned char* ws = a.ws;
    const bf16* qa = (const bf16*)(ws + OFF_QA); const bf16* ka = (const bf16*)(ws + OFF_KA); const bf16* vaT = (const bf16*)(ws + OFF_VAT);
    const bf16* qb = (const bf16*)(ws + OFF_QB); const bf16* kn = (const bf16*)(ws + OFF_KN); const bf16* kr = (const bf16*)(ws + OFF_KROPE); const bf16* vbT = (const bf16*)(ws + OFF_VBT);
    bf16* oa = (bf16*)a.out; bf16* ob = oa + 512;
    const float* sink = a.in[15];
    for (int uu = blockIdx.x; uu < 1024; uu += gridDim.x) {
        const int type = uu >> 8, u0 = uu & 255, vu = (u0 & 7) * 32 + (u0 >> 3);
        if (type == 0) {
            const int b = vu >> 6, h = (vu >> 3) & 7, qblk = vu & 7; const int tok = MP + b * 2048 + qblk * 256 + 32 * wave;
            attn_unit<96>(lds, tid, lane, qb + (size_t)tok * 768 + h * 64, 768, qb + (size_t)tok * 768 + 512 + h * 32, 768, kn + h * 64, 512, kr, vbT + (size_t)(h * 64) * MALL,
                          M + b * 512, 8, MP + b * 2048, 32, false, 0, 0.f, false, ob + (size_t)tok * 1024 + h * 64, 1024);
        } else if (type == 1) {
            const int b = vu >> 6, kh = (vu >> 5) & 1, qblk = vu & 31; const int head = kh * 4 + (wave >> 1); const int tok = MP + b * 2048 + qblk * 64 + 32 * (wave & 1);
            const int lo = qblk - 2 < 0 ? 0 : qblk - 2, hi = qblk + 2 > 31 ? 31 : qblk + 2;
            attn_unit<64>(lds, tid, lane, qa + (size_t)tok * 512 + head * 64, 512, nullptr, 0, ka + kh * 64, 128, nullptr, vaT + (size_t)(kh * 64) * MALL,
                          MP + b * 2048 + lo * 64, hi - lo + 1, M + b * 512, 8, true, tok, sink[head] * LOG2E, true, oa + (size_t)tok * 1024 + head * 64, 1024);
        } else if (type == 2) {
            const int b = vu >> 3, kh = (vu >> 2) & 1, qblk = vu & 3; const int head = kh * 4 + (wave >> 1); const int tok = b * 256 + qblk * 64 + 32 * (wave & 1);
            attn_unit<64>(lds, tid, lane, qa + (size_t)tok * 512 + head * 64, 512, nullptr, 0, ka + kh * 64, 128, nullptr, vaT + (size_t)(kh * 64) * MALL,
                          b * 256, 4, 0, 0, false, 0, sink[head] * LOG2E, true, oa + (size_t)tok * 1024 + head * 64, 1024);
        } else {
            const int b = vu >> 3, h = vu & 7; const int tok = b * 256 + 32 * wave;
            attn_unit<96>(lds, tid, lane, qb + (size_t)tok * 768 + h * 64, 768, qb + (size_t)tok * 768 + 512 + h * 32, 768, kn + h * 64, 512, kr, vbT + (size_t)(h * 64) * MALL,
                          b * 256, 4, 0, 0, false, 0, 0.f, false, ob + (size_t)tok * 1024 + h * 64, 1024);
        }
    }
}

__global__ void __launch_bounds__(512, 2) mk_fwd(Args a) {
    extern __shared__ __attribute__((aligned(16))) unsigned char lds_raw[];
    LAS unsigned char* lds = (LAS unsigned char*)lds_raw;
    cg::grid_group grid = cg::this_grid();
    const int tid = threadIdx.x, lane = tid & 63, wave = __builtin_amdgcn_readfirstlane(tid >> 6);
    const int G = gridDim.x, gw = blockIdx.x * 8 + wave, NGW = G * 8, gtid = blockIdx.x * 512 + tid, NT = G * 512;
    unsigned char* ws = a.ws;
    float* mods = (float*)(ws + OFF_MODS); float* ssq_q = (float*)(ws + OFF_SSQQ); float* ssq_kv = (float*)(ws + OFF_SSQKV);
    const float2* ropeA = (const float2*)(ws + OFF_ROPEA); const float2* ropeB = (const float2*)(ws + OFF_ROPEB);
    bf16* H = (bf16*)(ws + OFF_H); bf16* ACT = (bf16*)(ws + OFF_ACT);
    float* xr = a.out;
    const int lo = a.ph_lo, hi = a.ph_hi;
#if defined(TSK)
    const unsigned long long ts_start = __builtin_amdgcn_s_memrealtime(); unsigned long long ts_k = 0;
#endif
    if (hi > 1000) grid.sync();
    volatile LAS unsigned* xst = (volatile LAS unsigned*)(lds + 131072);
    if (tid < 2) xst[tid] = 0u;
    __syncthreads();
    XcdBarrier xbar = xcd_barrier_post((unsigned*)(ws + OFF_BAR), xst);
#ifndef P6M
#define P6M 7
#endif
#ifndef PH_MASK
#define PH_MASK 0x3fff
#endif
#define IN(k) (((PH_MASK >> (k)) & 1) && lo <= (k) && (k) < hi)
#define INX(k) (IN(k) || (k) == 4 || (k) == 10)
#if defined(TSK)
#define SEAM(k) do { if (IN(k) && INX((k) + 1)) xcd_barrier(xbar); if ((k) == TSK) ts_k = __builtin_amdgcn_s_memrealtime(); } while (0)
#else
#define SEAM(k) do { if (IN(k) && INX((k) + 1)) xcd_barrier(xbar); } while (0)
#endif
    if (IN(0)) { p0_misc(a, gtid, NT); p0_ada(a, lds, tid); }
    SEAM(0);
    float* ssq1 = (float*)(ws + OFF_SSQ1); float* ssq2 = (float*)(ws + OFF_SSQ2); float* shW2 = (float*)(ws + OFF_SHW2); float* shW3 = (float*)(ws + OFF_SHW3);
    if (IN(1)) { norm_mod_phase(a.in[0], a.in[1], a.in[10], mods, 0, H, gw, NGW, lane); p0_weights(a, lds, gw, NGW, wave, lane, 0, P0_EARLY); }
    SEAM(1);
    if (IN(2)) { pg8::Gemm g{H, (const bf16*)(ws + OFF_WGU1), M, NGU, D}; pg8::StaticOrder S; S.init(M, NGU, G, (int)blockIdx.x); EpiSwiglu<false> E{ACT, nullptr, nullptr};
        pg8::gemm_phase<EpiSwiglu<false>, pg8::StaticOrder, PG8_ALIGN, PG8_SP2>(lds, g, S, E);
        { const int nwg = (M / 256) * (NGU / 256), rounds = (nwg + G - 1) / G, first_idle = nwg - (rounds - 1) * G;
          const int nidle = G - first_idle;
          if (nidle <= 0) { shw_phase((const bf16*)(ws + OFF_WIN), NINP, mods, 3, shW2, gw, NGW, lane); p0_weights(a, lds, gw, NGW, wave, lane, P0_EARLY, P0_NIT); }
          else if ((int)blockIdx.x >= first_idle) { const int gw2 = ((int)blockIdx.x - first_idle) * 8 + wave, NGW2 = nidle * 8;
              shw_phase((const bf16*)(ws + OFF_WIN), NINP, mods, 3, shW2, gw2, NGW2, lane);
              p0_weights(a, lds, gw2, NGW2, wave, lane, P0_EARLY, P0_NIT); } } }
    SEAM(2);
    if (IN(3)) { pg8::Gemm g{ACT, (const bf16*)(ws + OFF_WD1), M, D, FF}; pg8::StaticOrder S; S.init(M, D, G, (int)blockIdx.x); EpiResid<true, false, false> E{a.in[0], a.in[1], nullptr, nullptr, nullptr, mods, H, a.in[13], ssq1, 2, 0, 4, 0.5f};
        pg8::gemm_phase<EpiResid<true, false, false>, pg8::StaticOrder, PG8_ALIGN, PG8_SP2>(lds, g, S, E); }
    SEAM(3);
    if (IN(5)) { pg8::Gemm g{H, (const bf16*)(ws + OFF_WIN), M, NINP, D}; pg8::StaticOrder S; S.init(M, NINP, G, (int)blockIdx.x);
        EpiWin E{(bf16*)(ws + OFF_QA), (bf16*)(ws + OFF_KA), (bf16*)(ws + OFF_VAT), (bf16*)(ws + OFF_QLAT), (bf16*)(ws + OFF_CKV), (bf16*)(ws + OFF_GA), (bf16*)(ws + OFF_GB), (bf16*)(ws + OFF_KROPE),
                 ssq_q, ssq_kv, a.out, ropeA, ropeB, true, ssq1, shW2};
        pg8::gemm_phase<EpiWin, pg8::StaticOrder, PG8_ALIGN, PG8_SP2>(lds, g, S, E);
        { const int nwg = (M / 256) * (NINP / 256), rounds = (nwg + G - 1) / G, first_idle = nwg - (rounds - 1) * G, nidle = G - first_idle;
          if (nidle <= 0) { ctx_convert(a, gtid, NT); shw_phase((const bf16*)(ws + OFF_WGU2), NGU, mods, 6, shW3, gw, NGW, lane); }
          else if ((int)blockIdx.x >= first_idle) { ctx_convert(a, ((int)blockIdx.x - first_idle) * 512 + tid, nidle * 512);
              shw_phase((const bf16*)(ws + OFF_WGU2), NGU, mods, 6, shW3, ((int)blockIdx.x - first_idle) * 8 + wave, nidle * 8, lane); } }
#if defined(DUP5)
        xcd_barrier(xbar); E.do_ssq = false; pg8::gemm_phase<EpiWin, pg8::StaticOrder, PG8_ALIGN, PG8_SP2>(lds, g, S, E);
#endif
    }
    SEAM(5);
#if defined(DUP6)
    for (int rep6 = 0; rep6 < 2; ++rep6) { if (rep6) xcd_barrier(xbar);
#endif
    if (IN(6)) {
        int K6 = 256; asm volatile("" : "+s"(K6));
#if P6M & 1
        { pg8::Gemm g{(const bf16*)(ws + OFF_QLAT), (const bf16*)(ws + OFF_WUQ), M, 768, K6}; pg8::StaticOrder S; S.init(M, 768, G, (int)blockIdx.x); EpiQB E{(bf16*)(ws + OFF_QB), ssq_q, ropeB};
          pg8::gemm_phase<EpiQB, pg8::StaticOrder, PG8_ALIGN, PG8_SP2>(lds, g, S, E); }
#endif
#if P6M & 2
        { pg8::Gemm g{(const bf16*)(ws + OFF_CKV), (const bf16*)(ws + OFF_WK), MALL, 512, K6}; pg8::StaticOrder S; S.init(MALL, 512, G, (int)((blockIdx.x + 64) % G)); EpiKN E{(bf16*)(ws + OFF_KN), ssq_kv};
          pg8::gemm_phase<EpiKN, pg8::StaticOrder, PG8_ALIGN, PG8_SP2>(lds, g, S, E); }
#endif
#if P6M & 4
        { pg8::Gemm g{(const bf16*)(ws + OFF_WV), (const bf16*)(ws + OFF_CKV), 512, MALL, K6}; pg8::StaticOrder S; S.init(512, MALL, G, (int)((blockIdx.x + 176) % G)); EpiVT E{(bf16*)(ws + OFF_VBT), ssq_kv};
          pg8::gemm_phase<EpiVT, pg8::StaticOrder, PG8_ALIGN, PG8_SP2>(lds, g, S, E); }
#endif
        { const bf16* ckv = (const bf16*)(ws + OFF_CKV); const float* gn = a.in[17]; float* o = a.out + OUT_CKV;
          for (int row = gw; row < MP; row += NGW) { const float rs = 1.0f / sqrtf(ssq_kv[row] * (1.f / 256.f) + EPS); const v2u w = *(const v2u*)(ckv + (size_t)row * 256 + 4 * lane); const f32x4 g4 = *(const f32x4*)(gn + 4 * lane);
              __builtin_nontemporal_store((f32x4){bflo(w.x), bfhi(w.x), bflo(w.y), bfhi(w.y)} * rs * g4, (f32x4*)(o + (size_t)row * 256 + 4 * lane)); } }
    }
#if defined(DUP6)
    }
#endif
    SEAM(6);
    if (IN(7)) attn_phase(a, lds, tid, wave, lane);
#if defined(DUP7)
    xcd_barrier(xbar); attn_phase(a, lds, tid, wave, lane);
#endif
    SEAM(7);
    if (IN(8)) { pg8::Gemm g{(const bf16*)a.out, (const bf16*)(ws + OFF_WOA), M, D, D}; pg8::StaticOrder S; S.init(M, D, G, (int)blockIdx.x); EpiMergeK E{(bf16*)(ws + OFF_MM), (const bf16*)(ws + OFF_GA), (const bf16*)(ws + OFF_GB)};
        pg8::gemm_phase<EpiMergeK, pg8::StaticOrder, PG8_ALIGN, PG8_SP2>(lds, g, S, E); }
    SEAM(8);
    if (IN(9)) { pg8::Gemm g{(const bf16*)(ws + OFF_MM), (const bf16*)(ws + OFF_WOUT), M, D, D}; pg8::StaticOrder S; S.init(M, D, G, (int)blockIdx.x); EpiResid<true, true, false> E{nullptr, nullptr, H, a.in[13], nullptr, mods, H, a.in[23], ssq2, 5, 4, 7, 1.0f};
        pg8::gemm_phase<EpiResid<true, true, false>, pg8::StaticOrder, PG8_ALIGN, PG8_SP2>(lds, g, S, E); }
    SEAM(9);
    if (IN(11)) { pg8::Gemm g{H, (const bf16*)(ws + OFF_WGU2), M, NGU, D}; pg8::StaticOrder S; S.init(M, NGU, G, (int)blockIdx.x); EpiSwiglu<true> E{ACT, ssq2, shW3};
        pg8::gemm_phase<EpiSwiglu<true>, pg8::StaticOrder, PG8_ALIGN, PG8_SP2>(lds, g, S, E); }
    SEAM(11);
    if (IN(12)) { pg8::Gemm g{ACT, (const bf16*)(ws + OFF_WD2), M, D, FF}; pg8::StaticOrder S; S.init(M, D, G, (int)blockIdx.x);
        if (G == 256) { EpiFinal E{H, a.in[23], xr, mods, a.in[26], (float*)(ws + OFF_PARTQ), (unsigned*)(ws + OFF_PCNT), 8, 7, 0.5f};
            pg8::gemm_phase<EpiFinal, pg8::StaticOrder, false, PG8_SP2>(lds, g, S, E); }
        else { EpiResid<false, true, true> E{nullptr, nullptr, H, a.in[23], xr, mods, nullptr, nullptr, nullptr, 8, 7, 0, 0.5f};
            pg8::gemm_phase<EpiResid<false, true, true>, pg8::StaticOrder, PG8_ALIGN, PG8_SP2>(lds, g, S, E);
            xcd_barrier(xbar); final_norm_phase(xr, a.in[26], gw, NGW, lane); } }
#if defined(TSK)
    if (blockIdx.x == 0 && tid == 0) { const unsigned long long t_end = __builtin_amdgcn_s_memrealtime(); const unsigned long long want = 4ull * (ts_k - ts_start); while (__builtin_amdgcn_s_memrealtime() - t_end < want) __builtin_amdgcn_s_sleep(8); }
#endif
#ifdef PROBE_SCALE
    grid.sync();
    { const size_t ranges[6][2] = {{0, (size_t)MP * D}, {(size_t)MP * D, (size_t)M * D}, {OUT_K, OUT_V}, {OUT_V, OUT_CKV}, {OUT_CKV, OUT_KR}, {OUT_KR, OUT_KR + 8192 * 32}};
#pragma unroll
      for (int o = 0; o < 6; ++o) if ((PROBE_SCALE >> o) & 1) for (size_t i = ranges[o][0] + gtid; i < ranges[o][1]; i += NT) a.out[i] *= 1.01f; }
#endif
#undef IN
#undef SEAM
}

constexpr int N_PHASES = 14;
extern "C" void kernel_launch(void* const* d_in, const int* in_sizes, int n_in, void* d_out, int out_size, void* d_ws, size_t ws_size, hipStream_t stream) {
    static int grid = 0;
    if (grid == 0) {
        if (n_in != 27 || ws_size < WS_END) { fprintf(stderr, "kernel_launch: unexpected n_in %d / ws %zu\n", n_in, ws_size); grid = -1; return; }
        int dev = 0, cus = 0, per_cu = 0;
        hipGetDevice(&dev); hipDeviceGetAttribute(&cus, hipDeviceAttributeMultiprocessorCount, dev);
        if (hipFuncSetAttribute((const void*)mk_fwd, hipFuncAttributeMaxDynamicSharedMemorySize, LDS_BYTES) != hipSuccess) { fprintf(stderr, "kernel_launch: hipFuncSetAttribute failed\n"); grid = -1; return; }
        if (hipOccupancyMaxActiveBlocksPerMultiprocessor(&per_cu, (const void*)mk_fwd, 512, LDS_BYTES) != hipSuccess || per_cu < 1) { fprintf(stderr, "kernel_launch: occupancy query gave %d\n", per_cu); per_cu = 1; }
        (void)hipGetLastError();
        grid = cus * 1;
        fprintf(stderr, "kernel_launch: cus %d per_cu %d grid %d\n", cus, per_cu, grid);
    }
    if (grid < 0) return;
    (void)hipMemsetAsync(d_ws, 0, ZERO_BYTES, stream);
    Args a{};
    for (int i = 0; i < 27; ++i) a.in[i] = (const float*)d_in[i];
    a.out = (float*)d_out; a.ws = (unsigned char*)d_ws;
#if MK_N_LAUNCHES == 1
    a.ph_lo = 0; a.ph_hi = N_PHASES;
    void* args[] = {&a};
    hipError_t e = hipLaunchCooperativeKernel((const void*)mk_fwd, dim3(grid), dim3(512), args, LDS_BYTES, stream);
    if (e != hipSuccess) fprintf(stderr, "cooperative launch failed: %s (grid %d)\n", hipGetErrorString(e), grid);
#else
    for (int p = 0; p < N_PHASES; ++p) { a.ph_lo = p; a.ph_hi = p + 1; hipLaunchKernelGGL(mk_fwd, dim3(grid), dim3(512), LDS_BYTES, stream, a); }
#endif
}
```

```cpp
#include <hip/hip_runtime.h>
#include <hip/hip_cooperative_groups.h>
#include <cstdio>
#include <cstdint>
namespace cg = cooperative_groups;
namespace pg8 {
#define PG8_LAS __attribute__((address_space(3)))
typedef unsigned short bf16_t;
typedef short bf16x8 __attribute__((ext_vector_type(8)));
typedef float f32x4 __attribute__((ext_vector_type(4)));
typedef unsigned u32x4 __attribute__((ext_vector_type(4)));
constexpr int BM = 256, BK = 64, HALF = 128, HTB = HALF * BK * 2  , STAGE_BYTES = 8 * HTB, NXCD = 8, WGM = 8;

__host__ __device__ __forceinline__ int lds_byte(int r, int c) { const int st = (r >> 4) * 2 + (c >> 5), rr = r & 15, cc = c & 31, ob = rr * 64 + cc * 2; return st * 1024 + (ob ^ (((ob >> 9) & 1) << 5)); }
__host__ __device__ __forceinline__ void stage_rc(int b, int& R, int& C) { const int st = b / 1024, sb = b % 1024, swz = sb ^ (((sb >> 9) & 1) << 5); R = (st >> 1) * 16 + swz / 64; C = (st & 1) * 32 + (swz % 64) / 2; }
__host__ __device__ __forceinline__ int perm32(int rho) { const int n = rho >> 4, i = rho & 15; return 8 * (i >> 2) + 4 * n + (i & 3); }

struct Unit { int pm, pn, half; };
struct Gemm { const bf16_t* A; const bf16_t* Bt; int M, N, K; };

struct StaticOrder {
    int nM, nN, nwg, G, c;
    __host__ __device__ void init(int M, int N, int G_, int c_) { nM = M / BM; nN = N / BM; nwg = nM * nN; G = G_; c = c_; }
    __host__ __device__ bool next(int i, Unit& u) const { const long L = (long)i * G + c; if (L >= nwg) return false; map(L, u); return true; }
    __host__ __device__ void map(long L, Unit& u) const {
        int wgid = (int)L; { const int q = nwg / NXCD, r = nwg % NXCD, xcd = wgid % NXCD, off = wgid / NXCD; wgid = (xcd < r ? xcd * (q + 1) : r * (q + 1) + (xcd - r) * q) + off; }
        const int nig = WGM * nN, gid = wgid / nig, fm = gid * WGM, gsz = (nM - fm) < WGM ? (nM - fm) : WGM;
        u.pm = fm + ((wgid % nig) % gsz); u.pn = (wgid % nig) / gsz; u.half = 0;
    }
    __device__ __forceinline__ void a_ready(const Unit&) const {}
    __device__ __forceinline__ void done(const Unit&) const {}
};
struct TailOrder : StaticOrder {
    __host__ __device__ bool next(int i, Unit& u) const {
        const int full = nwg / G, rem = nwg - full * G;
        if (rem == 0 || 2 * rem > G || (rem & 7) || (G & 15)) return StaticOrder::next(i, u);
        if (i < full) return StaticOrder::next(i, u);
        if (i > full) return false;
        const int x = c & 7, j = c >> 3;
        if ((j >> 1) >= rem / 8) return false;
        map((long)full * G + 8 * (j >> 1) + x, u); u.half = 1 + (j & 1); return true;
    }
};
__device__ __forceinline__ unsigned cvt_pk_bf16(float lo, float hi) { unsigned r; asm volatile("v_cvt_pk_bf16_f32 %0, %1, %2" : "=v"(r) : "v"(lo), "v"(hi)); return r; }
typedef float f32x2 __attribute__((ext_vector_type(2)));
template <class T, class = void> struct MidK { static constexpr bool value = false; };
template <class T> struct MidK<T, decltype((void)T::MIDK)> { static constexpr bool value = T::MIDK; };
template <class Epi, class Sched, bool ALIGN_EPI = false, bool SP2 = false, int A_AUX = 0>
__device__ __forceinline__ void gemm_phase(PG8_LAS unsigned char* lds, const Gemm g, const Sched& S, const Epi& E) {
    const int tid = threadIdx.x, wid = __builtin_amdgcn_readfirstlane(tid >> 6), lane = tid & 63, wr = wid >> 2, wc = wid & 3, fr = lane & 15, fq = lane >> 4;
    const int K = g.K, nt = K / BK;
    unsigned voffA[2], voffB[2];
#pragma unroll
    for (int i = 0; i < 2; ++i) { int R, C; stage_rc(tid * 16 + i * 8192, R, C); const int Rb = Epi::PERM ? ((R & ~31) + perm32(R & 31)) : R;
        voffA[i] = (unsigned)(R * K + C) * 2u; voffB[i] = (unsigned)(Rb * K + C) * 2u; }
    const size_t kstep = (size_t)(BK * 2);
    const size_t hstep = (size_t)HALF * K * 2;
    const size_t tstep = 2 * hstep;
    const unsigned ldsw = (unsigned)wid * 1024u;
    const int aoff = lds_byte(wr * 64 + fr, fq * 8), boff = lds_byte(wc * 32 + fr, fq * 8);
#define PG8_SA(b, h) (((b) * 2 + (h)) * HTB)
#define PG8_SB(b, h) ((4 + (b) * 2 + (h)) * HTB)
#define PG8_STAGE(bufoff, gbase, voff) do { _Pragma("unroll") for (int _i = 0; _i < 2; ++_i) \
        __builtin_amdgcn_global_load_lds((const unsigned*)((const char*)(gbase) + (voff)[_i]), (PG8_LAS unsigned*)(lds + (bufoff) + ldsw + _i * 8192), 16, 0, 0); } while (0)
#define PG8_STAGEA(bufoff, gbase, voff) do { _Pragma("unroll") for (int _i = 0; _i < 2; ++_i) \
        __builtin_amdgcn_global_load_lds((const unsigned*)((const char*)(gbase) + (voff)[_i]), (PG8_LAS unsigned*)(lds + (bufoff) + ldsw + _i * 8192), 16, 0, A_AUX); } while (0)
#define PG8_LDA(dst, b, h) do { _Pragma("unroll") for (int m = 0; m < 4; ++m) _Pragma("unroll") for (int k = 0; k < 2; ++k) dst[m][k] = *(const PG8_LAS bf16x8*)(lds + PG8_SA(b, h) + aoff + m * 2048 + k * 1024); } while (0)
#define PG8_LDB(dst, b, h) do { _Pragma("unroll") for (int n = 0; n < 2; ++n) _Pragma("unroll") for (int k = 0; k < 2; ++k) dst[n][k] = *(const PG8_LAS bf16x8*)(lds + PG8_SB(b, h) + boff + n * 2048 + k * 1024); } while (0)
#define PG8_MMA(ai, bj, At, Bt) do { __builtin_amdgcn_s_setprio(1); _Pragma("unroll") for (int m = 0; m < 4; ++m) _Pragma("unroll") for (int n = 0; n < 2; ++n) _Pragma("unroll") for (int k = 0; k < 2; ++k) \
        acc[ai][bj][m][n] = __builtin_amdgcn_mfma_f32_16x16x32_bf16(Bt[n][k], At[m][k], acc[ai][bj][m][n], 0, 0, 0); __builtin_amdgcn_s_setprio(0); } while (0)
#define PG8_WAIT_V(n) asm volatile("s_waitcnt vmcnt(" #n ")" ::: "memory")
#define PG8_WAIT_L(n) asm volatile("s_waitcnt lgkmcnt(" #n ")" ::: "memory")
#define PG8_BAR __builtin_amdgcn_s_barrier()
#define PG8_SCHED __builtin_amdgcn_sched_barrier(0)
    Unit cur, nxt; int ui = 0;
    if (!S.next(0, cur)) return;
    f32x4 acc[2][2][4][2];
#pragma unroll
    for (int a = 0; a < 2; ++a)
#pragma unroll
        for (int b = 0; b < 2; ++b)
#pragma unroll
            for (int m = 0; m < 4; ++m)
#pragma unroll
                for (int n = 0; n < 2; ++n) acc[a][b][m][n] = (f32x4){0.f, 0.f, 0.f, 0.f};
    bf16x8 At[4][2], B0[2][2], B1[2][2];
    const char* cA = (const char*)g.A + (size_t)cur.pm * tstep + (cur.half == 2 ? hstep : (size_t)0); const char* cB = (const char*)g.Bt + (size_t)cur.pn * tstep;
    S.a_ready(cur);
    if constexpr (SP2) {
        PG8_STAGE(PG8_SB(0, 0), cB, voffB); PG8_STAGE(PG8_SB(0, 1), cB + hstep, voffB); PG8_STAGEA(PG8_SA(0, 0), cA, voffA); PG8_STAGEA(PG8_SA(0, 1), cA + hstep, voffA);
        if (wr == 1) PG8_BAR;
        PG8_WAIT_V(2); PG8_BAR;
        PG8_STAGE(PG8_SB(1, 0), cB + kstep, voffB); PG8_STAGEA(PG8_SA(1, 0), cA + kstep, voffA); PG8_STAGE(PG8_SB(1, 1), cB + hstep + kstep, voffB);
        PG8_WAIT_V(6); PG8_BAR;
    } else {
        PG8_STAGE(PG8_SB(0, 0), cB, voffB); PG8_STAGEA(PG8_SA(0, 0), cA, voffA); PG8_STAGE(PG8_SB(0, 1), cB + hstep, voffB); PG8_STAGEA(PG8_SA(0, 1), cA + hstep, voffA);
        if (wr == 1) PG8_BAR;
        PG8_WAIT_V(4); PG8_BAR;
        PG8_STAGE(PG8_SB(1, 0), cB + kstep, voffB); PG8_STAGEA(PG8_SA(1, 0), cA + kstep, voffA); PG8_STAGE(PG8_SB(1, 1), cB + hstep + kstep, voffB);
        PG8_WAIT_V(6); PG8_BAR;
    }
    for (;;) {
        const bool has_next = S.next(ui + 1, nxt);
        const char* nA = has_next ? (const char*)g.A + (size_t)nxt.pm * tstep + (nxt.half == 2 ? hstep : (size_t)0) : cA; const char* nB = has_next ? (const char*)g.Bt + (size_t)nxt.pn * tstep : cB;
        for (int t = 0; t < nt; t += 2) {
            const bool last = (t == nt - 2);
            const char* a1 = cA + (size_t)(t + 1) * kstep;
            const char* a2 = last ? nA : cA + (size_t)(t + 2) * kstep; const char* b2 = last ? nB : cB + (size_t)(t + 2) * kstep;
            const char* a3 = a2 + kstep; const char* b3 = b2 + kstep;
            if constexpr (MidK<Epi>::value) { if (t == nt / 2) E.mid(acc, cur, wr, wc, fr, fq); }
            if (last && has_next) S.a_ready(nxt);
            if constexpr (SP2) {
            PG8_LDB(B0, 0, 0); PG8_LDB(B1, 0, 1); PG8_SCHED; PG8_LDA(At, 0, 0); PG8_STAGEA(PG8_SA(1, 1), a1 + hstep, voffA);
            PG8_WAIT_V(8); PG8_WAIT_L(0); PG8_BAR; PG8_MMA(0, 0, At, B0); PG8_MMA(0, 1, At, B1); PG8_BAR; PG8_SCHED;
            PG8_LDA(At, 0, 1); PG8_STAGE(PG8_SB(0, 0), b2, voffB); PG8_STAGE(PG8_SB(0, 1), b2 + hstep, voffB); PG8_STAGEA(PG8_SA(0, 0), a2, voffA);
            PG8_WAIT_V(8); PG8_WAIT_L(0); PG8_BAR; PG8_MMA(1, 0, At, B0); PG8_MMA(1, 1, At, B1); PG8_BAR; PG8_SCHED;
            PG8_LDB(B0, 1, 0); PG8_LDB(B1, 1, 1); PG8_SCHED; PG8_LDA(At, 1, 0); PG8_STAGEA(PG8_SA(0, 1), a2 + hstep, voffA);
            PG8_WAIT_V(8); PG8_WAIT_L(0); PG8_BAR; PG8_MMA(0, 0, At, B0); PG8_MMA(0, 1, At, B1); PG8_BAR; PG8_SCHED;
            PG8_LDA(At, 1, 1); PG8_STAGE(PG8_SB(1, 0), b3, voffB); PG8_STAGE(PG8_SB(1, 1), b3 + hstep, voffB); PG8_STAGEA(PG8_SA(1, 0), a3, voffA);
            PG8_WAIT_V(8); PG8_WAIT_L(0); PG8_BAR; PG8_MMA(1, 0, At, B0); PG8_MMA(1, 1, At, B1); PG8_BAR; PG8_SCHED;
            } else {
            PG8_LDB(B0, 0, 0); PG8_SCHED; PG8_LDA(At, 0, 0); PG8_STAGEA(PG8_SA(1, 1), a1 + hstep, voffA);
            PG8_WAIT_L(8); PG8_BAR; PG8_WAIT_L(0); PG8_MMA(0, 0, At, B0); PG8_BAR; PG8_SCHED;
            PG8_LDB(B1, 0, 1); PG8_STAGE(PG8_SB(0, 0), b2, voffB);
            PG8_BAR; PG8_WAIT_L(0); PG8_MMA(0, 1, At, B1); PG8_BAR;
            PG8_LDA(At, 0, 1); PG8_STAGEA(PG8_SA(0, 0), a2, voffA);
            PG8_BAR; PG8_WAIT_L(0); PG8_MMA(1, 0, At, B0); PG8_BAR; PG8_SCHED;
            PG8_STAGE(PG8_SB(0, 1), b2 + hstep, voffB);
            PG8_WAIT_V(6); PG8_BAR; PG8_MMA(1, 1, At, B1); PG8_BAR;
            PG8_LDB(B0, 1, 0); PG8_SCHED; PG8_LDA(At, 1, 0); PG8_STAGEA(PG8_SA(0, 1), a2 + hstep, voffA);
            PG8_WAIT_L(8); PG8_BAR; PG8_WAIT_L(0); PG8_MMA(0, 0, At, B0); PG8_BAR; PG8_SCHED;
            PG8_LDB(B1, 1, 1); PG8_STAGE(PG8_SB(1, 0), b3, voffB);
            PG8_BAR; PG8_WAIT_L(0); PG8_MMA(0, 1, At, B1); PG8_BAR;
            PG8_LDA(At, 1, 1); PG8_STAGEA(PG8_SA(1, 0), a3, voffA);
            PG8_BAR; PG8_WAIT_L(0); PG8_MMA(1, 0, At, B0); PG8_BAR; PG8_SCHED;
            PG8_STAGE(PG8_SB(1, 1), b3 + hstep, voffB);
            PG8_WAIT_V(6); PG8_BAR; PG8_MMA(1, 1, At, B1); PG8_BAR;
            }
        }
        if constexpr (ALIGN_EPI) { if (wr == 0) PG8_BAR; }
        if constexpr (!Epi::AFTER_DRAIN) { E(acc, cur, wr, wc, fr, fq); S.done(cur); }
        if (!has_next) break;
#pragma unroll
        for (int a = 0; a < 2; ++a)
#pragma unroll
            for (int b = 0; b < 2; ++b)
#pragma unroll
                for (int m = 0; m < 4; ++m)
#pragma unroll
                    for (int n = 0; n < 2; ++n) acc[a][b][m][n] = (f32x4){0.f, 0.f, 0.f, 0.f};
        cur = nxt; cA = nA; cB = nB; ++ui;
        if constexpr (ALIGN_EPI) { if (wr == 1) PG8_BAR; }
    }
    PG8_WAIT_V(0);
    if constexpr (!ALIGN_EPI) { if (wr == 0) PG8_BAR; }
    PG8_BAR;
    if constexpr (Epi::AFTER_DRAIN) { E.fused(acc, cur, wr, wc, fr, fq, lds, wid, lane); S.done(cur); }
#undef PG8_SA
#undef PG8_SB
#undef PG8_STAGE
#undef PG8_STAGEA
#undef PG8_LDA
#undef PG8_LDB
#undef PG8_MMA
#undef PG8_WAIT_V
#undef PG8_WAIT_L
#undef PG8_BAR
#undef PG8_SCHED
}
}
#ifndef PG8_SP2
#define PG8_SP2 true
#endif
#ifndef PG8_ALIGN
#define PG8_ALIGN true
#endif
#ifndef MK_N_LAUNCHES
#define MK_N_LAUNCHES 1
#endif
#define DI __device__ __forceinline__
#define LAS __attribute__((address_space(3)))
typedef unsigned short bf16;
typedef unsigned v4u __attribute__((ext_vector_type(4)));
typedef unsigned v2u __attribute__((ext_vector_type(2)));
typedef float f32x4 __attribute__((ext_vector_type(4)));
typedef float f32x16 __attribute__((ext_vector_type(16)));
typedef short bf16x8 __attribute__((ext_vector_type(8)));
using pg8::Unit;

constexpr int D = 1024, MP = 8192, M = 16384, MCTX = 2048, MALL = 18432;
constexpr int FF = 2816, NGU = 5632, NINP = 3584, NMODS = 9216;
constexpr float EPS = 1e-6f, LOG2E = 1.4426950408889634f;
constexpr float A_QS = 0.125f * LOG2E;
constexpr float B_QS = 0.10206207261596575f * LOG2E;
constexpr size_t OUT_K = (size_t)M * D, OUT_V = OUT_K + 8192 * 128, OUT_CKV = OUT_V + 8192 * 128, OUT_KR = OUT_CKV + 8192 * 256;
constexpr size_t MiB = 1u << 20;
constexpr size_t OFF_MODS = 0, OFF_SSQQ = 196608, OFF_SSQKV = 262144, OFF_BAR = 327680, OFF_SSQ1 = 344064, OFF_SSQ2 = 409600, OFF_PCNT = 475136, ZERO_BYTES = 491520, OFF_ROPEA = 524288, OFF_ROPEB = 532480, OFF_SHW2 = 589824, OFF_SHW3 = 663552;
constexpr size_t OFF_WGU1 = 1 * MiB, OFF_WGU2 = 12 * MiB, OFF_WD1 = 23 * MiB, OFF_WD2 = OFF_WD1 + 5767168, OFF_WIN = 34 * MiB, OFF_WOUT = 41 * MiB,
                 OFF_WOA = 43 * MiB, OFF_WOB = 44 * MiB, OFF_WUQ = 45 * MiB, OFF_WK = OFF_WUQ + 393216, OFF_WV = OFF_WK + 262144;
constexpr size_t OFF_H = 46 * MiB, OFF_OA = OFF_H, OFF_OB = OFF_H + 16 * MiB;
constexpr size_t OFF_ACT = 78 * MiB;
constexpr size_t OFF_QA = OFF_ACT, OFF_KA = OFF_QA + 16 * MiB, OFF_VAT = OFF_KA + (size_t)MALL * 128 * 2, OFF_QLAT = OFF_VAT + (size_t)MALL * 128 * 2,
                 OFF_CKV = OFF_QLAT + 8 * MiB, OFF_KROPE = OFF_CKV + 9 * MiB, OFF_QB = OFF_KROPE + (size_t)MALL * 32 * 2 + 131072, OFF_KN = OFF_QB + 24 * MiB;
constexpr size_t OFF_MM = OFF_ACT;
constexpr size_t OFF_GA = 166 * MiB, OFF_GB = 198 * MiB, OFF_VBT = 230 * MiB, OFF_PART1 = 248 * MiB, OFF_PART2 = 249 * MiB, OFF_PARTQ = 250 * MiB, OFF_PARTKV = 250 * MiB + 262144, WS_END = 251 * MiB;
static_assert(OFF_QLAT + 8 * MiB >= OFF_MM + 32 * MiB, "m overlay");
static_assert(OFF_KN + 18 * MiB <= OFF_GA && OFF_WV + 262144 <= OFF_H, "ws map");
constexpr int LDS_BYTES = 147456;

DI unsigned f2bf(float f) { unsigned u = __builtin_bit_cast(unsigned, f); return (u + 0x7fffu + ((u >> 16) & 1u)) >> 16; }
typedef __bf16 hbf16x2 __attribute__((ext_vector_type(2)));
typedef float hf32x2 __attribute__((ext_vector_type(2)));
DI unsigned pk2(float lo, float hi) { const hf32x2 f = {lo, hi}; return __builtin_bit_cast(unsigned, __builtin_convertvector(f, hbf16x2)); }
DI float bflo(unsigned w) { return __builtin_bit_cast(float, w << 16); }
DI float bfhi(unsigned w) { return __builtin_bit_cast(float, w & 0xffff0000u); }
DI float fexp2(float x) { return __builtin_amdgcn_exp2f(x); }
DI float frcp(float x) { return __builtin_amdgcn_rcpf(x); }
DI float rsq(float x) { return __builtin_amdgcn_rsqf(x); }
DI float sigm(float x) { return frcp(1.f + fexp2(-x * LOG2E)); }
#define LDS_WAIT() asm volatile("s_waitcnt lgkmcnt(0)" ::: "memory")
DI float wave_sum(float v) {
#pragma unroll
    for (int o = 1; o < 64; o <<= 1) v += __shfl_xor(v, o);
    return v;
}
DI float sum16(const float* p) { const f32x4 a = *(const f32x4*)p, b = *(const f32x4*)(p + 4), c = *(const f32x4*)(p + 8), d = *(const f32x4*)(p + 12); const f32x4 t = (a + b) + (c + d); return (t.x + t.y) + (t.z + t.w); }
DI float sum4(const float* p) { const f32x4 a = *(const f32x4*)p; return (a.x + a.y) + (a.z + a.w); }
DI int mod_index(int row) { return row < MP ? 0 : 1 + ((row - MP) >> 11); }

#define XB_TMO      128
#define XB_XCNT(j)  (256  + 64 * (j))
#define XB_XSUB(j)  (1280 + 64 * (j))
#define XB_XGEN(j)  (2304 + 64 * (j))
#define XB_TOP      3328
#define XB_TOPGEN   3392
#define XCD_BAR_WORDS 3456
#define XB_SPIN_CAP (1u << 18)

__device__ __forceinline__ unsigned xb_ld(unsigned* p)              { return __hip_atomic_load(p, __ATOMIC_RELAXED, __HIP_MEMORY_SCOPE_AGENT); }
__device__ __forceinline__ unsigned xb_add(unsigned* p, unsigned v) { return __hip_atomic_fetch_add(p, v, __ATOMIC_RELAXED, __HIP_MEMORY_SCOPE_AGENT); }
__device__ __forceinline__ unsigned xb_xcc_id() { return (unsigned)__builtin_amdgcn_s_getreg((3 << 11) | 20) & 0xFu; }
#define XB_SPIN(cond, bar) do { unsigned _sp = 0; while (cond) { __builtin_amdgcn_s_sleep(1); \
    if ((++_sp & 255u) == 0u) { if (xb_ld(&(bar)[XB_TMO])) break; if (_sp > XB_SPIN_CAP) { atomicAdd(&(bar)[XB_TMO], 1u); break; } } } } while (0)

struct XcdBarrier {
    unsigned* bar; unsigned x;
    volatile LAS unsigned* st;
};

__device__ __forceinline__ XcdBarrier xcd_barrier_post(unsigned* bar, volatile LAS unsigned* st) {
    XcdBarrier b; b.bar = bar; b.x = xb_xcc_id(); b.st = st;
    if (threadIdx.x == 0) (void)xb_add(&bar[XB_XCNT(b.x)], 1u);
    return b;
}
__device__ __forceinline__ void xcd_barrier_complete(unsigned* bar, unsigned x, unsigned& nloc, unsigned& nx) {
    const unsigned G = gridDim.x * gridDim.y * gridDim.z;
    unsigned sum, cnt, mine, sp = 0u;
    for (;;) {
        sum = 0u; cnt = 0u; mine = 0u;
#pragma unroll
        for (unsigned j = 0; j < 16; ++j) { const unsigned c = xb_ld(&bar[XB_XCNT(j)]); sum += c; cnt += (c > 0u) ? 1u : 0u; mine = (j == x) ? c : mine; }
        if (sum == G) break;
        __builtin_amdgcn_s_sleep(1);
        if ((++sp & 255u) == 0u) { if (xb_ld(&bar[XB_TMO])) break; if (sp > XB_SPIN_CAP) { atomicAdd(&bar[XB_TMO], 1u); break; } }
    }
    nloc = mine > 0u ? mine : 1u; nx = cnt > 0u ? cnt : 1u;
}

__device__ __forceinline__ void xcd_barrier(const XcdBarrier& b) {
    asm volatile("s_waitcnt vmcnt(0)" ::: "memory");
    __syncthreads();
    if (threadIdx.x == 0) {
        unsigned* bar = b.bar;
        __builtin_amdgcn_s_waitcnt(0);
        unsigned nloc = b.st[0], nx = b.st[1];
        if (nloc == 0u) { xcd_barrier_complete(bar, b.x, nloc, nx); b.st[0] = nloc; b.st[1] = nx; }
        const unsigned old = xb_add(&bar[XB_XSUB(b.x)], 1u);
        const unsigned gen = old / nloc;
        if (old + 1u == (gen + 1u) * nloc) {
            __builtin_amdgcn_fence(__ATOMIC_RELEASE, "agent");
            asm volatile("s_waitcnt vmcnt(0)" ::: "memory");
            const unsigned og = xb_add(&bar[XB_TOP], 1u);
            const unsigned tg = og / nx;
            if (og + 1u == (tg + 1u) * nx) xb_add(&bar[XB_TOPGEN], 1u);
            else XB_SPIN(xb_ld(&bar[XB_TOPGEN]) == tg, bar);
            __builtin_amdgcn_fence(__ATOMIC_ACQUIRE, "agent");
            xb_add(&bar[XB_XGEN(b.x)], 1u);
            asm volatile("s_waitcnt vmcnt(0)" ::: "memory");
        } else {
            XB_SPIN(xb_ld(&bar[XB_XGEN(b.x)]) == gen, bar);
            __builtin_amdgcn_fence(__ATOMIC_ACQUIRE, "agent");
            asm volatile("s_waitcnt vmcnt(0)" ::: "memory");
        }
    }
    __syncthreads();
}


DI void transpose_item(const float* W, int N, bf16* WT, int K, int k0, int src_n0, int dst_r0, const float* kscale, float sscale, LAS float* scr, int lane, int dk = 0, bool ntst = false) {
    if (src_n0 >= 0) {
        float v[32];
#pragma unroll
        for (int i = 0; i < 32; ++i) v[i] = __builtin_nontemporal_load(W + (size_t)(k0 + 2 * i + (lane >> 5)) * N + src_n0 + (lane & 31));
        if (kscale) {
#pragma unroll
            for (int i = 0; i < 32; ++i) v[i] *= kscale[k0 + 2 * i + (lane >> 5)]; }
#pragma unroll
        for (int i = 0; i < 32; ++i) scr[(2 * i + (lane >> 5)) * 33 + (lane & 31)] = v[i] * sscale;
    } else {
#pragma unroll 8
        for (int i = 0; i < 32; ++i) { const int kk = 2 * i + (lane >> 5); scr[kk * 33 + (lane & 31)] = 0.f; }
    }
    LDS_WAIT(); asm volatile("" ::: "memory");
    const int c = lane & 7;
#pragma unroll
    for (int j = 0; j < 4; ++j) { const int n = (lane >> 3) + 8 * j; const LAS float* s = scr + (8 * c) * 33 + n;
        v4u o; o.x = pk2(s[0 * 33], s[1 * 33]); o.y = pk2(s[2 * 33], s[3 * 33]); o.z = pk2(s[4 * 33], s[5 * 33]); o.w = pk2(s[6 * 33], s[7 * 33]);
        v4u* dp = (v4u*)(WT + (size_t)(dst_r0 + n) * K + k0 + dk + 8 * c);
        if (ntst) __builtin_nontemporal_store(o, dp); else *dp = o; }
    LDS_WAIT(); asm volatile("" ::: "memory");
}

struct Args { const float* in[27]; float* out; unsigned char* ws; int ph_lo, ph_hi; };

constexpr int I_GU = 16 * 176, I_D = 44 * 32, I_IN = 16 * 112, I_OUT = 16 * 32, I_O = 8 * 32, I_UQ = 4 * 24, I_K = 4 * 16;
constexpr int P0_EARLY = I_GU + I_IN, P0_NIT = P0_EARLY + I_GU + 2 * I_D + I_OUT + 2 * I_O + I_UQ + 2 * I_K;
DI void p0_weights(const Args& a, LAS unsigned char* lds, int gw, int NGW, int wave, int lane, int it_lo, int it_hi) {
    LAS float* scr = (LAS float*)(lds + wave * 16384);
    unsigned char* ws = a.ws;
    for (int it = it_lo + gw; it < it_hi; it += NGW) {
        int r = it;
        if (r < I_GU) { const int w = 0; const int kb = r / 176, nb = r % 176, R0 = 32 * nb;
            const int pn = R0 >> 8, half = (R0 >> 7) & 1, j = R0 & 127;
            transpose_item(a.in[w ? 24 : 11], NGU, (bf16*)(ws + (w ? OFF_WGU2 : OFF_WGU1)), 1024, 64 * kb, half * FF + 128 * pn + j, R0, nullptr, half ? (1.0f / LOG2E) : LOG2E, scr, lane); continue; }
        r -= I_GU;
        if (r < I_IN) { const int kb = r / 112, nb = r % 112, R0 = 32 * nb;
            const int gq = R0 - 1280; const int src = R0 < 1280 ? R0 : (R0 < 3328 ? (((gq >> 7) & 1) ? 2336 : 1312) + 128 * (gq >> 8) + (gq & 127) : (R0 == 3328 ? 1280 : -1));
            transpose_item(a.in[14], 3360, (bf16*)(ws + OFF_WIN), 1024, 64 * kb, src, R0, nullptr, (R0 >= 1280 && R0 < 3328) ? LOG2E : 1.f, scr, lane); continue; }
        r -= I_IN;
        if (r < I_GU) { const int w = 1; const int kb = r / 176, nb = r % 176, R0 = 32 * nb;
            const int pn = R0 >> 8, half = (R0 >> 7) & 1, j = R0 & 127;
            transpose_item(a.in[w ? 24 : 11], NGU, (bf16*)(ws + (w ? OFF_WGU2 : OFF_WGU1)), 1024, 64 * kb, half * FF + 128 * pn + j, R0, nullptr, half ? (1.0f / LOG2E) : LOG2E, scr, lane, 0, true); continue; }
        r -= I_GU;
        if (r < I_D) { const int kb = r / 32, nb = r % 32;
            transpose_item(a.in[12], 1024, (bf16*)(ws + OFF_WD1), FF, 64 * kb, 32 * nb, 32 * nb, nullptr, 1.f, scr, lane); continue; }
        r -= I_D;
        if (r < I_D) { const int kb = r / 32, nb = r % 32;
            transpose_item(a.in[25], 1024, (bf16*)(ws + OFF_WD2), FF, 64 * kb, 32 * nb, 32 * nb, nullptr, 1.f, scr, lane, 0, true); continue; }
        r -= I_D;
        if (r < I_OUT) { const int kb = r / 32, nb = r % 32; transpose_item(a.in[22], 1024, (bf16*)(ws + OFF_WOUT), 1024, 64 * kb, 32 * nb, 32 * nb, nullptr, 1.f, scr, lane, 0, true); continue; }
        r -= I_OUT;
        if (r < 2 * I_O) { const int w = r >= I_O; r -= w * I_O; const int kb = r / 32, nb = r % 32;
            transpose_item(a.in[w ? 21 : 20], 1024, (bf16*)(ws + OFF_WOA), 1024, 64 * kb, 32 * nb, 32 * nb, nullptr, 1.f, scr, lane, w ? 512 : 0, true); continue; }
        r -= 2 * I_O;
        if (r < I_UQ) { const int kb = r / 24, nb = r % 24, R0 = 32 * nb;
            const int src = R0 < 512 ? (R0 >> 6) * 96 + (R0 & 63) : ((R0 - 512) >> 5) * 96 + 64;
            transpose_item(a.in[18], 768, (bf16*)(ws + OFF_WUQ), 256, 64 * kb, src, R0, a.in[16], B_QS, scr, lane, 0, true); continue; }
        r -= I_UQ;
        { const int w = r >= I_K; r -= w * I_K; const int kb = r / 16, nb = r % 16, R0 = 32 * nb;
            const int src = (R0 >> 6) * 128 + (R0 & 63) + (w ? 64 : 0);
            transpose_item(a.in[19], 1024, (bf16*)(ws + (w ? OFF_WV : OFF_WK)), 256, 64 * kb, src, R0, a.in[17], 1.f, scr, lane, 0, true); }
    }
}
DI void p0_ada(const Args& a, LAS unsigned char* lds, int tid) {
    LAS float* sc = (LAS float*)lds;
    LAS float* red = (LAS float*)(lds + 4096);
    float* mods = (float*)(a.ws + OFF_MODS);
    const float* adaw = a.in[8];
    for (int it = blockIdx.x; it < 256; it += gridDim.x) {
        const int cgp = it & 31, ks = it >> 5;
        __syncthreads();
        for (int i = tid; i < 640; i += 512) { const int v = i >> 7, k = ks * 128 + (i & 127); const float c = v == 0 ? a.in[7][k] : a.in[6][(v - 1) * 1024 + k]; sc[i] = c * sigm(c); }
        __syncthreads();
        const int colq = tid % 72, kl = tid / 72;
        if (kl < 7) {
            f32x4 acc[5];
#pragma unroll
            for (int v = 0; v < 5; ++v) acc[v] = (f32x4){0.f, 0.f, 0.f, 0.f};
            f32x4 w[19];
#pragma unroll
            for (int q = 0; q < 19; ++q) { const int k = kl + 7 * q; w[q] = k < 128 ? __builtin_nontemporal_load((const f32x4*)(adaw + (size_t)(ks * 128 + k) * NMODS + cgp * 288 + colq * 4)) : (f32x4){0.f, 0.f, 0.f, 0.f}; }
#pragma unroll
            for (int q = 0; q < 19; ++q) { const int k = kl + 7 * q; if (k < 128) {
#pragma unroll
                for (int v = 0; v < 5; ++v) acc[v] += w[q] * sc[v * 128 + k]; } }
#pragma unroll
            for (int v = 0; v < 5; ++v) *(LAS f32x4*)(red + (kl * 5 + v) * 288 + colq * 4) = acc[v];
        }
        __syncthreads();
        for (int i = tid; i < 1440; i += 512) { const int v = i / 288, cc = i % 288; float s = 0.f;
#pragma unroll
            for (int q = 0; q < 7; ++q) s += red[(q * 5 + v) * 288 + cc];
            const int col = cgp * 288 + cc; if (ks == 0) s += a.in[9][col];
            atomicAdd(mods + v * NMODS + col, s); }
    }
    __syncthreads();
}
DI void ctx_convert(const Args& a, int gtid, int NT) {
    unsigned char* ws = a.ws;
    bf16* ka = (bf16*)(ws + OFF_KA) + (size_t)M * 128; bf16* vaT = (bf16*)(ws + OFF_VAT); bf16* ckv = (bf16*)(ws + OFF_CKV) + (size_t)M * 256; bf16* kr = (bf16*)(ws + OFF_KROPE) + (size_t)M * 32;
    for (int i = gtid; i < MCTX * 128; i += NT) ka[i] = (bf16)f2bf(a.in[2][i]);
    for (int i = gtid; i < MCTX * 128; i += NT) { const int f = i >> 11, tk = i & 2047; vaT[(size_t)f * MALL + M + tk] = (bf16)f2bf(a.in[3][tk * 128 + f]); }
    for (int i = gtid; i < MCTX * 256; i += NT) ckv[i] = (bf16)f2bf(a.in[4][i] / a.in[17][i & 255]);
    for (int i = gtid; i < MCTX * 32; i += NT) kr[i] = (bf16)f2bf(a.in[5][i]);
}
DI void p0_misc(const Args& a, int gtid, int NT) {
    unsigned char* ws = a.ws;
    float2* ra = (float2*)(ws + OFF_ROPEA); float2* rb = (float2*)(ws + OFF_ROPEB);
    for (int i = gtid; i < 1024; i += NT) { const int pos = i >> 4, fi = i & 15; const float inv = 1.0f / powf(10000.f, (float)(2 * fi) / 32.f); const float ang = (float)pos * inv; ra[i] = make_float2(cosf(ang), sinf(ang)); }
    for (int i = gtid; i < 512; i += NT) { const int pos = i >> 3, fi = i & 7; const float inv = 1.0f / powf(10000.f, (float)(2 * fi) / 16.f); const float ang = (float)pos * inv; rb[i] = make_float2(cosf(ang), sinf(ang)); }
}

DI void norm_mod_phase(const float* xa, const float* xb, const float* gain, const float* mods, int s, bf16* h, int gw, int NGW, int lane) {
    for (int row = gw; row < M; row += NGW) {
        const float* xr = row < MP ? xa + (size_t)row * D : xb + (size_t)(row - MP) * D;
        f32x4 v[4]; float ss = 0.f;
#pragma unroll
        for (int j = 0; j < 4; ++j) { v[j] = *(const f32x4*)(xr + 4 * (64 * j + lane)); ss += (v[j].x * v[j].x + v[j].y * v[j].y) + (v[j].z * v[j].z + v[j].w * v[j].w); }
        const float rstd = 1.0f / sqrtf(wave_sum(ss) * (1.f / D) + EPS);
        const float* sh = mods + mod_index(row) * NMODS + (3 * s) * D; const float* sc = sh + D;
#pragma unroll
        for (int j = 0; j < 4; ++j) { const int c = 4 * (64 * j + lane); const f32x4 g = *(const f32x4*)(gain + c), s4 = *(const f32x4*)(sh + c), c4 = *(const f32x4*)(sc + c);
            const f32x4 o = (v[j] * rstd * g) * (c4 + 1.0f) + s4; v2u w; w.x = pk2(o.x, o.y); w.y = pk2(o.z, o.w); *(v2u*)(h + (size_t)row * D + c) = w; }
    }
}
DI void shw_phase(const bf16* WT, int nrows, const float* mods, int shslot, float* shW, int gw, int NGW, int lane) {
    for (int n = gw; n < nrows; n += NGW) {
        const v4u w0 = *(const v4u*)(WT + (size_t)n * D + 16 * lane), w1 = *(const v4u*)(WT + (size_t)n * D + 16 * lane + 8);
        f32x4 a0, a1, a2, a3; { f32x4 t0, t1; a0 = (f32x4){bflo(w0.x), bfhi(w0.x), bflo(w0.y), bfhi(w0.y)}; a1 = (f32x4){bflo(w0.z), bfhi(w0.z), bflo(w0.w), bfhi(w0.w)};
            a2 = (f32x4){bflo(w1.x), bfhi(w1.x), bflo(w1.y), bfhi(w1.y)}; a3 = (f32x4){bflo(w1.z), bfhi(w1.z), bflo(w1.w), bfhi(w1.w)}; }
#pragma unroll
        for (int b = 0; b < 5; ++b) { const float* sh = mods + b * NMODS + shslot * D + 16 * lane;
            const f32x4 p = a0 * *(const f32x4*)(sh) + a1 * *(const f32x4*)(sh + 4) + a2 * *(const f32x4*)(sh + 8) + a3 * *(const f32x4*)(sh + 12);
            const float sum = wave_sum((p.x + p.y) + (p.z + p.w)); if (lane == 0) shW[b * nrows + n] = sum; }
    }
}
DI void final_norm_phase(float* x, const float* gain, int gw, int NGW, int lane) {
    for (int row = gw; row < M; row += NGW) {
        float* xr = x + (size_t)row * D; f32x4 v[4]; float ss = 0.f;
#pragma unroll
        for (int j = 0; j < 4; ++j) { v[j] = *(const f32x4*)(xr + 4 * (64 * j + lane)); ss += (v[j].x * v[j].x + v[j].y * v[j].y) + (v[j].z * v[j].z + v[j].w * v[j].w); }
        const float rstd = 1.0f / sqrtf(wave_sum(ss) * (1.f / D) + EPS);
#pragma unroll
        for (int j = 0; j < 4; ++j) { const int c = 4 * (64 * j + lane); *(f32x4*)(xr + c) = v[j] * rstd * *(const f32x4*)(gain + c); }
    }
}
#define EPI_ARGS const f32x4 (&acc)[2][2][4][2], const Unit& u, int wr, int wc, int fr, int fq
DI v4u pack8(const f32x4& a, const f32x4& b) { v4u w; w.x = pk2(a.x, a.y); w.y = pk2(a.z, a.w); w.z = pk2(b.x, b.y); w.w = pk2(b.z, b.w); return w; }
DI void unpack8(const v4u& w, f32x4& a, f32x4& b) { a = (f32x4){bflo(w.x), bfhi(w.x), bflo(w.y), bfhi(w.y)}; b = (f32x4){bflo(w.z), bfhi(w.z), bflo(w.w), bfhi(w.w)}; }
DI f32x4 shx4(const f32x4& v, int m) { return (f32x4){__shfl_xor(v.x, m), __shfl_xor(v.y, m), __shfl_xor(v.z, m), __shfl_xor(v.w, m)}; }
DI void rope8(f32x4& v0, f32x4& v1, const float2* cs, int xm, float sgn) {
    const f32x4 p0 = shx4(v0, xm), p1 = shx4(v1, xm);
    const f32x4 t0 = *(const f32x4*)(cs), t1 = *(const f32x4*)(cs + 2), t2 = *(const f32x4*)(cs + 4), t3 = *(const f32x4*)(cs + 6);
    v0 = (f32x4){v0.x * t0.x + sgn * p0.x * t0.y, v0.y * t0.z + sgn * p0.y * t0.w, v0.z * t1.x + sgn * p0.z * t1.y, v0.w * t1.z + sgn * p0.w * t1.w};
    v1 = (f32x4){v1.x * t2.x + sgn * p1.x * t2.y, v1.y * t2.z + sgn * p1.y * t2.w, v1.z * t3.x + sgn * p1.z * t3.y, v1.w * t3.z + sgn * p1.w * t3.w};
}

template <bool NORM> struct EpiSwiglu { static constexpr bool PERM = true, AFTER_DRAIN = false; bf16* O; const float* ssq; const float* shW;
    DI void operator()(EPI_ARGS) const {
        asm volatile("" : "+v"(fr), "+v"(fq));
        const int row0 = u.pm * 256 + (u.half == 2 ? 128 : 0) + wr * 64 + fr, col0 = u.pn * 128 + wc * 32 + 8 * fq;
        f32x4 sw[2][2];
        if (NORM) { const float* sp = shW + mod_index(u.pm * 256) * NGU + u.pn * 256 + wc * 32 + 8 * fq;
#pragma unroll
            for (int bj = 0; bj < 2; ++bj)
#pragma unroll
                for (int n = 0; n < 2; ++n) sw[bj][n] = *(const f32x4*)(sp + bj * 128 + 4 * n); }
#pragma unroll
        for (int ai = 0; ai < 2; ++ai) { if (ai == 1 && u.half) break;
#pragma unroll
            for (int m = 0; m < 4; ++m) { f32x4 o[2]; const int row = row0 + ai * 128 + m * 16;
                float rs = 1.f; if (NORM) rs = rsq(ssq[row] * (1.f / D) + EPS);
#pragma unroll
                for (int n = 0; n < 2; ++n) { f32x4 g = acc[ai][0][m][n], uu = acc[ai][1][m][n];
                    if (NORM) { g = g * rs + sw[0][n]; uu = uu * rs + sw[1][n]; }
#pragma unroll
                    for (int j = 0; j < 4; ++j) o[n][j] = g[j] * frcp(1.f + fexp2(-g[j])) * uu[j]; }
                *(v4u*)(O + (size_t)row * FF + col0) = pack8(o[0], o[1]); } }
    }
};
DI f32x4 gsafe(const f32x4& g) { f32x4 r; for (int j = 0; j < 4; ++j) r[j] = fabsf(g[j]) < 1e-20f ? 1e-20f : g[j]; return r; }
template <bool NEXT, bool RECON, bool WRITE_X> struct EpiResid { static constexpr bool PERM = false, AFTER_DRAIN = false;
    const float* inA; const float* inB; const bf16* hin; const float* gain_prev; float* out; const float* mods; bf16* hn; const float* gain; float* ssq; int gslot; int scprev; int scslot; float coef;
    DI void operator()(EPI_ARGS) const {
        asm volatile("" : "+v"(fr), "+v"(fq));
        const int row0 = u.pm * 256 + wr * 64 + fr, col0 = u.pn * 256 + wc * 32 + 4 * fq;
        const float* mb = mods + mod_index(u.pm * 256) * NMODS; const float* gate = mb + gslot * D;
        f32x4 gv[2][2], gg[2][2], rg[2][2];
#pragma unroll
        for (int bj = 0; bj < 2; ++bj)
#pragma unroll
            for (int n = 0; n < 2; ++n) { const int c = col0 + bj * 128 + n * 16; gv[bj][n] = *(const f32x4*)(gate + c) * coef;
                if (NEXT) gg[bj][n] = gsafe(*(const f32x4*)(gain + c) * (*(const f32x4*)(mb + scslot * D + c) + 1.0f));
                if (RECON) { const f32x4 g = gsafe(*(const f32x4*)(gain_prev + c) * (*(const f32x4*)(mb + scprev * D + c) + 1.0f)); rg[bj][n] = (f32x4){1.0f / g.x, 1.0f / g.y, 1.0f / g.z, 1.0f / g.w}; } }
#pragma unroll
        for (int ai = 0; ai < 2; ++ai)
#pragma unroll
            for (int m = 0; m < 4; ++m) { const int row = row0 + ai * 128 + m * 16;
                const float* ip = row < MP ? inA + (size_t)row * D : inB + (size_t)(row - MP) * D; float s = 0.f;
#pragma unroll
                for (int bj = 0; bj < 2; ++bj)
#pragma unroll
                    for (int n = 0; n < 2; ++n) { const int c = col0 + bj * 128 + n * 16; f32x4 xin;
                        if (RECON) { const v2u w = *(const v2u*)(hin + (size_t)row * D + c); xin = (f32x4){bflo(w.x), bfhi(w.x), bflo(w.y), bfhi(w.y)} * rg[bj][n]; }
                        else xin = __builtin_nontemporal_load((const f32x4*)(ip + c));
                        const f32x4 x = xin + gv[bj][n] * acc[ai][bj][m][n];
                        if (WRITE_X) *(f32x4*)(out + (size_t)row * D + c) = x;
                        if (NEXT) { s += (x.x * x.x + x.y * x.y) + (x.z * x.z + x.w * x.w); const f32x4 y = x * gg[bj][n]; v2u w; w.x = pk2(y.x, y.y); w.y = pk2(y.z, y.w); *(v2u*)(hn + (size_t)row * D + c) = w; } }
                if (NEXT) { s += __shfl_xor(s, 16); s += __shfl_xor(s, 32); if (fq == 0) atomicAdd(ssq + row, s); } }
    }
};
struct EpiFinal { static constexpr bool PERM = false, AFTER_DRAIN = true; const bf16* hin; const float* gain_prev; float* out; const float* mods; const float* fgain; float* xbuf; unsigned* cnt; int gslot; int scprev; float coef;
    DI void operator()(EPI_ARGS) const {}
    DI void fused(f32x4 (&acc)[2][2][4][2], const Unit& u, int wr, int wc, int fr, int fq, LAS unsigned char* lds, int wid, int lane) const {
        const int tid = wid * 64 + lane;
        const int row0 = u.pm * 256 + wr * 64 + fr, col0 = u.pn * 256 + wc * 32 + 4 * fq;
        const float* gate = mods + mod_index(u.pm * 256) * NMODS + gslot * D;
        LAS float* P = (LAS float*)lds; LAS float* S = (LAS float*)(lds + 4096);
        f32x4 gv[2][2], rg[2][2]; const float* mb = mods + mod_index(u.pm * 256) * NMODS;
#pragma unroll
        for (int bj = 0; bj < 2; ++bj)
#pragma unroll
            for (int n = 0; n < 2; ++n) { const int c = col0 + bj * 128 + n * 16; gv[bj][n] = *(const f32x4*)(gate + c) * coef;
                const f32x4 g = gsafe(*(const f32x4*)(gain_prev + c) * (*(const f32x4*)(mb + scprev * D + c) + 1.0f)); rg[bj][n] = (f32x4){1.0f / g.x, 1.0f / g.y, 1.0f / g.z, 1.0f / g.w}; }
#pragma unroll
        for (int ai = 0; ai < 2; ++ai)
#pragma unroll
            for (int m = 0; m < 4; ++m) { const int row = row0 + ai * 128 + m * 16; const bf16* ip = hin + (size_t)row * D; float s = 0.f;
#pragma unroll
                for (int bj = 0; bj < 2; ++bj)
#pragma unroll
                    for (int n = 0; n < 2; ++n) { const v2u w = __builtin_nontemporal_load((const v2u*)(ip + col0 + bj * 128 + n * 16)); const f32x4 x = (f32x4){bflo(w.x), bfhi(w.x), bflo(w.y), bfhi(w.y)} * rg[bj][n] + gv[bj][n] * acc[ai][bj][m][n]; acc[ai][bj][m][n] = x; s += (x.x * x.x + x.y * x.y) + (x.z * x.z + x.w * x.w); }
                s += __shfl_xor(s, 16); s += __shfl_xor(s, 32);
                if (fq == 0) P[(ai * 128 + wr * 64 + m * 16 + fr) * 4 + wc] = s; }
        LDS_WAIT(); __syncthreads();
        if (tid < 256) { const f32x4 p = *(const LAS f32x4*)(P + tid * 4);
            __hip_atomic_store(xbuf + (size_t)(u.pm * 256 + tid) * 4 + u.pn, (p.x + p.y) + (p.z + p.w), __ATOMIC_RELAXED, __HIP_MEMORY_SCOPE_AGENT);
            asm volatile("s_waitcnt vmcnt(0)" ::: "memory");
            if (lane == 0) __hip_atomic_fetch_add(cnt + 64 * u.pm, 1u, __ATOMIC_RELAXED, __HIP_MEMORY_SCOPE_AGENT); }
        if (wid == 0) { unsigned sp = 0;
            while ((unsigned)__builtin_amdgcn_readfirstlane(__hip_atomic_load(cnt + 64 * u.pm, __ATOMIC_RELAXED, __HIP_MEMORY_SCOPE_AGENT)) < 16u) { __builtin_amdgcn_s_sleep(2); if (++sp > (1u << 22)) break; }
            __builtin_amdgcn_fence(__ATOMIC_ACQUIRE, "agent"); }
        asm volatile("s_waitcnt vmcnt(0) lgkmcnt(0)" ::: "memory"); __syncthreads();
        if (tid < 256) { const float* xp = xbuf + (size_t)(u.pm * 256 + tid) * 4; float t = 0.f;
#pragma unroll
            for (int q = 0; q < 4; ++q) t += __hip_atomic_load(xp + q, __ATOMIC_RELAXED, __HIP_MEMORY_SCOPE_AGENT);
            S[tid] = rsq(t * (1.f / D) + EPS); }
        LDS_WAIT(); __syncthreads();
        f32x4 fg[2][2];
#pragma unroll
        for (int bj = 0; bj < 2; ++bj)
#pragma unroll
            for (int n = 0; n < 2; ++n) fg[bj][n] = *(const f32x4*)(fgain + col0 + bj * 128 + n * 16);
#pragma unroll
        for (int ai = 0; ai < 2; ++ai)
#pragma unroll
            for (int m = 0; m < 4; ++m) { const int rl = ai * 128 + wr * 64 + m * 16 + fr; const float rs = S[rl]; float* op = out + (size_t)(u.pm * 256 + rl) * D;
#pragma unroll
                for (int bj = 0; bj < 2; ++bj)
#pragma unroll
                    for (int n = 0; n < 2; ++n) __builtin_nontemporal_store(acc[ai][bj][m][n] * rs * fg[bj][n], (f32x4*)(op + col0 + bj * 128 + n * 16)); }
    }
};
struct EpiWin { static constexpr bool PERM = true, AFTER_DRAIN = false;
    bf16 *qa, *ka, *vaT, *qlat, *ckv, *ga, *gb, *krope; float *ssq_q, *ssq_kv; float* out; const float2* ropeA; const float2* ropeB; bool do_ssq; const float* ssq1; const float* shW;
    DI void operator()(EPI_ARGS) const {
        asm volatile("" : "+v"(fr), "+v"(fq));
        const int pn = u.pn; const bool sample = u.pm >= 32;
        const int rbase = u.pm * 256 + (u.half == 2 ? 128 : 0) + wr * 64 + fr;
        f32x4 sw[2][2]; { const float* sp = shW + mod_index(u.pm * 256) * NINP + pn * 256 + wc * 32 + 8 * fq;
#pragma unroll
            for (int bj = 0; bj < 2; ++bj)
#pragma unroll
                for (int n = 0; n < 2; ++n) sw[bj][n] = *(const f32x4*)(sp + bj * 128 + 4 * n); }
#define WACC(ai, bj, m, n) (acc[ai][bj][m][n] * rs + sw[bj][n])
        if (pn < 3) {
#pragma unroll
            for (int ai = 0; ai < 2; ++ai) { if (ai == 1 && u.half) break;
#pragma unroll
                for (int m = 0; m < 4; ++m) { const int row = rbase + ai * 128 + m * 16; const float rs = rsq(ssq1[row] * (1.f / D) + EPS); const int t = (row - MP) & 2047; const int pos = (wc & 1) ? (t & 63) : (t >> 6);
                    const float2* cs = ropeA + pos * 16 + 8 * (fq & 1); const float sgn = (fq & 2) ? 1.f : -1.f;
#pragma unroll
                    for (int bj = 0; bj < 2; ++bj) { f32x4 v0 = WACC(ai, bj, m, 0), v1 = WACC(ai, bj, m, 1); const int cl = bj * 128 + wc * 32 + 8 * fq;
                        if (pn < 2) { if (sample) rope8(v0, v1, cs, 32, sgn); v0 = v0 * A_QS; v1 = v1 * A_QS; *(v4u*)(qa + (size_t)row * 512 + pn * 256 + cl) = pack8(v0, v1); }
                        else if (bj == 0) { if (sample) rope8(v0, v1, cs, 32, sgn); *(v4u*)(ka + (size_t)row * 128 + cl) = pack8(v0, v1);
                            if (!sample) { float* o = out + OUT_K + (size_t)row * 128 + cl; __builtin_nontemporal_store(v0, (f32x4*)o); __builtin_nontemporal_store(v1, (f32x4*)(o + 4)); } }
                        else { const int c = cl - 128;
#pragma unroll
                            for (int j = 0; j < 4; ++j) { vaT[(size_t)(c + j) * MALL + row] = (bf16)f2bf(v0[j]); vaT[(size_t)(c + 4 + j) * MALL + row] = (bf16)f2bf(v1[j]); }
                            if (!sample) { float* o = out + OUT_V + (size_t)row * 128 + c; __builtin_nontemporal_store(v0, (f32x4*)o); __builtin_nontemporal_store(v1, (f32x4*)(o + 4)); } } } } }
        } else if (pn < 5) {
            bf16* dst = pn == 3 ? qlat : ckv; float* ssq = pn == 3 ? ssq_q : ssq_kv;
#pragma unroll
            for (int ai = 0; ai < 2; ++ai) { if (ai == 1 && u.half) break;
#pragma unroll
                for (int m = 0; m < 4; ++m) { const int row = rbase + ai * 128 + m * 16; const float rs = rsq(ssq1[row] * (1.f / D) + EPS); float s = 0.f;
#pragma unroll
                    for (int bj = 0; bj < 2; ++bj) { const f32x4 v0 = WACC(ai, bj, m, 0), v1 = WACC(ai, bj, m, 1);
                        s += (v0.x * v0.x + v0.y * v0.y) + (v0.z * v0.z + v0.w * v0.w) + (v1.x * v1.x + v1.y * v1.y) + (v1.z * v1.z + v1.w * v1.w);
                        *(v4u*)(dst + (size_t)row * 256 + bj * 128 + wc * 32 + 8 * fq) = pack8(v0, v1); }
                    s += __shfl_xor(s, 16); s += __shfl_xor(s, 32);
                    if (fq == 0 && do_ssq) atomicAdd(ssq + row, s); } }
        } else if (pn < 13) {
            const int ct = (pn - 5) * 128 + wc * 32 + 8 * fq;
#pragma unroll
            for (int ai = 0; ai < 2; ++ai) { if (ai == 1 && u.half) break;
#pragma unroll
                for (int m = 0; m < 4; ++m) { const int row = rbase + ai * 128 + m * 16; const float rs = rsq(ssq1[row] * (1.f / D) + EPS);
                    f32x4 r0, r1, b0, b1;
                    { const f32x4 a0 = WACC(ai, 0, m, 0), a1 = WACC(ai, 0, m, 1), c0 = WACC(ai, 1, m, 0), c1 = WACC(ai, 1, m, 1);
#pragma unroll
                      for (int j = 0; j < 4; ++j) {
                          const float ea0 = fexp2(-a0[j]), ea1 = fexp2(-a1[j]), eb0 = fminf(fexp2(-c0[j]), 1e30f), eb1 = fminf(fexp2(-c1[j]), 1e30f);
                          b0[j] = frcp(1.f + eb0); b1[j] = frcp(1.f + eb1); r0[j] = (1.f + eb0) * frcp(1.f + ea0); r1[j] = (1.f + eb1) * frcp(1.f + ea1); } }
                    *(v4u*)(ga + (size_t)row * D + ct) = pack8(r0, r1); *(v4u*)(gb + (size_t)row * D + ct) = pack8(b0, b1); } }
        } else if (wc == 0) {
#pragma unroll
            for (int ai = 0; ai < 2; ++ai) { if (ai == 1 && u.half) break;
#pragma unroll
                for (int m = 0; m < 4; ++m) { const int row = rbase + ai * 128 + m * 16; const float rs = rsq(ssq1[row] * (1.f / D) + EPS); const int t = (row - MP) & 2047; const int pos = (fq & 2) ? (t & 63) : (t >> 6);
                    f32x4 v0 = WACC(ai, 0, m, 0), v1 = WACC(ai, 0, m, 1);
                    if (sample) rope8(v0, v1, ropeB + pos * 8, 16, (fq & 1) ? 1.f : -1.f);
                    *(v4u*)(krope + (size_t)row * 32 + 8 * fq) = pack8(v0, v1);
                    if (!sample) { float* o = out + OUT_KR + (size_t)row * 32 + 8 * fq; __builtin_nontemporal_store(v0, (f32x4*)o); __builtin_nontemporal_store(v1, (f32x4*)(o + 4)); } } }
        }
    }
};
#undef WACC
struct EpiQB { static constexpr bool PERM = true, AFTER_DRAIN = false; bf16* qb; const float* ssq; const float2* ropeB;
    DI void operator()(EPI_ARGS) const {
        asm volatile("" : "+v"(fr), "+v"(fq));
        const int rbase = u.pm * 256 + wr * 64 + fr; const bool sample = u.pm >= 32;
#pragma unroll
        for (int ai = 0; ai < 2; ++ai)
#pragma unroll
            for (int m = 0; m < 4; ++m) { const int row = rbase + ai * 128 + m * 16; const float rs = rsq(ssq[row] * (1.f / 256.f) + EPS);
                const int t = (row - MP) & 2047; const int pos = (fq & 2) ? (t & 63) : (t >> 6);
#pragma unroll
                for (int bj = 0; bj < 2; ++bj) { f32x4 v0 = acc[ai][bj][m][0] * rs, v1 = acc[ai][bj][m][1] * rs;
                    if (u.pn == 2 && sample) rope8(v0, v1, ropeB + pos * 8, 16, (fq & 1) ? 1.f : -1.f);
                    *(v4u*)(qb + (size_t)row * 768 + u.pn * 256 + bj * 128 + wc * 32 + 8 * fq) = pack8(v0, v1); } }
    }
};
struct EpiKN { static constexpr bool PERM = true, AFTER_DRAIN = false; bf16* kn; const float* ssq;
    DI void operator()(EPI_ARGS) const {
        asm volatile("" : "+v"(fr), "+v"(fq));
        const int rbase = u.pm * 256 + wr * 64 + fr; const bool lat = u.pm < 64;
#pragma unroll
        for (int ai = 0; ai < 2; ++ai)
#pragma unroll
            for (int m = 0; m < 4; ++m) { const int row = rbase + ai * 128 + m * 16; const float rs = lat ? rsq(ssq[row] * (1.f / 256.f) + EPS) : 1.0f;
#pragma unroll
                for (int bj = 0; bj < 2; ++bj) *(v4u*)(kn + (size_t)row * 512 + u.pn * 256 + bj * 128 + wc * 32 + 8 * fq) = pack8(acc[ai][bj][m][0] * rs, acc[ai][bj][m][1] * rs); }
    }
};
struct EpiVT { static constexpr bool PERM = true, AFTER_DRAIN = false; bf16* vt; const float* ssq;
    DI void operator()(EPI_ARGS) const {
        asm volatile("" : "+v"(fr), "+v"(fq));
        const int rbase = u.pm * 256 + wr * 64 + fr; const bool lat = u.pn < 64;
        f32x4 rs[2][2];
#pragma unroll
        for (int bj = 0; bj < 2; ++bj)
#pragma unroll
            for (int n = 0; n < 2; ++n) { const int c = u.pn * 256 + bj * 128 + wc * 32 + 8 * fq + 4 * n;
                if (lat) { const f32x4 q = *(const f32x4*)(ssq + c); rs[bj][n] = (f32x4){rsq(q.x * (1.f / 256.f) + EPS), rsq(q.y * (1.f / 256.f) + EPS), rsq(q.z * (1.f / 256.f) + EPS), rsq(q.w * (1.f / 256.f) + EPS)}; }
                else rs[bj][n] = (f32x4){1.f, 1.f, 1.f, 1.f}; }
#pragma unroll
        for (int ai = 0; ai < 2; ++ai)
#pragma unroll
            for (int m = 0; m < 4; ++m) { const int row = rbase + ai * 128 + m * 16;
#pragma unroll
                for (int bj = 0; bj < 2; ++bj) *(v4u*)(vt + (size_t)row * MALL + u.pn * 256 + bj * 128 + wc * 32 + 8 * fq) = pack8(acc[ai][bj][m][0] * rs[bj][0], acc[ai][bj][m][1] * rs[bj][1]); }
    }
};
template <bool SECOND> struct EpiMerge { static constexpr bool PERM = true, AFTER_DRAIN = false; bf16* mm; const bf16* g;
    DI void operator()(EPI_ARGS) const {
        asm volatile("" : "+v"(fr), "+v"(fq));
        const int rbase = u.pm * 256 + wr * 64 + fr;
#pragma unroll
        for (int ai = 0; ai < 2; ++ai)
#pragma unroll
            for (int m = 0; m < 4; ++m) { const int row = rbase + ai * 128 + m * 16;
#pragma unroll
                for (int bj = 0; bj < 2; ++bj) { const size_t o = (size_t)row * D + u.pn * 256 + bj * 128 + wc * 32 + 8 * fq;
                    f32x4 g0, g1; unpack8(*(const v4u*)(g + o), g0, g1); f32x4 v0 = acc[ai][bj][m][0] * g0, v1 = acc[ai][bj][m][1] * g1;
                    if (SECOND) { f32x4 p0, p1; unpack8(*(const v4u*)(mm + o), p0, p1); v0 += p0; v1 += p1; }
                    *(v4u*)(mm + o) = pack8(v0, v1); } }
    }
};

struct EpiMergeK { static constexpr bool PERM = true, AFTER_DRAIN = false, MIDK = true; bf16* mm; const bf16* ga; const bf16* gb;
    DI void mid(f32x4 (&acc)[2][2][4][2], const Unit& u, int wr, int wc, int fr, int fq) const {
        asm volatile("" : "+v"(fr), "+v"(fq));
        const int rbase = u.pm * 256 + wr * 64 + fr;
#pragma unroll
        for (int ai = 0; ai < 2; ++ai)
#pragma unroll
            for (int m = 0; m < 4; ++m) { const int row = rbase + ai * 128 + m * 16;
#pragma unroll
                for (int bj = 0; bj < 2; ++bj) { const size_t o = (size_t)row * D + u.pn * 256 + bj * 128 + wc * 32 + 8 * fq;
                    f32x4 a0, a1; unpack8(__builtin_nontemporal_load((const v4u*)(ga + o)), a0, a1);
                    acc[ai][bj][m][0] = acc[ai][bj][m][0] * a0; acc[ai][bj][m][1] = acc[ai][bj][m][1] * a1; } }
    }
    DI void operator()(EPI_ARGS) const {
        asm volatile("" : "+v"(fr), "+v"(fq));
        const int rbase = u.pm * 256 + wr * 64 + fr;
#pragma unroll
        for (int ai = 0; ai < 2; ++ai)
#pragma unroll
            for (int m = 0; m < 4; ++m) { const int row = rbase + ai * 128 + m * 16;
#pragma unroll
                for (int bj = 0; bj < 2; ++bj) { const size_t o = (size_t)row * D + u.pn * 256 + bj * 128 + wc * 32 + 8 * fq;
                    f32x4 b0, b1; unpack8(__builtin_nontemporal_load((const v4u*)(gb + o)), b0, b1);
                    *(v4u*)(mm + o) = pack8(acc[ai][bj][m][0] * b0, acc[ai][bj][m][1] * b1); } }
    }
};
static_assert(pg8::MidK<EpiMergeK>::value && !pg8::MidK<EpiWin>::value, "mid-K hook trait");
#define MFMA32(a, b, c) __builtin_amdgcn_mfma_f32_32x32x16_bf16((a), (b), (c), 0, 0, 0)
#ifndef ATT_RS
#define ATT_RS 16.0f
#endif
template <int DQ>
DI void attn_unit(LAS unsigned char* lds, int tid, int lane,
                  const bf16* qn, int ldqn, const bf16* qr, int ldqr,
                  const bf16* Kb, int ldk, const bf16* Kr, const bf16* Vt,
                  int s0_tok, int s0_n, int s1_tok, int s1_n, bool band, int qtok,
                  float sink_l2, bool has_sink, bf16* outp, int ldo) {
    constexpr int KS = DQ * 2 + 16, VS = 144, BUF = 64 * KS + 64 * VS, NKS = DQ / 16;
    const int r = lane & 31, hh = lane >> 5;
    const int pr = (r & ~12) | ((r & 4) << 1) | ((r & 8) >> 1);
    bf16x8 qf[NKS];
#pragma unroll
    for (int ks = 0; ks < NKS; ++ks) qf[ks] = ks < 4 ? __builtin_nontemporal_load((const bf16x8*)(qn + (size_t)r * ldqn + 16 * ks + 8 * hh)) : __builtin_nontemporal_load((const bf16x8*)(qr + (size_t)r * ldqr + 16 * (ks - 4) + 8 * hh));
    f32x16 ot[2];
#pragma unroll
    for (int i = 0; i < 16; ++i) { ot[0][i] = 0.f; ot[1][i] = 0.f; }
    float mrun = 0.f; f32x16 lacc;
#pragma unroll
    for (int i = 0; i < 16; ++i) lacc[i] = 0.f;
    const int ntile = s0_n + s1_n;
    const int krow = tid >> 3, kch = tid & 7, rrow = tid >> 2, rch = tid & 3;
    v4u kreg, rreg, vreg;
    auto tile_tok = [&](int t) { return t < s0_n ? s0_tok + 64 * t : s1_tok + 64 * (t - s0_n); };
    auto gload = [&](int t) { const int tok0 = tile_tok(t);
        kreg = *(const v4u*)(Kb + (size_t)(tok0 + krow) * ldk + kch * 8);
        if (DQ == 96) { if (tid < 256) rreg = *(const v4u*)(Kr + (size_t)(tok0 + rrow) * 32 + rch * 8); }
        vreg = *(const v4u*)(Vt + (size_t)krow * MALL + tok0 + kch * 8); };
    auto lstore = [&](int b) { LAS unsigned char* kb_ = lds + b * BUF;
        *(LAS v4u*)(kb_ + krow * KS + kch * 16) = kreg;
        if (DQ == 96) { if (tid < 256) *(LAS v4u*)(kb_ + rrow * KS + 128 + rch * 16) = rreg; }
        *(LAS v4u*)(kb_ + 64 * KS + krow * VS + kch * 16) = vreg; };
    gload(0); lstore(0); __syncthreads();
    for (int t = 0; t < ntile; ++t) {
        const bool more = t + 1 < ntile;
        if (more) gload(t + 1);
        LAS unsigned char* kb_ = lds + (t & 1) * BUF; LAS unsigned char* vb_ = kb_ + 64 * KS;
        f32x16 st[2];
#pragma unroll
        for (int kb = 0; kb < 2; ++kb) {
#pragma unroll
            for (int i = 0; i < 16; ++i) st[kb][i] = 0.f;
#pragma unroll
            for (int ks = 0; ks < NKS; ++ks) { const bf16x8 kf = *(const LAS bf16x8*)(kb_ + (32 * kb + pr) * KS + (16 * ks + 8 * hh) * 2); st[kb] = MFMA32(kf, qf[ks], st[kb]); }
        }
        __builtin_amdgcn_sched_barrier(0);
        if (band && t < s0_n) { const int d0 = tile_tok(t) + 8 * hh - (qtok + r);
#pragma unroll
            for (int kb = 0; kb < 2; ++kb)
#pragma unroll
                for (int i = 0; i < 16; ++i) { const int d = d0 + 32 * kb + 16 * (i >> 3) + (i & 7); if (d > 128 || d < -128) st[kb][i] = -1e30f; } }
        float mx;
        { const f32x16& A = st[0]; const f32x16& B = st[1];
          float m0 = fmaxf(fmaxf(A[0], A[1]), A[2]), m1 = fmaxf(fmaxf(A[3], A[4]), A[5]), m2 = fmaxf(fmaxf(A[6], A[7]), A[8]), m3 = fmaxf(fmaxf(A[9], A[10]), A[11]);
          m0 = fmaxf(fmaxf(m0, A[12]), A[13]); m1 = fmaxf(fmaxf(m1, A[14]), A[15]); m2 = fmaxf(fmaxf(m2, B[0]), B[1]); m3 = fmaxf(fmaxf(m3, B[2]), B[3]);
          m0 = fmaxf(fmaxf(m0, B[4]), B[5]); m1 = fmaxf(fmaxf(m1, B[6]), B[7]); m2 = fmaxf(fmaxf(m2, B[8]), B[9]); m3 = fmaxf(fmaxf(m3, B[10]), B[11]);
          m0 = fmaxf(fmaxf(m0, B[12]), B[13]); m1 = fmaxf(fmaxf(m1, B[14]), B[15]); mx = fmaxf(fmaxf(m0, m1), fmaxf(m2, m3)); }
        mx = fmaxf(mx, __shfl_xor(mx, 32));
        { const bool up = mx > mrun + ATT_RS, dn = (t == 0) && (mx < mrun - ATT_RS);
          if (__builtin_amdgcn_ballot_w64(up || dn) != 0ull) {
              if (t == 0) { mrun = (up || dn) ? mx : mrun; }
              else { const float mnew = up ? mx : mrun, alpha = fexp2(mrun - mnew); mrun = mnew; lacc = lacc * alpha; ot[0] = ot[0] * alpha; ot[1] = ot[1] * alpha; } } }
        if (__builtin_amdgcn_ballot_w64(mrun != 0.f) != 0ull) { st[0] = st[0] - mrun; st[1] = st[1] - mrun; }
#pragma unroll
        for (int kb = 0; kb < 2; ++kb)
#pragma unroll
            for (int i = 0; i < 16; ++i) st[kb][i] = fexp2(st[kb][i]);
        lacc = lacc + (st[0] + st[1]);
#pragma unroll
        for (int kb = 0; kb < 2; ++kb)
#pragma unroll
            for (int s = 0; s < 2; ++s) { v4u pw; pw.x = pk2(st[kb][8 * s], st[kb][8 * s + 1]); pw.y = pk2(st[kb][8 * s + 2], st[kb][8 * s + 3]); pw.z = pk2(st[kb][8 * s + 4], st[kb][8 * s + 5]); pw.w = pk2(st[kb][8 * s + 6], st[kb][8 * s + 7]);
                const bf16x8 pf = __builtin_bit_cast(bf16x8, pw);
#pragma unroll
                for (int db = 0; db < 2; ++db) { const bf16x8 vf = *(const LAS bf16x8*)(vb_ + (32 * db + r) * VS + (32 * kb + 16 * s + 8 * hh) * 2); ot[db] = MFMA32(vf, pf, ot[db]); } }
        __builtin_amdgcn_sched_barrier(0);
        if (more) lstore((t + 1) & 1);
        __syncthreads();
    }
    float lrun = ((lacc[0] + lacc[1]) + (lacc[2] + lacc[3])) + ((lacc[4] + lacc[5]) + (lacc[6] + lacc[7])) + (((lacc[8] + lacc[9]) + (lacc[10] + lacc[11])) + ((lacc[12] + lacc[13]) + (lacc[14] + lacc[15])));
    if (has_sink && hh == 0) lrun += fexp2(sink_l2 - mrun);
    const float inv = 1.0f / (lrun + __shfl_xor(lrun, 32));
#pragma unroll
    for (int db = 0; db < 2; ++db)
#pragma unroll
        for (int a4 = 0; a4 < 4; ++a4) { v2u w; w.x = pk2(ot[db][4 * a4] * inv, ot[db][4 * a4 + 1] * inv); w.y = pk2(ot[db][4 * a4 + 2] * inv, ot[db][4 * a4 + 3] * inv);
            *(v2u*)(outp + (size_t)r * ldo + 32 * db + 8 * a4 + 4 * hh) = w; }
}

DI void attn_phase(const Args& a, LAS unsigned char* lds, int tid, int wave, int lane) {
    unsigned char* ws = a.ws;
    const bf16* qa = (const bf16*)(ws + OFF_QA); const bf16* ka = (const bf16*)(ws + OFF_KA); const bf16* vaT = (const bf16*)(ws + OFF_VAT);
    const bf16* qb = (const bf16*)(ws + OFF_QB); const bf16* kn = (const bf16*)(ws + OFF_KN); const bf16* kr = (const bf16*)(ws + OFF_KROPE); const bf16* vbT = (const bf16*)(ws + OFF_VBT);
    bf16* oa = (bf16*)a.out; bf16* ob = oa + 512;
    const float* sink = a.in[15];
    for (int uu = blockIdx.x; uu < 1024; uu += gridDim.x) {
        const int type = uu >> 8, u0 = uu & 255, vu = (u0 & 7) * 32 + (u0 >> 3);
        if (type == 0) {
            const int b = vu >> 6, h = (vu >> 3) & 7, qblk = vu & 7; const int tok = MP + b * 2048 + qblk * 256 + 32 * wave;
            attn_unit<96>(lds, tid, lane, qb + (size_t)tok * 768 + h * 64, 768, qb + (size_t)tok * 768 + 512 + h * 32, 768, kn + h * 64, 512, kr, vbT + (size_t)(h * 64) * MALL,
                          M + b * 512, 8, MP + b * 2048, 32, false, 0, 0.f, false, ob + (size_t)tok * 1024 + h * 64, 1024);
        } else if (type == 1) {
            const int b = vu >> 6, kh = (vu >> 5) & 1, qblk = vu & 31; const int head = kh * 4 + (wave >> 1); const int tok = MP + b * 2048 + qblk * 64 + 32 * (wave & 1);
            const int lo = qblk - 2 < 0 ? 0 : qblk - 2, hi = qblk + 2 > 31 ? 31 : qblk + 2;
            attn_unit<64>(lds, tid, lane, qa + (size_t)tok * 512 + head * 64, 512, nullptr, 0, ka + kh * 64, 128, nullptr, vaT + (size_t)(kh * 64) * MALL,
                          MP + b * 2048 + lo * 64, hi - lo + 1, M + b * 512, 8, true, tok, sink[head] * LOG2E, true, oa + (size_t)tok * 1024 + head * 64, 1024);
        } else if (type == 2) {
            const int b = vu >> 3, kh = (vu >> 2) & 1, qblk = vu & 3; const int head = kh * 4 + (wave >> 1); const int tok = b * 256 + qblk * 64 + 32 * (wave & 1);
            attn_unit<64>(lds, tid, lane, qa + (size_t)tok * 512 + head * 64, 512, nullptr, 0, ka + kh * 64, 128, nullptr, vaT + (size_t)(kh * 64) * MALL,
                          b * 256, 4, 0, 0, false, 0, sink[head] * LOG2E, true, oa + (size_t)tok * 1024 + head * 64, 1024);
        } else {
            const int b = vu >> 3, h = vu & 7; const int tok = b * 256 + 32 * wave;
            attn_unit<96>(lds, tid, lane, qb + (size_t)tok * 768 + h * 64, 768, qb + (size_t)tok * 768 + 512 + h * 32, 768, kn + h * 64, 512, kr, vbT + (size_t)(h * 64) * MALL,
                          b * 256, 4, 0, 0, false, 0, 0.f, false, ob + (size_t)tok * 1024 + h * 64, 1024);
        }
    }
}

__global__ void __launch_bounds__(512, 2) mk_fwd(Args a) {
    extern __shared__ __attribute__((aligned(16))) unsigned char lds_raw[];
    LAS unsigned char* lds = (LAS unsigned char*)lds_raw;
    cg::grid_group grid = cg::this_grid();
    const int tid = threadIdx.x, lane = tid & 63, wave = __builtin_amdgcn_readfirstlane(tid >> 6);
    const int G = gridDim.x, gw = blockIdx.x * 8 + wave, NGW = G * 8, gtid = blockIdx.x * 512 + tid, NT = G * 512;
    unsigned char* ws = a.ws;
    float* mods = (float*)(ws + OFF_MODS); float* ssq_q = (float*)(ws + OFF_SSQQ); float* ssq_kv = (float*)(ws + OFF_SSQKV);
    const float2* ropeA = (const float2*)(ws + OFF_ROPEA); const float2* ropeB = (const float2*)(ws + OFF_ROPEB);
    bf16* H = (bf16*)(ws + OFF_H); bf16* ACT = (bf16*)(ws + OFF_ACT);
    float* xr = a.out;
    const int lo = a.ph_lo, hi = a.ph_hi;
#if defined(TSK)
    const unsigned long long ts_start = __builtin_amdgcn_s_memrealtime(); unsigned long long ts_k = 0;
#endif
    if (hi > 1000) grid.sync();
    volatile LAS unsigned* xst = (volatile LAS unsigned*)(lds + 131072);
    if (tid < 2) xst[tid] = 0u;
    __syncthreads();
    XcdBarrier xbar = xcd_barrier_post((unsigned*)(ws + OFF_BAR), xst);
#ifndef P6M
#define P6M 7
#endif
#ifndef PH_MASK
#define PH_MASK 0x3fff
#endif
#define IN(k) (((PH_MASK >> (k)) & 1) && lo <= (k) && (k) < hi)
#define INX(k) (IN(k) || (k) == 4 || (k) == 10)
#if defined(TSK)
#define SEAM(k) do { if (IN(k) && INX((k) + 1)) xcd_barrier(xbar); if ((k) == TSK) ts_k = __builtin_amdgcn_s_memrealtime(); } while (0)
#else
#define SEAM(k) do { if (IN(k) && INX((k) + 1)) xcd_barrier(xbar); } while (0)
#endif
    if (IN(0)) { p0_misc(a, gtid, NT); p0_ada(a, lds, tid); }
    SEAM(0);
    float* ssq1 = (float*)(ws + OFF_SSQ1); float* ssq2 = (float*)(ws + OFF_SSQ2); float* shW2 = (float*)(ws + OFF_SHW2); float* shW3 = (float*)(ws + OFF_SHW3);
    if (IN(1)) { norm_mod_phase(a.in[0], a.in[1], a.in[10], mods, 0, H, gw, NGW, lane); p0_weights(a, lds, gw, NGW, wave, lane, 0, P0_EARLY); }
    SEAM(1);
    if (IN(2)) { pg8::Gemm g{H, (const bf16*)(ws + OFF_WGU1), M, NGU, D}; pg8::StaticOrder S; S.init(M, NGU, G, (int)blockIdx.x); EpiSwiglu<false> E{ACT, nullptr, nullptr};
        pg8::gemm_phase<EpiSwiglu<false>, pg8::StaticOrder, PG8_ALIGN, PG8_SP2>(lds, g, S, E);
        { const int nwg = (M / 256) * (NGU / 256), rounds = (nwg + G - 1) / G, first_idle = nwg - (rounds - 1) * G;
          const int nidle = G - first_idle;
          if (nidle <= 0) { shw_phase((const bf16*)(ws + OFF_WIN), NINP, mods, 3, shW2, gw, NGW, lane); p0_weights(a, lds, gw, NGW, wave, lane, P0_EARLY, P0_NIT); }
          else if ((int)blockIdx.x >= first_idle) { const int gw2 = ((int)blockIdx.x - first_idle) * 8 + wave, NGW2 = nidle * 8;
              shw_phase((const bf16*)(ws + OFF_WIN), NINP, mods, 3, shW2, gw2, NGW2, lane);
              p0_weights(a, lds, gw2, NGW2, wave, lane, P0_EARLY, P0_NIT); } } }
    SEAM(2);
    if (IN(3)) { pg8::Gemm g{ACT, (const bf16*)(ws + OFF_WD1), M, D, FF}; pg8::StaticOrder S; S.init(M, D, G, (int)blockIdx.x); EpiResid<true, false, false> E{a.in[0], a.in[1], nullptr, nullptr, nullptr, mods, H, a.in[13], ssq1, 2, 0, 4, 0.5f};
        pg8::gemm_phase<EpiResid<true, false, false>, pg8::StaticOrder, PG8_ALIGN, PG8_SP2>(lds, g, S, E); }
    SEAM(3);
    if (IN(5)) { pg8::Gemm g{H, (const bf16*)(ws + OFF_WIN), M, NINP, D}; pg8::StaticOrder S; S.init(M, NINP, G, (int)blockIdx.x);
        EpiWin E{(bf16*)(ws + OFF_QA), (bf16*)(ws + OFF_KA), (bf16*)(ws + OFF_VAT), (bf16*)(ws + OFF_QLAT), (bf16*)(ws + OFF_CKV), (bf16*)(ws + OFF_GA), (bf16*)(ws + OFF_GB), (bf16*)(ws + OFF_KROPE),
                 ssq_q, ssq_kv, a.out, ropeA, ropeB, true, ssq1, shW2};
        pg8::gemm_phase<EpiWin, pg8::StaticOrder, PG8_ALIGN, PG8_SP2>(lds, g, S, E);
        { const int nwg = (M / 256) * (NINP / 256), rounds = (nwg + G - 1) / G, first_idle = nwg - (rounds - 1) * G, nidle = G - first_idle;
          if (nidle <= 0) { ctx_convert(a, gtid, NT); shw_phase((const bf16*)(ws + OFF_WGU2), NGU, mods, 6, shW3, gw, NGW, lane); }
          else if ((int)blockIdx.x >= first_idle) { ctx_convert(a, ((int)blockIdx.x - first_idle) * 512 + tid, nidle * 512);
              shw_phase((const bf16*)(ws + OFF_WGU2), NGU, mods, 6, shW3, ((int)blockIdx.x - first_idle) * 8 + wave, nidle * 8, lane); } }
#if defined(DUP5)
        xcd_barrier(xbar); E.do_ssq = false; pg8::gemm_phase<EpiWin, pg8::StaticOrder, PG8_ALIGN, PG8_SP2>(lds, g, S, E);
#endif
    }
    SEAM(5);
#if defined(DUP6)
    for (int rep6 = 0; rep6 < 2; ++rep6) { if (rep6) xcd_barrier(xbar);
#endif
    if (IN(6)) {
        int K6 = 256; asm volatile("" : "+s"(K6));
#if P6M & 1
        { pg8::Gemm g{(const bf16*)(ws + OFF_QLAT), (const bf16*)(ws + OFF_WUQ), M, 768, K6}; pg8::StaticOrder S; S.init(M, 768, G, (int)blockIdx.x); EpiQB E{(bf16*)(ws + OFF_QB), ssq_q, ropeB};
          pg8::gemm_phase<EpiQB, pg8::StaticOrder, PG8_ALIGN, PG8_SP2>(lds, g, S, E); }
#endif
#if P6M & 2
        { pg8::Gemm g{(const bf16*)(ws + OFF_CKV), (const bf16*)(ws + OFF_WK), MALL, 512, K6}; pg8::StaticOrder S; S.init(MALL, 512, G, (int)((blockIdx.x + 64) % G)); EpiKN E{(bf16*)(ws + OFF_KN), ssq_kv};
          pg8::gemm_phase<EpiKN, pg8::StaticOrder, PG8_ALIGN, PG8_SP2>(lds, g, S, E); }
#endif
#if P6M & 4
        { pg8::Gemm g{(const bf16*)(ws + OFF_WV), (const bf16*)(ws + OFF_CKV), 512, MALL, K6}; pg8::StaticOrder S; S.init(512, MALL, G, (int)((blockIdx.x + 176) % G)); EpiVT E{(bf16*)(ws + OFF_VBT), ssq_kv};
          pg8::gemm_phase<EpiVT, pg8::StaticOrder, PG8_ALIGN, PG8_SP2>(lds, g, S, E); }
#endif
        { const bf16* ckv = (const bf16*)(ws + OFF_CKV); const float* gn = a.in[17]; float* o = a.out + OUT_CKV;
          for (int row = gw; row < MP; row += NGW) { const float rs = rsq(ssq_kv[row] * (1.f / 256.f) + EPS); const v2u w = *(const v2u*)(ckv + (size_t)row * 256 + 4 * lane); const f32x4 g4 = *(const f32x4*)(gn + 4 * lane);
              __builtin_nontemporal_store((f32x4){bflo(w.x), bfhi(w.x), bflo(w.y), bfhi(w.y)} * rs * g4, (f32x4*)(o + (size_t)row * 256 + 4 * lane)); } }
    }
#if defined(DUP6)
    }
#endif
    SEAM(6);
    if (IN(7)) attn_phase(a, lds, tid, wave, lane);
#if defined(DUP7)
    xcd_barrier(xbar); attn_phase(a, lds, tid, wave, lane);
#endif
    SEAM(7);
    if (IN(8)) { pg8::Gemm g{(const bf16*)a.out, (const bf16*)(ws + OFF_WOA), M, D, D}; pg8::StaticOrder S; S.init(M, D, G, (int)blockIdx.x); EpiMergeK E{(bf16*)(ws + OFF_MM), (const bf16*)(ws + OFF_GA), (const bf16*)(ws + OFF_GB)};
        pg8::gemm_phase<EpiMergeK, pg8::StaticOrder, PG8_ALIGN, PG8_SP2>(lds, g, S, E); }
    SEAM(8);
    if (IN(9)) { pg8::Gemm g{(const bf16*)(ws + OFF_MM), (const bf16*)(ws + OFF_WOUT), M, D, D}; pg8::StaticOrder S; S.init(M, D, G, (int)blockIdx.x); EpiResid<true, true, false> E{nullptr, nullptr, H, a.in[13], nullptr, mods, H, a.in[23], ssq2, 5, 4, 7, 1.0f};
        pg8::gemm_phase<EpiResid<true, true, false>, pg8::StaticOrder, PG8_ALIGN, PG8_SP2>(lds, g, S, E); }
    SEAM(9);
    if (IN(11)) { pg8::Gemm g{H, (const bf16*)(ws + OFF_WGU2), M, NGU, D}; pg8::StaticOrder S; S.init(M, NGU, G, (int)blockIdx.x); EpiSwiglu<true> E{ACT, ssq2, shW3};
        pg8::gemm_phase<EpiSwiglu<true>, pg8::StaticOrder, PG8_ALIGN, PG8_SP2>(lds, g, S, E); }
    SEAM(11);
    if (IN(12)) { pg8::Gemm g{ACT, (const bf16*)(ws + OFF_WD2), M, D, FF}; pg8::StaticOrder S; S.init(M, D, G, (int)blockIdx.x);
        if (G == 256) { EpiFinal E{H, a.in[23], xr, mods, a.in[26], (float*)(ws + OFF_PARTQ), (unsigned*)(ws + OFF_PCNT), 8, 7, 0.5f};
            pg8::gemm_phase<EpiFinal, pg8::StaticOrder, false, PG8_SP2>(lds, g, S, E); }
        else { EpiResid<false, true, true> E{nullptr, nullptr, H, a.in[23], xr, mods, nullptr, nullptr, nullptr, 8, 7, 0, 0.5f};
            pg8::gemm_phase<EpiResid<false, true, true>, pg8::StaticOrder, PG8_ALIGN, PG8_SP2>(lds, g, S, E);
            xcd_barrier(xbar); final_norm_phase(xr, a.in[26], gw, NGW, lane); } }
#if defined(TSK)
    if (blockIdx.x == 0 && tid == 0) { const unsigned long long t_end = __builtin_amdgcn_s_memrealtime(); const unsigned long long want = 4ull * (ts_k - ts_start); while (__builtin_amdgcn_s_memrealtime() - t_end < want) __builtin_amdgcn_s_sleep(8); }
#endif
#ifdef PROBE_SCALE
    grid.sync();
    { const size_t ranges[6][2] = {{0, (size_t)MP * D}, {(size_t)MP * D, (size_t)M * D}, {OUT_K, OUT_V}, {OUT_V, OUT_CKV}, {OUT_CKV, OUT_KR}, {OUT_KR, OUT_KR + 8192 * 32}};
#pragma unroll
      for (int o = 0; o < 6; ++o) if ((PROBE_SCALE >> o) & 1) for (size_t i = ranges[o][0] + gtid; i < ranges[o][1]; i += NT) a.out[i] *= 1.01f; }
#endif
#undef IN
#undef SEAM
}

constexpr int N_PHASES = 14;
extern "C" void kernel_launch(void* const* d_in, const int* in_sizes, int n_in, void* d_out, int out_size, void* d_ws, size_t ws_size, hipStream_t stream) {
    static int grid = 0;
    if (grid == 0) {
        if (n_in != 27 || ws_size < WS_END) { fprintf(stderr, "kernel_launch: unexpected n_in %d / ws %zu\n", n_in, ws_size); grid = -1; return; }
        int dev = 0, cus = 0, per_cu = 0;
        hipGetDevice(&dev); hipDeviceGetAttribute(&cus, hipDeviceAttributeMultiprocessorCount, dev);
        if (hipFuncSetAttribute((const void*)mk_fwd, hipFuncAttributeMaxDynamicSharedMemorySize, LDS_BYTES) != hipSuccess) { fprintf(stderr, "kernel_launch: hipFuncSetAttribute failed\n"); grid = -1; return; }
        if (hipOccupancyMaxActiveBlocksPerMultiprocessor(&per_cu, (const void*)mk_fwd, 512, LDS_BYTES) != hipSuccess || per_cu < 1) { fprintf(stderr, "kernel_launch: occupancy query gave %d\n", per_cu); per_cu = 1; }
        (void)hipGetLastError();
        grid = cus * 1;
        fprintf(stderr, "kernel_launch: cus %d per_cu %d grid %d\n", cus, per_cu, grid);
    }
    if (grid < 0) return;
    (void)hipMemsetAsync(d_ws, 0, ZERO_BYTES, stream);
    Args a{};
    for (int i = 0; i < 27; ++i) a.in[i] = (const float*)d_in[i];
    a.out = (float*)d_out; a.ws = (unsigned char*)d_ws;
#if MK_N_LAUNCHES == 1
    a.ph_lo = 0; a.ph_hi = N_PHASES;
    void* args[] = {&a};
    hipError_t e = hipLaunchCooperativeKernel((const void*)mk_fwd, dim3(grid), dim3(512), args, LDS_BYTES, stream);
    if (e != hipSuccess) fprintf(stderr, "cooperative launch failed: %s (grid %d)\n", hipGetErrorString(e), grid);
#else
    for (int p = 0; p < N_PHASES; ++p) { a.ph_lo = p; a.ph_hi = p + 1; hipLaunchKernelGGL(mk_fwd, dim3(grid), dim3(512), LDS_BYTES, stream, a); }
#endif
}
```

```cpp
#include <hip/hip_runtime.h>
#include <hip/hip_cooperative_groups.h>
#include <cstdio>
#include <cstdint>
namespace cg = cooperative_groups;
namespace pg8 {
#define PG8_LAS __attribute__((address_space(3)))
typedef unsigned short bf16_t;
typedef short bf16x8 __attribute__((ext_vector_type(8)));
typedef float f32x4 __attribute__((ext_vector_type(4)));
typedef unsigned u32x4 __attribute__((ext_vector_type(4)));
constexpr int BM = 256, BK = 64, HALF = 128, HTB = HALF * BK * 2  , STAGE_BYTES = 8 * HTB, NXCD = 8, WGM = 8;

__host__ __device__ __forceinline__ int lds_byte(int r, int c) { const int st = (r >> 4) * 2 + (c >> 5), rr = r & 15, cc = c & 31, ob = rr * 64 + cc * 2; return st * 1024 + (ob ^ (((ob >> 9) & 1) << 5)); }
__host__ __device__ __forceinline__ void stage_rc(int b, int& R, int& C) { const int st = b / 1024, sb = b % 1024, swz = sb ^ (((sb >> 9) & 1) << 5); R = (st >> 1) * 16 + swz / 64; C = (st & 1) * 32 + (swz % 64) / 2; }
__host__ __device__ __forceinline__ int perm32(int rho) { const int n = rho >> 4, i = rho & 15; return 8 * (i >> 2) + 4 * n + (i & 3); }

struct Unit { int pm, pn, half; };
struct Gemm { const bf16_t* A; const bf16_t* Bt; int M, N, K; };

struct StaticOrder {
    int nM, nN, nwg, G, c;
    __host__ __device__ void init(int M, int N, int G_, int c_) { nM = M / BM; nN = N / BM; nwg = nM * nN; G = G_; c = c_; }
    __host__ __device__ bool next(int i, Unit& u) const { const long L = (long)i * G + c; if (L >= nwg) return false; map(L, u); return true; }
    __host__ __device__ void map(long L, Unit& u) const {
        int wgid = (int)L; { const int q = nwg / NXCD, r = nwg % NXCD, xcd = wgid % NXCD, off = wgid / NXCD; wgid = (xcd < r ? xcd * (q + 1) : r * (q + 1) + (xcd - r) * q) + off; }
        const int nig = WGM * nN, gid = wgid / nig, fm = gid * WGM, gsz = (nM - fm) < WGM ? (nM - fm) : WGM;
        u.pm = fm + ((wgid % nig) % gsz); u.pn = (wgid % nig) / gsz; u.half = 0;
    }
    __device__ __forceinline__ void a_ready(const Unit&) const {}
    __device__ __forceinline__ void done(const Unit&) const {}
};
struct TailOrder : StaticOrder {
    __host__ __device__ bool next(int i, Unit& u) const {
        const int full = nwg / G, rem = nwg - full * G;
        if (rem == 0 || 2 * rem > G || (rem & 7) || (G & 15)) return StaticOrder::next(i, u);
        if (i < full) return StaticOrder::next(i, u);
        if (i > full) return false;
        const int x = c & 7, j = c >> 3;
        if ((j >> 1) >= rem / 8) return false;
        map((long)full * G + 8 * (j >> 1) + x, u); u.half = 1 + (j & 1); return true;
    }
};
__device__ __forceinline__ unsigned cvt_pk_bf16(float lo, float hi) { unsigned r; asm volatile("v_cvt_pk_bf16_f32 %0, %1, %2" : "=v"(r) : "v"(lo), "v"(hi)); return r; }
typedef float f32x2 __attribute__((ext_vector_type(2)));
template <class T, class = void> struct MidK { static constexpr bool value = false; };
template <class T> struct MidK<T, decltype((void)T::MIDK)> { static constexpr bool value = T::MIDK; };
template <class Epi, class Sched, bool ALIGN_EPI = false, bool SP2 = false, int A_AUX = 0>
__device__ __forceinline__ void gemm_phase(PG8_LAS unsigned char* lds, const Gemm g, const Sched& S, const Epi& E) {
    const int tid = threadIdx.x, wid = __builtin_amdgcn_readfirstlane(tid >> 6), lane = tid & 63, wr = wid >> 2, wc = wid & 3, fr = lane & 15, fq = lane >> 4;
    const int K = g.K, nt = K / BK;
    unsigned voffA[2], voffB[2];
#pragma unroll
    for (int i = 0; i < 2; ++i) { int R, C; stage_rc(tid * 16 + i * 8192, R, C); const int Rb = Epi::PERM ? ((R & ~31) + perm32(R & 31)) : R;
        voffA[i] = (unsigned)(R * K + C) * 2u; voffB[i] = (unsigned)(Rb * K + C) * 2u; }
    const size_t kstep = (size_t)(BK * 2);
    const size_t hstep = (size_t)HALF * K * 2;
    const size_t tstep = 2 * hstep;
    const unsigned ldsw = (unsigned)wid * 1024u;
    const int aoff = lds_byte(wr * 64 + fr, fq * 8), boff = lds_byte(wc * 32 + fr, fq * 8);
#define PG8_SA(b, h) (((b) * 2 + (h)) * HTB)
#define PG8_SB(b, h) ((4 + (b) * 2 + (h)) * HTB)
#define PG8_STAGE(bufoff, gbase, voff) do { _Pragma("unroll") for (int _i = 0; _i < 2; ++_i) \
        __builtin_amdgcn_global_load_lds((const unsigned*)((const char*)(gbase) + (voff)[_i]), (PG8_LAS unsigned*)(lds + (bufoff) + ldsw + _i * 8192), 16, 0, 0); } while (0)
#define PG8_STAGEA(bufoff, gbase, voff) do { _Pragma("unroll") for (int _i = 0; _i < 2; ++_i) \
        __builtin_amdgcn_global_load_lds((const unsigned*)((const char*)(gbase) + (voff)[_i]), (PG8_LAS unsigned*)(lds + (bufoff) + ldsw + _i * 8192), 16, 0, A_AUX); } while (0)
#define PG8_LDA(dst, b, h) do { _Pragma("unroll") for (int m = 0; m < 4; ++m) _Pragma("unroll") for (int k = 0; k < 2; ++k) dst[m][k] = *(const PG8_LAS bf16x8*)(lds + PG8_SA(b, h) + aoff + m * 2048 + k * 1024); } while (0)
#define PG8_LDB(dst, b, h) do { _Pragma("unroll") for (int n = 0; n < 2; ++n) _Pragma("unroll") for (int k = 0; k < 2; ++k) dst[n][k] = *(const PG8_LAS bf16x8*)(lds + PG8_SB(b, h) + boff + n * 2048 + k * 1024); } while (0)
#define PG8_MMA(ai, bj, At, Bt) do { __builtin_amdgcn_s_setprio(1); _Pragma("unroll") for (int m = 0; m < 4; ++m) _Pragma("unroll") for (int n = 0; n < 2; ++n) _Pragma("unroll") for (int k = 0; k < 2; ++k) \
        acc[ai][bj][m][n] = __builtin_amdgcn_mfma_f32_16x16x32_bf16(Bt[n][k], At[m][k], acc[ai][bj][m][n], 0, 0, 0); __builtin_amdgcn_s_setprio(0); } while (0)
#define PG8_WAIT_V(n) asm volatile("s_waitcnt vmcnt(" #n ")" ::: "memory")
#define PG8_WAIT_L(n) asm volatile("s_waitcnt lgkmcnt(" #n ")" ::: "memory")
#define PG8_BAR __builtin_amdgcn_s_barrier()
#define PG8_SCHED __builtin_amdgcn_sched_barrier(0)
    Unit cur, nxt; int ui = 0;
    if (!S.next(0, cur)) return;
    f32x4 acc[2][2][4][2];
#pragma unroll
    for (int a = 0; a < 2; ++a)
#pragma unroll
        for (int b = 0; b < 2; ++b)
#pragma unroll
            for (int m = 0; m < 4; ++m)
#pragma unroll
                for (int n = 0; n < 2; ++n) acc[a][b][m][n] = (f32x4){0.f, 0.f, 0.f, 0.f};
    bf16x8 At[4][2], B0[2][2], B1[2][2];
    const char* cA = (const char*)g.A + (size_t)cur.pm * tstep + (cur.half == 2 ? hstep : (size_t)0); const char* cB = (const char*)g.Bt + (size_t)cur.pn * tstep;
    S.a_ready(cur);
    if constexpr (SP2) {
        PG8_STAGE(PG8_SB(0, 0), cB, voffB); PG8_STAGE(PG8_SB(0, 1), cB + hstep, voffB); PG8_STAGEA(PG8_SA(0, 0), cA, voffA); PG8_STAGEA(PG8_SA(0, 1), cA + hstep, voffA);
        if (wr == 1) PG8_BAR;
        PG8_WAIT_V(2); PG8_BAR;
        PG8_STAGE(PG8_SB(1, 0), cB + kstep, voffB); PG8_STAGEA(PG8_SA(1, 0), cA + kstep, voffA); PG8_STAGE(PG8_SB(1, 1), cB + hstep + kstep, voffB);
        PG8_WAIT_V(6); PG8_BAR;
    } else {
        PG8_STAGE(PG8_SB(0, 0), cB, voffB); PG8_STAGEA(PG8_SA(0, 0), cA, voffA); PG8_STAGE(PG8_SB(0, 1), cB + hstep, voffB); PG8_STAGEA(PG8_SA(0, 1), cA + hstep, voffA);
        if (wr == 1) PG8_BAR;
        PG8_WAIT_V(4); PG8_BAR;
        PG8_STAGE(PG8_SB(1, 0), cB + kstep, voffB); PG8_STAGEA(PG8_SA(1, 0), cA + kstep, voffA); PG8_STAGE(PG8_SB(1, 1), cB + hstep + kstep, voffB);
        PG8_WAIT_V(6); PG8_BAR;
    }
    for (;;) {
        const bool has_next = S.next(ui + 1, nxt);
        const char* nA = has_next ? (const char*)g.A + (size_t)nxt.pm * tstep + (nxt.half == 2 ? hstep : (size_t)0) : cA; const char* nB = has_next ? (const char*)g.Bt + (size_t)nxt.pn * tstep : cB;
        for (int t = 0; t < nt; t += 2) {
            const bool last = (t == nt - 2);
            const char* a1 = cA + (size_t)(t + 1) * kstep;
            const char* a2 = last ? nA : cA + (size_t)(t + 2) * kstep; const char* b2 = last ? nB : cB + (size_t)(t + 2) * kstep;
            const char* a3 = a2 + kstep; const char* b3 = b2 + kstep;
            if constexpr (MidK<Epi>::value) { if (t == nt / 2) E.mid(acc, cur, wr, wc, fr, fq); }
            if (last && has_next) S.a_ready(nxt);
            if constexpr (SP2) {
            PG8_LDB(B0, 0, 0); PG8_LDB(B1, 0, 1); PG8_SCHED; PG8_LDA(At, 0, 0); PG8_STAGEA(PG8_SA(1, 1), a1 + hstep, voffA);
            PG8_WAIT_V(8); PG8_WAIT_L(0); PG8_BAR; PG8_MMA(0, 0, At, B0); PG8_MMA(0, 1, At, B1); PG8_BAR; PG8_SCHED;
            PG8_LDA(At, 0, 1); PG8_STAGE(PG8_SB(0, 0), b2, voffB); PG8_STAGE(PG8_SB(0, 1), b2 + hstep, voffB); PG8_STAGEA(PG8_SA(0, 0), a2, voffA);
            PG8_WAIT_V(8); PG8_WAIT_L(0); PG8_BAR; PG8_MMA(1, 0, At, B0); PG8_MMA(1, 1, At, B1); PG8_BAR; PG8_SCHED;
            PG8_LDB(B0, 1, 0); PG8_LDB(B1, 1, 1); PG8_SCHED; PG8_LDA(At, 1, 0); PG8_STAGEA(PG8_SA(0, 1), a2 + hstep, voffA);
            PG8_WAIT_V(8); PG8_WAIT_L(0); PG8_BAR; PG8_MMA(0, 0, At, B0); PG8_MMA(0, 1, At, B1); PG8_BAR; PG8_SCHED;
            PG8_LDA(At, 1, 1); PG8_STAGE(PG8_SB(1, 0), b3, voffB); PG8_STAGE(PG8_SB(1, 1), b3 + hstep, voffB); PG8_STAGEA(PG8_SA(1, 0), a3, voffA);
            PG8_WAIT_V(8); PG8_WAIT_L(0); PG8_BAR; PG8_MMA(1, 0, At, B0); PG8_MMA(1, 1, At, B1); PG8_BAR; PG8_SCHED;
            } else {
            PG8_LDB(B0, 0, 0); PG8_SCHED; PG8_LDA(At, 0, 0); PG8_STAGEA(PG8_SA(1, 1), a1 + hstep, voffA);
            PG8_WAIT_L(8); PG8_BAR; PG8_WAIT_L(0); PG8_MMA(0, 0, At, B0); PG8_BAR; PG8_SCHED;
            PG8_LDB(B1, 0, 1); PG8_STAGE(PG8_SB(0, 0), b2, voffB);
            PG8_BAR; PG8_WAIT_L(0); PG8_MMA(0, 1, At, B1); PG8_BAR;
            PG8_LDA(At, 0, 1); PG8_STAGEA(PG8_SA(0, 0), a2, voffA);
            PG8_BAR; PG8_WAIT_L(0); PG8_MMA(1, 0, At, B0); PG8_BAR; PG8_SCHED;
            PG8_STAGE(PG8_SB(0, 1), b2 + hstep, voffB);
            PG8_WAIT_V(6); PG8_BAR; PG8_MMA(1, 1, At, B1); PG8_BAR;
            PG8_LDB(B0, 1, 0); PG8_SCHED; PG8_LDA(At, 1, 0); PG8_STAGEA(PG8_SA(0, 1), a2 + hstep, voffA);
            PG8_WAIT_L(8); PG8_BAR; PG8_WAIT_L(0); PG8_MMA(0, 0, At, B0); PG8_BAR; PG8_SCHED;
            PG8_LDB(B1, 1, 1); PG8_STAGE(PG8_SB(1, 0), b3, voffB);
            PG8_BAR; PG8_WAIT_L(0); PG8_MMA(0, 1, At, B1); PG8_BAR;
            PG8_LDA(At, 1, 1); PG8_STAGEA(PG8_SA(1, 0), a3, voffA);
            PG8_BAR; PG8_WAIT_L(0); PG8_MMA(1, 0, At, B0); PG8_BAR; PG8_SCHED;
            PG8_STAGE(PG8_SB(1, 1), b3 + hstep, voffB);
            PG8_WAIT_V(6); PG8_BAR; PG8_MMA(1, 1, At, B1); PG8_BAR;
            }
        }
        if constexpr (ALIGN_EPI) { if (wr == 0) PG8_BAR; }
        if constexpr (!Epi::AFTER_DRAIN) { E(acc, cur, wr, wc, fr, fq); S.done(cur); }
        if (!has_next) break;
#pragma unroll
        for (int a = 0; a < 2; ++a)
#pragma unroll
            for (int b = 0; b < 2; ++b)
#pragma unroll
                for (int m = 0; m < 4; ++m)
#pragma unroll
                    for (int n = 0; n < 2; ++n) acc[a][b][m][n] = (f32x4){0.f, 0.f, 0.f, 0.f};
        cur = nxt; cA = nA; cB = nB; ++ui;
        if constexpr (ALIGN_EPI) { if (wr == 1) PG8_BAR; }
    }
    PG8_WAIT_V(0);
    if constexpr (!ALIGN_EPI) { if (wr == 0) PG8_BAR; }
    PG8_BAR;
    if constexpr (Epi::AFTER_DRAIN) { E.fused(acc, cur, wr, wc, fr, fq, lds, wid, lane); S.done(cur); }
#undef PG8_SA
#undef PG8_SB
#undef PG8_STAGE
#undef PG8_STAGEA
#undef PG8_LDA
#undef PG8_LDB
#undef PG8_MMA
#undef PG8_WAIT_V
#undef PG8_WAIT_L
#undef PG8_BAR
#undef PG8_SCHED
}
}
#ifndef PG8_SP2
#define PG8_SP2 true
#endif
#ifndef PG8_ALIGN
#define PG8_ALIGN true
#endif
#ifndef MK_N_LAUNCHES
#define MK_N_LAUNCHES 1
#endif
#define DI __device__ __forceinline__
#define LAS __attribute__((address_space(3)))
typedef unsigned short bf16;
typedef unsigned v4u __attribute__((ext_vector_type(4)));
typedef unsigned v2u __attribute__((ext_vector_type(2)));
typedef float f32x4 __attribute__((ext_vector_type(4)));
typedef float f32x16 __attribute__((ext_vector_type(16)));
typedef short bf16x8 __attribute__((ext_vector_type(8)));
using pg8::Unit;

constexpr int D = 1024, MP = 8192, M = 16384, MCTX = 2048, MALL = 18432;
constexpr int FF = 2816, NGU = 5632, NINP = 3584, NMODS = 9216;
constexpr float EPS = 1e-6f, LOG2E = 1.4426950408889634f;
constexpr float A_QS = 0.125f * LOG2E;
constexpr float B_QS = 0.10206207261596575f * LOG2E;
constexpr size_t OUT_K = (size_t)M * D, OUT_V = OUT_K + 8192 * 128, OUT_CKV = OUT_V + 8192 * 128, OUT_KR = OUT_CKV + 8192 * 256;
constexpr size_t MiB = 1u << 20;
constexpr size_t OFF_MODS = 0, OFF_SSQQ = 196608, OFF_SSQKV = 262144, OFF_BAR = 327680, OFF_SSQ1 = 344064, OFF_SSQ2 = 409600, OFF_PCNT = 475136, ZERO_BYTES = 491520, OFF_ROPEA = 524288, OFF_ROPEB = 532480, OFF_SHW2 = 589824, OFF_SHW3 = 663552;
constexpr size_t OFF_WGU1 = 1 * MiB, OFF_WGU2 = 12 * MiB, OFF_WD1 = 23 * MiB, OFF_WD2 = OFF_WD1 + 5767168, OFF_WIN = 34 * MiB, OFF_WOUT = 41 * MiB,
                 OFF_WOA = 43 * MiB, OFF_WOB = 44 * MiB, OFF_WUQ = 45 * MiB, OFF_WK = OFF_WUQ + 393216, OFF_WV = OFF_WK + 262144;
constexpr size_t OFF_H = 46 * MiB, OFF_OA = OFF_H, OFF_OB = OFF_H + 16 * MiB;
constexpr size_t OFF_ACT = 78 * MiB;
constexpr size_t OFF_QA = OFF_ACT, OFF_KA = OFF_QA + 16 * MiB, OFF_VAT = OFF_KA + (size_t)MALL * 128 * 2, OFF_QLAT = OFF_VAT + (size_t)MALL * 128 * 2,
                 OFF_CKV = OFF_QLAT + 8 * MiB, OFF_KROPE = OFF_CKV + 9 * MiB, OFF_QB = OFF_KROPE + (size_t)MALL * 32 * 2 + 131072, OFF_KN = OFF_QB + 24 * MiB;
constexpr size_t OFF_MM = OFF_ACT;
constexpr size_t OFF_GA = 166 * MiB, OFF_GB = 198 * MiB, OFF_VBT = 230 * MiB, OFF_PART1 = 248 * MiB, OFF_PART2 = 249 * MiB, OFF_PARTQ = 250 * MiB, OFF_PARTKV = 250 * MiB + 262144, WS_END = 251 * MiB;
static_assert(OFF_QLAT + 8 * MiB >= OFF_MM + 32 * MiB, "m overlay");
static_assert(OFF_KN + 18 * MiB <= OFF_GA && OFF_WV + 262144 <= OFF_H, "ws map");
constexpr int LDS_BYTES = 147456;

DI unsigned f2bf(float f) { unsigned u = __builtin_bit_cast(unsigned, f); return (u + 0x7fffu + ((u >> 16) & 1u)) >> 16; }
typedef __bf16 hbf16x2 __attribute__((ext_vector_type(2)));
typedef float hf32x2 __attribute__((ext_vector_type(2)));
DI unsigned pk2(float lo, float hi) { const hf32x2 f = {lo, hi}; return __builtin_bit_cast(unsigned, __builtin_convertvector(f, hbf16x2)); }
DI float bflo(unsigned w) { return __builtin_bit_cast(float, w << 16); }
DI float bfhi(unsigned w) { return __builtin_bit_cast(float, w & 0xffff0000u); }
DI float fexp2(float x) { return __builtin_amdgcn_exp2f(x); }
DI float frcp(float x) { return __builtin_amdgcn_rcpf(x); }
DI float rsq(float x) { return __builtin_amdgcn_rsqf(x); }
DI float sigm(float x) { return frcp(1.f + fexp2(-x * LOG2E)); }
#define LDS_WAIT() asm volatile("s_waitcnt lgkmcnt(0)" ::: "memory")
DI float wave_sum(float v) {
#pragma unroll
    for (int o = 1; o < 64; o <<= 1) v += __shfl_xor(v, o);
    return v;
}
DI float sum16(const float* p) { const f32x4 a = *(const f32x4*)p, b = *(const f32x4*)(p + 4), c = *(const f32x4*)(p + 8), d = *(const f32x4*)(p + 12); const f32x4 t = (a + b) + (c + d); return (t.x + t.y) + (t.z + t.w); }
DI float sum4(const float* p) { const f32x4 a = *(const f32x4*)p; return (a.x + a.y) + (a.z + a.w); }
DI int mod_index(int row) { return row < MP ? 0 : 1 + ((row - MP) >> 11); }

#define XB_TMO      128
#define XB_XCNT(j)  (256  + 64 * (j))
#define XB_XSUB(j)  (1280 + 64 * (j))
#define XB_XGEN(j)  (2304 + 64 * (j))
#define XB_TOP      3328
#define XB_TOPGEN   3392
#define XCD_BAR_WORDS 3456
#define XB_SPIN_CAP (1u << 18)

__device__ __forceinline__ unsigned xb_ld(unsigned* p)              { return __hip_atomic_load(p, __ATOMIC_RELAXED, __HIP_MEMORY_SCOPE_AGENT); }
__device__ __forceinline__ unsigned xb_add(unsigned* p, unsigned v) { return __hip_atomic_fetch_add(p, v, __ATOMIC_RELAXED, __HIP_MEMORY_SCOPE_AGENT); }
__device__ __forceinline__ unsigned xb_xcc_id() { return (unsigned)__builtin_amdgcn_s_getreg((3 << 11) | 20) & 0xFu; }
#define XB_SPIN(cond, bar) do { unsigned _sp = 0; while (cond) { __builtin_amdgcn_s_sleep(1); \
    if ((++_sp & 255u) == 0u) { if (xb_ld(&(bar)[XB_TMO])) break; if (_sp > XB_SPIN_CAP) { atomicAdd(&(bar)[XB_TMO], 1u); break; } } } } while (0)

struct XcdBarrier {
    unsigned* bar; unsigned x;
    volatile LAS unsigned* st;
};

__device__ __forceinline__ XcdBarrier xcd_barrier_post(unsigned* bar, volatile LAS unsigned* st) {
    XcdBarrier b; b.bar = bar; b.x = xb_xcc_id(); b.st = st;
    if (threadIdx.x == 0) (void)xb_add(&bar[XB_XCNT(b.x)], 1u);
    return b;
}
__device__ __forceinline__ void xcd_barrier_complete(unsigned* bar, unsigned x, unsigned& nloc, unsigned& nx) {
    const unsigned G = gridDim.x * gridDim.y * gridDim.z;
    unsigned sum, cnt, mine, sp = 0u;
    for (;;) {
        sum = 0u; cnt = 0u; mine = 0u;
#pragma unroll
        for (unsigned j = 0; j < 16; ++j) { const unsigned c = xb_ld(&bar[XB_XCNT(j)]); sum += c; cnt += (c > 0u) ? 1u : 0u; mine = (j == x) ? c : mine; }
        if (sum == G) break;
        __builtin_amdgcn_s_sleep(1);
        if ((++sp & 255u) == 0u) { if (xb_ld(&bar[XB_TMO])) break; if (sp > XB_SPIN_CAP) { atomicAdd(&bar[XB_TMO], 1u); break; } }
    }
    nloc = mine > 0u ? mine : 1u; nx = cnt > 0u ? cnt : 1u;
}

__device__ __forceinline__ void xcd_barrier(const XcdBarrier& b) {
    asm volatile("s_waitcnt vmcnt(0)" ::: "memory");
    __syncthreads();
    if (threadIdx.x == 0) {
        unsigned* bar = b.bar;
        __builtin_amdgcn_s_waitcnt(0);
        unsigned nloc = b.st[0], nx = b.st[1];
        if (nloc == 0u) { xcd_barrier_complete(bar, b.x, nloc, nx); b.st[0] = nloc; b.st[1] = nx; }
        const unsigned old = xb_add(&bar[XB_XSUB(b.x)], 1u);
        const unsigned gen = old / nloc;
        if (old + 1u == (gen + 1u) * nloc) {
            __builtin_amdgcn_fence(__ATOMIC_RELEASE, "agent");
            asm volatile("s_waitcnt vmcnt(0)" ::: "memory");
            const unsigned og = xb_add(&bar[XB_TOP], 1u);
            const unsigned tg = og / nx;
            if (og + 1u == (tg + 1u) * nx) xb_add(&bar[XB_TOPGEN], 1u);
            else XB_SPIN(xb_ld(&bar[XB_TOPGEN]) == tg, bar);
            __builtin_amdgcn_fence(__ATOMIC_ACQUIRE, "agent");
            xb_add(&bar[XB_XGEN(b.x)], 1u);
            asm volatile("s_waitcnt vmcnt(0)" ::: "memory");
        } else {
            XB_SPIN(xb_ld(&bar[XB_XGEN(b.x)]) == gen, bar);
            __builtin_amdgcn_fence(__ATOMIC_ACQUIRE, "agent");
            asm volatile("s_waitcnt vmcnt(0)" ::: "memory");
        }
    }
    __syncthreads();
}


DI void transpose_item(const float* W, int N, bf16* WT, int K, int k0, int src_n0, int dst_r0, const float* kscale, float sscale, LAS float* scr, int lane, int dk = 0, bool ntst = false) {
    if (src_n0 >= 0) {
        float v[32];
#pragma unroll
        for (int i = 0; i < 32; ++i) v[i] = __builtin_nontemporal_load(W + (size_t)(k0 + 2 * i + (lane >> 5)) * N + src_n0 + (lane & 31));
        if (kscale) {
#pragma unroll
            for (int i = 0; i < 32; ++i) v[i] *= kscale[k0 + 2 * i + (lane >> 5)]; }
#pragma unroll
        for (int i = 0; i < 32; ++i) scr[(2 * i + (lane >> 5)) * 33 + (lane & 31)] = v[i] * sscale;
    } else {
#pragma unroll 8
        for (int i = 0; i < 32; ++i) { const int kk = 2 * i + (lane >> 5); scr[kk * 33 + (lane & 31)] = 0.f; }
    }
    LDS_WAIT(); asm volatile("" ::: "memory");
    const int c = lane & 7;
#pragma unroll
    for (int j = 0; j < 4; ++j) { const int n = (lane >> 3) + 8 * j; const LAS float* s = scr + (8 * c) * 33 + n;
        v4u o; o.x = pk2(s[0 * 33], s[1 * 33]); o.y = pk2(s[2 * 33], s[3 * 33]); o.z = pk2(s[4 * 33], s[5 * 33]); o.w = pk2(s[6 * 33], s[7 * 33]);
        v4u* dp = (v4u*)(WT + (size_t)(dst_r0 + n) * K + k0 + dk + 8 * c);
        if (ntst) __builtin_nontemporal_store(o, dp); else *dp = o; }
    LDS_WAIT(); asm volatile("" ::: "memory");
}

struct Args { const float* in[27]; float* out; unsigned char* ws; int ph_lo, ph_hi; };

constexpr int I_GU = 16 * 176, I_D = 44 * 32, I_IN = 16 * 112, I_OUT = 16 * 32, I_O = 8 * 32, I_UQ = 4 * 24, I_K = 4 * 16;
constexpr int P0_EARLY = I_GU + I_IN, P0_NIT = P0_EARLY + I_GU + 2 * I_D + I_OUT + 2 * I_O + I_UQ + 2 * I_K;
DI void p0_weights(const Args& a, LAS unsigned char* lds, int gw, int NGW, int wave, int lane, int it_lo, int it_hi) {
    LAS float* scr = (LAS float*)(lds + wave * 16384);
    unsigned char* ws = a.ws;
    for (int it = it_lo + gw; it < it_hi; it += NGW) {
        int r = it;
        if (r < I_GU) { const int w = 0; const int kb = r / 176, nb = r % 176, R0 = 32 * nb;
            const int pn = R0 >> 8, half = (R0 >> 7) & 1, j = R0 & 127;
            transpose_item(a.in[w ? 24 : 11], NGU, (bf16*)(ws + (w ? OFF_WGU2 : OFF_WGU1)), 1024, 64 * kb, half * FF + 128 * pn + j, R0, nullptr, half ? (1.0f / LOG2E) : LOG2E, scr, lane); continue; }
        r -= I_GU;
        if (r < I_IN) { const int kb = r / 112, nb = r % 112, R0 = 32 * nb;
            const int gq = R0 - 1280; const int src = R0 < 1280 ? R0 : (R0 < 3328 ? (((gq >> 7) & 1) ? 2336 : 1312) + 128 * (gq >> 8) + (gq & 127) : (R0 == 3328 ? 1280 : -1));
            transpose_item(a.in[14], 3360, (bf16*)(ws + OFF_WIN), 1024, 64 * kb, src, R0, nullptr, (R0 >= 1280 && R0 < 3328) ? LOG2E : 1.f, scr, lane); continue; }
        r -= I_IN;
        if (r < I_GU) { const int w = 1; const int kb = r / 176, nb = r % 176, R0 = 32 * nb;
            const int pn = R0 >> 8, half = (R0 >> 7) & 1, j = R0 & 127;
            transpose_item(a.in[w ? 24 : 11], NGU, (bf16*)(ws + (w ? OFF_WGU2 : OFF_WGU1)), 1024, 64 * kb, half * FF + 128 * pn + j, R0, nullptr, half ? (1.0f / LOG2E) : LOG2E, scr, lane, 0, true); continue; }
        r -= I_GU;
        if (r < I_D) { const int kb = r / 32, nb = r % 32;
            transpose_item(a.in[12], 1024, (bf16*)(ws + OFF_WD1), FF, 64 * kb, 32 * nb, 32 * nb, nullptr, 1.f, scr, lane); continue; }
        r -= I_D;
        if (r < I_D) { const int kb = r / 32, nb = r % 32;
            transpose_item(a.in[25], 1024, (bf16*)(ws + OFF_WD2), FF, 64 * kb, 32 * nb, 32 * nb, nullptr, 1.f, scr, lane, 0, true); continue; }
        r -= I_D;
        if (r < I_OUT) { const int kb = r / 32, nb = r % 32; transpose_item(a.in[22], 1024, (bf16*)(ws + OFF_WOUT), 1024, 64 * kb, 32 * nb, 32 * nb, nullptr, 1.f, scr, lane, 0, true); continue; }
        r -= I_OUT;
        if (r < 2 * I_O) { const int w = r >= I_O; r -= w * I_O; const int kb = r / 32, nb = r % 32;
            transpose_item(a.in[w ? 21 : 20], 1024, (bf16*)(ws + OFF_WOA), 1024, 64 * kb, 32 * nb, 32 * nb, nullptr, 1.f, scr, lane, w ? 512 : 0, true); continue; }
        r -= 2 * I_O;
        if (r < I_UQ) { const int kb = r / 24, nb = r % 24, R0 = 32 * nb;
            const int src = R0 < 512 ? (R0 >> 6) * 96 + (R0 & 63) : ((R0 - 512) >> 5) * 96 + 64;
            transpose_item(a.in[18], 768, (bf16*)(ws + OFF_WUQ), 256, 64 * kb, src, R0, a.in[16], B_QS, scr, lane, 0, true); continue; }
        r -= I_UQ;
        { const int w = r >= I_K; r -= w * I_K; const int kb = r / 16, nb = r % 16, R0 = 32 * nb;
            const int src = (R0 >> 6) * 128 + (R0 & 63) + (w ? 64 : 0);
            transpose_item(a.in[19], 1024, (bf16*)(ws + (w ? OFF_WV : OFF_WK)), 256, 64 * kb, src, R0, a.in[17], 1.f, scr, lane, 0, true); }
    }
}
DI void p0_ada(const Args& a, LAS unsigned char* lds, int tid) {
    LAS float* sc = (LAS float*)lds;
    LAS float* red = (LAS float*)(lds + 4096);
    float* mods = (float*)(a.ws + OFF_MODS);
    const float* adaw = a.in[8];
    for (int it = blockIdx.x; it < 256; it += gridDim.x) {
        const int cgp = it & 31, ks = it >> 5;
        __syncthreads();
        for (int i = tid; i < 640; i += 512) { const int v = i >> 7, k = ks * 128 + (i & 127); const float c = v == 0 ? a.in[7][k] : a.in[6][(v - 1) * 1024 + k]; sc[i] = c * sigm(c); }
        __syncthreads();
        const int colq = tid % 72, kl = tid / 72;
        if (kl < 7) {
            f32x4 acc[5];
#pragma unroll
            for (int v = 0; v < 5; ++v) acc[v] = (f32x4){0.f, 0.f, 0.f, 0.f};
            f32x4 w[19];
#pragma unroll
            for (int q = 0; q < 19; ++q) { const int k = kl + 7 * q; w[q] = k < 128 ? __builtin_nontemporal_load((const f32x4*)(adaw + (size_t)(ks * 128 + k) * NMODS + cgp * 288 + colq * 4)) : (f32x4){0.f, 0.f, 0.f, 0.f}; }
#pragma unroll
            for (int q = 0; q < 19; ++q) { const int k = kl + 7 * q; if (k < 128) {
#pragma unroll
                for (int v = 0; v < 5; ++v) acc[v] += w[q] * sc[v * 128 + k]; } }
#pragma unroll
            for (int v = 0; v < 5; ++v) *(LAS f32x4*)(red + (kl * 5 + v) * 288 + colq * 4) = acc[v];
        }
        __syncthreads();
        for (int i = tid; i < 1440; i += 512) { const int v = i / 288, cc = i % 288; float s = 0.f;
#pragma unroll
            for (int q = 0; q < 7; ++q) s += red[(q * 5 + v) * 288 + cc];
            const int col = cgp * 288 + cc; if (ks == 0) s += a.in[9][col];
            atomicAdd(mods + v * NMODS + col, s); }
    }
    __syncthreads();
}
DI void ctx_convert(const Args& a, int gtid, int NT) {
    unsigned char* ws = a.ws;
    bf16* ka = (bf16*)(ws + OFF_KA) + (size_t)M * 128; bf16* vaT = (bf16*)(ws + OFF_VAT); bf16* ckv = (bf16*)(ws + OFF_CKV) + (size_t)M * 256; bf16* kr = (bf16*)(ws + OFF_KROPE) + (size_t)M * 32;
    for (int i = gtid; i < MCTX * 128; i += NT) ka[i] = (bf16)f2bf(a.in[2][i]);
    for (int i = gtid; i < MCTX * 128; i += NT) { const int f = i >> 11, tk = i & 2047; vaT[(size_t)f * MALL + M + tk] = (bf16)f2bf(a.in[3][tk * 128 + f]); }
    for (int i = gtid; i < MCTX * 256; i += NT) ckv[i] = (bf16)f2bf(a.in[4][i] * frcp(a.in[17][i & 255]));
    for (int i = gtid; i < MCTX * 32; i += NT) kr[i] = (bf16)f2bf(a.in[5][i]);
}
DI void p0_misc(const Args& a, int gtid, int NT) {
    unsigned char* ws = a.ws;
    float2* ra = (float2*)(ws + OFF_ROPEA); float2* rb = (float2*)(ws + OFF_ROPEB);
    for (int i = gtid; i < 1024; i += NT) { const int pos = i >> 4, fi = i & 15; const float inv = 1.0f / powf(10000.f, (float)(2 * fi) / 32.f); const float ang = (float)pos * inv; ra[i] = make_float2(cosf(ang), sinf(ang)); }
    for (int i = gtid; i < 512; i += NT) { const int pos = i >> 3, fi = i & 7; const float inv = 1.0f / powf(10000.f, (float)(2 * fi) / 16.f); const float ang = (float)pos * inv; rb[i] = make_float2(cosf(ang), sinf(ang)); }
}

DI void norm_mod_phase(const float* xa, const float* xb, const float* gain, const float* mods, int s, bf16* h, int gw, int NGW, int lane) {
    for (int row = gw; row < M; row += NGW) {
        const float* xr = row < MP ? xa + (size_t)row * D : xb + (size_t)(row - MP) * D;
        f32x4 v[4]; float ss = 0.f;
#pragma unroll
        for (int j = 0; j < 4; ++j) { v[j] = *(const f32x4*)(xr + 4 * (64 * j + lane)); ss += (v[j].x * v[j].x + v[j].y * v[j].y) + (v[j].z * v[j].z + v[j].w * v[j].w); }
        const float rstd = rsq(wave_sum(ss) * (1.f / D) + EPS);
        const float* sh = mods + mod_index(row) * NMODS + (3 * s) * D; const float* sc = sh + D;
#pragma unroll
        for (int j = 0; j < 4; ++j) { const int c = 4 * (64 * j + lane); const f32x4 g = *(const f32x4*)(gain + c), s4 = *(const f32x4*)(sh + c), c4 = *(const f32x4*)(sc + c);
            const f32x4 o = (v[j] * rstd * g) * (c4 + 1.0f) + s4; v2u w; w.x = pk2(o.x, o.y); w.y = pk2(o.z, o.w); *(v2u*)(h + (size_t)row * D + c) = w; }
    }
}
DI void shw_phase(const bf16* WT, int nrows, const float* mods, int shslot, float* shW, int gw, int NGW, int lane) {
    for (int n = gw; n < nrows; n += NGW) {
        const v4u w0 = *(const v4u*)(WT + (size_t)n * D + 16 * lane), w1 = *(const v4u*)(WT + (size_t)n * D + 16 * lane + 8);
        f32x4 a0, a1, a2, a3; { f32x4 t0, t1; a0 = (f32x4){bflo(w0.x), bfhi(w0.x), bflo(w0.y), bfhi(w0.y)}; a1 = (f32x4){bflo(w0.z), bfhi(w0.z), bflo(w0.w), bfhi(w0.w)};
            a2 = (f32x4){bflo(w1.x), bfhi(w1.x), bflo(w1.y), bfhi(w1.y)}; a3 = (f32x4){bflo(w1.z), bfhi(w1.z), bflo(w1.w), bfhi(w1.w)}; }
#pragma unroll
        for (int b = 0; b < 5; ++b) { const float* sh = mods + b * NMODS + shslot * D + 16 * lane;
            const f32x4 p = a0 * *(const f32x4*)(sh) + a1 * *(const f32x4*)(sh + 4) + a2 * *(const f32x4*)(sh + 8) + a3 * *(const f32x4*)(sh + 12);
            const float sum = wave_sum((p.x + p.y) + (p.z + p.w)); if (lane == 0) shW[b * nrows + n] = sum; }
    }
}
DI void final_norm_phase(float* x, const float* gain, int gw, int NGW, int lane) {
    for (int row = gw; row < M; row += NGW) {
        float* xr = x + (size_t)row * D; f32x4 v[4]; float ss = 0.f;
#pragma unroll
        for (int j = 0; j < 4; ++j) { v[j] = *(const f32x4*)(xr + 4 * (64 * j + lane)); ss += (v[j].x * v[j].x + v[j].y * v[j].y) + (v[j].z * v[j].z + v[j].w * v[j].w); }
        const float rstd = rsq(wave_sum(ss) * (1.f / D) + EPS);
#pragma unroll
        for (int j = 0; j < 4; ++j) { const int c = 4 * (64 * j + lane); *(f32x4*)(xr + c) = v[j] * rstd * *(const f32x4*)(gain + c); }
    }
}
#define EPI_ARGS const f32x4 (&acc)[2][2][4][2], const Unit& u, int wr, int wc, int fr, int fq
DI v4u pack8(const f32x4& a, const f32x4& b) { v4u w; w.x = pk2(a.x, a.y); w.y = pk2(a.z, a.w); w.z = pk2(b.x, b.y); w.w = pk2(b.z, b.w); return w; }
DI void unpack8(const v4u& w, f32x4& a, f32x4& b) { a = (f32x4){bflo(w.x), bfhi(w.x), bflo(w.y), bfhi(w.y)}; b = (f32x4){bflo(w.z), bfhi(w.z), bflo(w.w), bfhi(w.w)}; }
DI f32x4 shx4(const f32x4& v, int m) { return (f32x4){__shfl_xor(v.x, m), __shfl_xor(v.y, m), __shfl_xor(v.z, m), __shfl_xor(v.w, m)}; }
DI void rope8(f32x4& v0, f32x4& v1, const float2* cs, int xm, float sgn) {
    const f32x4 p0 = shx4(v0, xm), p1 = shx4(v1, xm);
    const f32x4 t0 = *(const f32x4*)(cs), t1 = *(const f32x4*)(cs + 2), t2 = *(const f32x4*)(cs + 4), t3 = *(const f32x4*)(cs + 6);
    v0 = (f32x4){v0.x * t0.x + sgn * p0.x * t0.y, v0.y * t0.z + sgn * p0.y * t0.w, v0.z * t1.x + sgn * p0.z * t1.y, v0.w * t1.z + sgn * p0.w * t1.w};
    v1 = (f32x4){v1.x * t2.x + sgn * p1.x * t2.y, v1.y * t2.z + sgn * p1.y * t2.w, v1.z * t3.x + sgn * p1.z * t3.y, v1.w * t3.z + sgn * p1.w * t3.w};
}

template <bool NORM> struct EpiSwiglu { static constexpr bool PERM = true, AFTER_DRAIN = false; bf16* O; const float* ssq; const float* shW;
    DI void operator()(EPI_ARGS) const {
        asm volatile("" : "+v"(fr), "+v"(fq));
        const int row0 = u.pm * 256 + (u.half == 2 ? 128 : 0) + wr * 64 + fr, col0 = u.pn * 128 + wc * 32 + 8 * fq;
        f32x4 sw[2][2];
        if (NORM) { const float* sp = shW + mod_index(u.pm * 256) * NGU + u.pn * 256 + wc * 32 + 8 * fq;
#pragma unroll
            for (int bj = 0; bj < 2; ++bj)
#pragma unroll
                for (int n = 0; n < 2; ++n) sw[bj][n] = *(const f32x4*)(sp + bj * 128 + 4 * n); }
#pragma unroll
        for (int ai = 0; ai < 2; ++ai) { if (ai == 1 && u.half) break;
#pragma unroll
            for (int m = 0; m < 4; ++m) { f32x4 o[2]; const int row = row0 + ai * 128 + m * 16;
                float rs = 1.f; if (NORM) rs = rsq(ssq[row] * (1.f / D) + EPS);
#pragma unroll
                for (int n = 0; n < 2; ++n) { f32x4 g = acc[ai][0][m][n], uu = acc[ai][1][m][n];
                    if (NORM) { g = g * rs + sw[0][n]; uu = uu * rs + sw[1][n]; }
#pragma unroll
                    for (int j = 0; j < 4; ++j) o[n][j] = g[j] * frcp(1.f + fexp2(-g[j])) * uu[j]; }
                *(v4u*)(O + (size_t)row * FF + col0) = pack8(o[0], o[1]); } }
    }
};
DI f32x4 gsafe(const f32x4& g) { f32x4 r; for (int j = 0; j < 4; ++j) r[j] = fabsf(g[j]) < 1e-20f ? 1e-20f : g[j]; return r; }
template <bool NEXT, bool RECON, bool WRITE_X> struct EpiResid { static constexpr bool PERM = false, AFTER_DRAIN = false;
    const float* inA; const float* inB; const bf16* hin; const float* gain_prev; float* out; const float* mods; bf16* hn; const float* gain; float* ssq; int gslot; int scprev; int scslot; float coef;
    DI void operator()(EPI_ARGS) const {
        asm volatile("" : "+v"(fr), "+v"(fq));
        const int row0 = u.pm * 256 + wr * 64 + fr, col0 = u.pn * 256 + wc * 32 + 4 * fq;
        const float* mb = mods + mod_index(u.pm * 256) * NMODS; const float* gate = mb + gslot * D;
        f32x4 gv[2][2], gg[2][2], rg[2][2];
#pragma unroll
        for (int bj = 0; bj < 2; ++bj)
#pragma unroll
            for (int n = 0; n < 2; ++n) { const int c = col0 + bj * 128 + n * 16; gv[bj][n] = *(const f32x4*)(gate + c) * coef;
                if (NEXT) gg[bj][n] = gsafe(*(const f32x4*)(gain + c) * (*(const f32x4*)(mb + scslot * D + c) + 1.0f));
                if (RECON) { const f32x4 g = gsafe(*(const f32x4*)(gain_prev + c) * (*(const f32x4*)(mb + scprev * D + c) + 1.0f)); rg[bj][n] = (f32x4){frcp(g.x), frcp(g.y), frcp(g.z), frcp(g.w)}; } }
#pragma unroll
        for (int ai = 0; ai < 2; ++ai)
#pragma unroll
            for (int m = 0; m < 4; ++m) { const int row = row0 + ai * 128 + m * 16;
                const float* ip = row < MP ? inA + (size_t)row * D : inB + (size_t)(row - MP) * D; float s = 0.f;
#pragma unroll
                for (int bj = 0; bj < 2; ++bj)
#pragma unroll
                    for (int n = 0; n < 2; ++n) { const int c = col0 + bj * 128 + n * 16; f32x4 xin;
                        if (RECON) { const v2u w = *(const v2u*)(hin + (size_t)row * D + c); xin = (f32x4){bflo(w.x), bfhi(w.x), bflo(w.y), bfhi(w.y)} * rg[bj][n]; }
                        else xin = __builtin_nontemporal_load((const f32x4*)(ip + c));
                        const f32x4 x = xin + gv[bj][n] * acc[ai][bj][m][n];
                        if (WRITE_X) *(f32x4*)(out + (size_t)row * D + c) = x;
                        if (NEXT) { s += (x.x * x.x + x.y * x.y) + (x.z * x.z + x.w * x.w); const f32x4 y = x * gg[bj][n]; v2u w; w.x = pk2(y.x, y.y); w.y = pk2(y.z, y.w); *(v2u*)(hn + (size_t)row * D + c) = w; } }
                if (NEXT) { s += __shfl_xor(s, 16); s += __shfl_xor(s, 32); if (fq == 0) atomicAdd(ssq + row, s); } }
    }
};
struct EpiFinal { static constexpr bool PERM = false, AFTER_DRAIN = true; const bf16* hin; const float* gain_prev; float* out; const float* mods; const float* fgain; float* xbuf; unsigned* cnt; int gslot; int scprev; float coef;
    DI void operator()(EPI_ARGS) const {}
    DI void fused(f32x4 (&acc)[2][2][4][2], const Unit& u, int wr, int wc, int fr, int fq, LAS unsigned char* lds, int wid, int lane) const {
        const int tid = wid * 64 + lane;
        const int row0 = u.pm * 256 + wr * 64 + fr, col0 = u.pn * 256 + wc * 32 + 4 * fq;
        const float* gate = mods + mod_index(u.pm * 256) * NMODS + gslot * D;
        LAS float* P = (LAS float*)lds; LAS float* S = (LAS float*)(lds + 4096);
        f32x4 gv[2][2], rg[2][2]; const float* mb = mods + mod_index(u.pm * 256) * NMODS;
#pragma unroll
        for (int bj = 0; bj < 2; ++bj)
#pragma unroll
            for (int n = 0; n < 2; ++n) { const int c = col0 + bj * 128 + n * 16; gv[bj][n] = *(const f32x4*)(gate + c) * coef;
                const f32x4 g = gsafe(*(const f32x4*)(gain_prev + c) * (*(const f32x4*)(mb + scprev * D + c) + 1.0f)); rg[bj][n] = (f32x4){frcp(g.x), frcp(g.y), frcp(g.z), frcp(g.w)}; }
#pragma unroll
        for (int ai = 0; ai < 2; ++ai)
#pragma unroll
            for (int m = 0; m < 4; ++m) { const int row = row0 + ai * 128 + m * 16; const bf16* ip = hin + (size_t)row * D; float s = 0.f;
#pragma unroll
                for (int bj = 0; bj < 2; ++bj)
#pragma unroll
                    for (int n = 0; n < 2; ++n) { const v2u w = __builtin_nontemporal_load((const v2u*)(ip + col0 + bj * 128 + n * 16)); const f32x4 x = (f32x4){bflo(w.x), bfhi(w.x), bflo(w.y), bfhi(w.y)} * rg[bj][n] + gv[bj][n] * acc[ai][bj][m][n]; acc[ai][bj][m][n] = x; s += (x.x * x.x + x.y * x.y) + (x.z * x.z + x.w * x.w); }
                s += __shfl_xor(s, 16); s += __shfl_xor(s, 32);
                if (fq == 0) P[(ai * 128 + wr * 64 + m * 16 + fr) * 4 + wc] = s; }
        LDS_WAIT(); __syncthreads();
        if (tid < 256) { const f32x4 p = *(const LAS f32x4*)(P + tid * 4);
            __hip_atomic_store(xbuf + (size_t)(u.pm * 256 + tid) * 4 + u.pn, (p.x + p.y) + (p.z + p.w), __ATOMIC_RELAXED, __HIP_MEMORY_SCOPE_AGENT);
            asm volatile("s_waitcnt vmcnt(0)" ::: "memory");
            if (lane == 0) __hip_atomic_fetch_add(cnt + 64 * u.pm, 1u, __ATOMIC_RELAXED, __HIP_MEMORY_SCOPE_AGENT); }
        if (wid == 0) { unsigned sp = 0;
            while ((unsigned)__builtin_amdgcn_readfirstlane(__hip_atomic_load(cnt + 64 * u.pm, __ATOMIC_RELAXED, __HIP_MEMORY_SCOPE_AGENT)) < 16u) { __builtin_amdgcn_s_sleep(2); if (++sp > (1u << 22)) break; }
            __builtin_amdgcn_fence(__ATOMIC_ACQUIRE, "agent"); }
        asm volatile("s_waitcnt vmcnt(0) lgkmcnt(0)" ::: "memory"); __syncthreads();
        if (tid < 256) { const float* xp = xbuf + (size_t)(u.pm * 256 + tid) * 4; float t = 0.f;
#pragma unroll
            for (int q = 0; q < 4; ++q) t += __hip_atomic_load(xp + q, __ATOMIC_RELAXED, __HIP_MEMORY_SCOPE_AGENT);
            S[tid] = rsq(t * (1.f / D) + EPS); }
        LDS_WAIT(); __syncthreads();
        f32x4 fg[2][2];
#pragma unroll
        for (int bj = 0; bj < 2; ++bj)
#pragma unroll
            for (int n = 0; n < 2; ++n) fg[bj][n] = *(const f32x4*)(fgain + col0 + bj * 128 + n * 16);
#pragma unroll
        for (int ai = 0; ai < 2; ++ai)
#pragma unroll
            for (int m = 0; m < 4; ++m) { const int rl = ai * 128 + wr * 64 + m * 16 + fr; const float rs = S[rl]; float* op = out + (size_t)(u.pm * 256 + rl) * D;
#pragma unroll
                for (int bj = 0; bj < 2; ++bj)
#pragma unroll
                    for (int n = 0; n < 2; ++n) __builtin_nontemporal_store(acc[ai][bj][m][n] * rs * fg[bj][n], (f32x4*)(op + col0 + bj * 128 + n * 16)); }
    }
};
struct EpiWin { static constexpr bool PERM = true, AFTER_DRAIN = false;
    bf16 *qa, *ka, *vaT, *qlat, *ckv, *ga, *gb, *krope; float *ssq_q, *ssq_kv; float* out; const float2* ropeA; const float2* ropeB; bool do_ssq; const float* ssq1; const float* shW;
    DI void operator()(EPI_ARGS) const {
        asm volatile("" : "+v"(fr), "+v"(fq));
        const int pn = u.pn; const bool sample = u.pm >= 32;
        const int rbase = u.pm * 256 + (u.half == 2 ? 128 : 0) + wr * 64 + fr;
        f32x4 sw[2][2]; { const float* sp = shW + mod_index(u.pm * 256) * NINP + pn * 256 + wc * 32 + 8 * fq;
#pragma unroll
            for (int bj = 0; bj < 2; ++bj)
#pragma unroll
                for (int n = 0; n < 2; ++n) sw[bj][n] = *(const f32x4*)(sp + bj * 128 + 4 * n); }
#define WACC(ai, bj, m, n) (acc[ai][bj][m][n] * rs + sw[bj][n])
        if (pn < 3) {
#pragma unroll
            for (int ai = 0; ai < 2; ++ai) { if (ai == 1 && u.half) break;
#pragma unroll
                for (int m = 0; m < 4; ++m) { const int row = rbase + ai * 128 + m * 16; const float rs = rsq(ssq1[row] * (1.f / D) + EPS); const int t = (row - MP) & 2047; const int pos = (wc & 1) ? (t & 63) : (t >> 6);
                    const float2* cs = ropeA + pos * 16 + 8 * (fq & 1); const float sgn = (fq & 2) ? 1.f : -1.f;
#pragma unroll
                    for (int bj = 0; bj < 2; ++bj) { f32x4 v0 = WACC(ai, bj, m, 0), v1 = WACC(ai, bj, m, 1); const int cl = bj * 128 + wc * 32 + 8 * fq;
                        if (pn < 2) { if (sample) rope8(v0, v1, cs, 32, sgn); v0 = v0 * A_QS; v1 = v1 * A_QS; *(v4u*)(qa + (size_t)row * 512 + pn * 256 + cl) = pack8(v0, v1); }
                        else if (bj == 0) { if (sample) rope8(v0, v1, cs, 32, sgn); *(v4u*)(ka + (size_t)row * 128 + cl) = pack8(v0, v1);
                            if (!sample) { float* o = out + OUT_K + (size_t)row * 128 + cl; __builtin_nontemporal_store(v0, (f32x4*)o); __builtin_nontemporal_store(v1, (f32x4*)(o + 4)); } }
                        else { const int c = cl - 128;
#pragma unroll
                            for (int j = 0; j < 4; ++j) { vaT[(size_t)(c + j) * MALL + row] = (bf16)f2bf(v0[j]); vaT[(size_t)(c + 4 + j) * MALL + row] = (bf16)f2bf(v1[j]); }
                            if (!sample) { float* o = out + OUT_V + (size_t)row * 128 + c; __builtin_nontemporal_store(v0, (f32x4*)o); __builtin_nontemporal_store(v1, (f32x4*)(o + 4)); } } } } }
        } else if (pn < 5) {
            bf16* dst = pn == 3 ? qlat : ckv; float* ssq = pn == 3 ? ssq_q : ssq_kv;
#pragma unroll
            for (int ai = 0; ai < 2; ++ai) { if (ai == 1 && u.half) break;
#pragma unroll
                for (int m = 0; m < 4; ++m) { const int row = rbase + ai * 128 + m * 16; const float rs = rsq(ssq1[row] * (1.f / D) + EPS); float s = 0.f;
#pragma unroll
                    for (int bj = 0; bj < 2; ++bj) { const f32x4 v0 = WACC(ai, bj, m, 0), v1 = WACC(ai, bj, m, 1);
                        s += (v0.x * v0.x + v0.y * v0.y) + (v0.z * v0.z + v0.w * v0.w) + (v1.x * v1.x + v1.y * v1.y) + (v1.z * v1.z + v1.w * v1.w);
                        *(v4u*)(dst + (size_t)row * 256 + bj * 128 + wc * 32 + 8 * fq) = pack8(v0, v1); }
                    s += __shfl_xor(s, 16); s += __shfl_xor(s, 32);
                    if (fq == 0 && do_ssq) atomicAdd(ssq + row, s); } }
        } else if (pn < 13) {
            const int ct = (pn - 5) * 128 + wc * 32 + 8 * fq;
#pragma unroll
            for (int ai = 0; ai < 2; ++ai) { if (ai == 1 && u.half) break;
#pragma unroll
                for (int m = 0; m < 4; ++m) { const int row = rbase + ai * 128 + m * 16; const float rs = rsq(ssq1[row] * (1.f / D) + EPS);
                    f32x4 r0, r1, b0, b1;
                    { const f32x4 a0 = WACC(ai, 0, m, 0), a1 = WACC(ai, 0, m, 1), c0 = WACC(ai, 1, m, 0), c1 = WACC(ai, 1, m, 1);
#pragma unroll
                      for (int j = 0; j < 4; ++j) {
                          const float ea0 = fexp2(-a0[j]), ea1 = fexp2(-a1[j]), eb0 = fminf(fexp2(-c0[j]), 1e30f), eb1 = fminf(fexp2(-c1[j]), 1e30f);
                          b0[j] = frcp(1.f + eb0); b1[j] = frcp(1.f + eb1); r0[j] = (1.f + eb0) * frcp(1.f + ea0); r1[j] = (1.f + eb1) * frcp(1.f + ea1); } }
                    *(v4u*)(ga + (size_t)row * D + ct) = pack8(r0, r1); *(v4u*)(gb + (size_t)row * D + ct) = pack8(b0, b1); } }
        } else if (wc == 0) {
#pragma unroll
            for (int ai = 0; ai < 2; ++ai) { if (ai == 1 && u.half) break;
#pragma unroll
                for (int m = 0; m < 4; ++m) { const int row = rbase + ai * 128 + m * 16; const float rs = rsq(ssq1[row] * (1.f / D) + EPS); const int t = (row - MP) & 2047; const int pos = (fq & 2) ? (t & 63) : (t >> 6);
                    f32x4 v0 = WACC(ai, 0, m, 0), v1 = WACC(ai, 0, m, 1);
                    if (sample) rope8(v0, v1, ropeB + pos * 8, 16, (fq & 1) ? 1.f : -1.f);
                    *(v4u*)(krope + (size_t)row * 32 + 8 * fq) = pack8(v0, v1);
                    if (!sample) { float* o = out + OUT_KR + (size_t)row * 32 + 8 * fq; __builtin_nontemporal_store(v0, (f32x4*)o); __builtin_nontemporal_store(v1, (f32x4*)(o + 4)); } } }
        }
    }
};
#undef WACC
struct EpiQB { static constexpr bool PERM = true, AFTER_DRAIN = false; bf16* qb; const float* ssq; const float2* ropeB;
    DI void operator()(EPI_ARGS) const {
        asm volatile("" : "+v"(fr), "+v"(fq));
        const int rbase = u.pm * 256 + wr * 64 + fr; const bool sample = u.pm >= 32;
#pragma unroll
        for (int ai = 0; ai < 2; ++ai)
#pragma unroll
            for (int m = 0; m < 4; ++m) { const int row = rbase + ai * 128 + m * 16; const float rs = rsq(ssq[row] * (1.f / 256.f) + EPS);
                const int t = (row - MP) & 2047; const int pos = (fq & 2) ? (t & 63) : (t >> 6);
#pragma unroll
                for (int bj = 0; bj < 2; ++bj) { f32x4 v0 = acc[ai][bj][m][0] * rs, v1 = acc[ai][bj][m][1] * rs;
                    if (u.pn == 2 && sample) rope8(v0, v1, ropeB + pos * 8, 16, (fq & 1) ? 1.f : -1.f);
                    *(v4u*)(qb + (size_t)row * 768 + u.pn * 256 + bj * 128 + wc * 32 + 8 * fq) = pack8(v0, v1); } }
    }
};
struct EpiKN { static constexpr bool PERM = true, AFTER_DRAIN = false; bf16* kn; const float* ssq;
    DI void operator()(EPI_ARGS) const {
        asm volatile("" : "+v"(fr), "+v"(fq));
        const int rbase = u.pm * 256 + wr * 64 + fr; const bool lat = u.pm < 64;
#pragma unroll
        for (int ai = 0; ai < 2; ++ai)
#pragma unroll
            for (int m = 0; m < 4; ++m) { const int row = rbase + ai * 128 + m * 16; const float rs = lat ? rsq(ssq[row] * (1.f / 256.f) + EPS) : 1.0f;
#pragma unroll
                for (int bj = 0; bj < 2; ++bj) *(v4u*)(kn + (size_t)row * 512 + u.pn * 256 + bj * 128 + wc * 32 + 8 * fq) = pack8(acc[ai][bj][m][0] * rs, acc[ai][bj][m][1] * rs); }
    }
};
struct EpiVT { static constexpr bool PERM = true, AFTER_DRAIN = false; bf16* vt; const float* ssq;
    DI void operator()(EPI_ARGS) const {
        asm volatile("" : "+v"(fr), "+v"(fq));
        const int rbase = u.pm * 256 + wr * 64 + fr; const bool lat = u.pn < 64;
        f32x4 rs[2][2];
#pragma unroll
        for (int bj = 0; bj < 2; ++bj)
#pragma unroll
            for (int n = 0; n < 2; ++n) { const int c = u.pn * 256 + bj * 128 + wc * 32 + 8 * fq + 4 * n;
                if (lat) { const f32x4 q = *(const f32x4*)(ssq + c); rs[bj][n] = (f32x4){rsq(q.x * (1.f / 256.f) + EPS), rsq(q.y * (1.f / 256.f) + EPS), rsq(q.z * (1.f / 256.f) + EPS), rsq(q.w * (1.f / 256.f) + EPS)}; }
                else rs[bj][n] = (f32x4){1.f, 1.f, 1.f, 1.f}; }
#pragma unroll
        for (int ai = 0; ai < 2; ++ai)
#pragma unroll
            for (int m = 0; m < 4; ++m) { const int row = rbase + ai * 128 + m * 16;
#pragma unroll
                for (int bj = 0; bj < 2; ++bj) *(v4u*)(vt + (size_t)row * MALL + u.pn * 256 + bj * 128 + wc * 32 + 8 * fq) = pack8(acc[ai][bj][m][0] * rs[bj][0], acc[ai][bj][m][1] * rs[bj][1]); }
    }
};
template <bool SECOND> struct EpiMerge { static constexpr bool PERM = true, AFTER_DRAIN = false; bf16* mm; const bf16* g;
    DI void operator()(EPI_ARGS) const {
        asm volatile("" : "+v"(fr), "+v"(fq));
        const int rbase = u.pm * 256 + wr * 64 + fr;
#pragma unroll
        for (int ai = 0; ai < 2; ++ai)
#pragma unroll
            for (int m = 0; m < 4; ++m) { const int row = rbase + ai * 128 + m * 16;
#pragma unroll
                for (int bj = 0; bj < 2; ++bj) { const size_t o = (size_t)row * D + u.pn * 256 + bj * 128 + wc * 32 + 8 * fq;
                    f32x4 g0, g1; unpack8(*(const v4u*)(g + o), g0, g1); f32x4 v0 = acc[ai][bj][m][0] * g0, v1 = acc[ai][bj][m][1] * g1;
                    if (SECOND) { f32x4 p0, p1; unpack8(*(const v4u*)(mm + o), p0, p1); v0 += p0; v1 += p1; }
                    *(v4u*)(mm + o) = pack8(v0, v1); } }
    }
};

struct EpiMergeK { static constexpr bool PERM = true, AFTER_DRAIN = false, MIDK = true; bf16* mm; const bf16* ga; const bf16* gb;
    DI void mid(f32x4 (&acc)[2][2][4][2], const Unit& u, int wr, int wc, int fr, int fq) const {
        asm volatile("" : "+v"(fr), "+v"(fq));
        const int rbase = u.pm * 256 + wr * 64 + fr;
#pragma unroll
        for (int ai = 0; ai < 2; ++ai)
#pragma unroll
            for (int m = 0; m < 4; ++m) { const int row = rbase + ai * 128 + m * 16;
#pragma unroll
                for (int bj = 0; bj < 2; ++bj) { const size_t o = (size_t)row * D + u.pn * 256 + bj * 128 + wc * 32 + 8 * fq;
                    f32x4 a0, a1; unpack8(__builtin_nontemporal_load((const v4u*)(ga + o)), a0, a1);
                    acc[ai][bj][m][0] = acc[ai][bj][m][0] * a0; acc[ai][bj][m][1] = acc[ai][bj][m][1] * a1; } }
    }
    DI void operator()(EPI_ARGS) const {
        asm volatile("" : "+v"(fr), "+v"(fq));
        const int rbase = u.pm * 256 + wr * 64 + fr;
#pragma unroll
        for (int ai = 0; ai < 2; ++ai)
#pragma unroll
            for (int m = 0; m < 4; ++m) { const int row = rbase + ai * 128 + m * 16;
#pragma unroll
                for (int bj = 0; bj < 2; ++bj) { const size_t o = (size_t)row * D + u.pn * 256 + bj * 128 + wc * 32 + 8 * fq;
                    f32x4 b0, b1; unpack8(__builtin_nontemporal_load((const v4u*)(gb + o)), b0, b1);
                    *(v4u*)(mm + o) = pack8(acc[ai][bj][m][0] * b0, acc[ai][bj][m][1] * b1); } }
    }
};
static_assert(pg8::MidK<EpiMergeK>::value && !pg8::MidK<EpiWin>::value, "mid-K hook trait");
#define MFMA32(a, b, c) __builtin_amdgcn_mfma_f32_32x32x16_bf16((a), (b), (c), 0, 0, 0)
#ifndef ATT_RS
#define ATT_RS 16.0f
#endif
template <int DQ>
DI void attn_unit(LAS unsigned char* lds, int tid, int lane,
                  const bf16* qn, int ldqn, const bf16* qr, int ldqr,
                  const bf16* Kb, int ldk, const bf16* Kr, const bf16* Vt,
                  int s0_tok, int s0_n, int s1_tok, int s1_n, bool band, int qtok,
                  float sink_l2, bool has_sink, bf16* outp, int ldo) {
    constexpr int KS = DQ * 2 + 16, VS = 144, BUF = 64 * KS + 64 * VS, NKS = DQ / 16;
    const int r = lane & 31, hh = lane >> 5;
    const int pr = (r & ~12) | ((r & 4) << 1) | ((r & 8) >> 1);
    bf16x8 qf[NKS];
#pragma unroll
    for (int ks = 0; ks < NKS; ++ks) qf[ks] = ks < 4 ? __builtin_nontemporal_load((const bf16x8*)(qn + (size_t)r * ldqn + 16 * ks + 8 * hh)) : __builtin_nontemporal_load((const bf16x8*)(qr + (size_t)r * ldqr + 16 * (ks - 4) + 8 * hh));
    f32x16 ot[2];
#pragma unroll
    for (int i = 0; i < 16; ++i) { ot[0][i] = 0.f; ot[1][i] = 0.f; }
    float mrun = 0.f; f32x16 lacc;
#pragma unroll
    for (int i = 0; i < 16; ++i) lacc[i] = 0.f;
    const int ntile = s0_n + s1_n;
    const int krow = tid >> 3, kch = tid & 7, rrow = tid >> 2, rch = tid & 3;
    v4u kreg, rreg, vreg;
    auto tile_tok = [&](int t) { return t < s0_n ? s0_tok + 64 * t : s1_tok + 64 * (t - s0_n); };
    auto gload = [&](int t) { const int tok0 = tile_tok(t);
        kreg = *(const v4u*)(Kb + (size_t)(tok0 + krow) * ldk + kch * 8);
        if (DQ == 96) { if (tid < 256) rreg = *(const v4u*)(Kr + (size_t)(tok0 + rrow) * 32 + rch * 8); }
        vreg = *(const v4u*)(Vt + (size_t)krow * MALL + tok0 + kch * 8); };
    auto lstore = [&](int b) { LAS unsigned char* kb_ = lds + b * BUF;
        *(LAS v4u*)(kb_ + krow * KS + kch * 16) = kreg;
        if (DQ == 96) { if (tid < 256) *(LAS v4u*)(kb_ + rrow * KS + 128 + rch * 16) = rreg; }
        *(LAS v4u*)(kb_ + 64 * KS + krow * VS + kch * 16) = vreg; };
    gload(0); lstore(0); __syncthreads();
    for (int t = 0; t < ntile; ++t) {
        const bool more = t + 1 < ntile;
        if (more) gload(t + 1);
        LAS unsigned char* kb_ = lds + (t & 1) * BUF; LAS unsigned char* vb_ = kb_ + 64 * KS;
        f32x16 st[2];
#pragma unroll
        for (int kb = 0; kb < 2; ++kb) {
#pragma unroll
            for (int i = 0; i < 16; ++i) st[kb][i] = 0.f;
#pragma unroll
            for (int ks = 0; ks < NKS; ++ks) { const bf16x8 kf = *(const LAS bf16x8*)(kb_ + (32 * kb + pr) * KS + (16 * ks + 8 * hh) * 2); st[kb] = MFMA32(kf, qf[ks], st[kb]); }
        }
        __builtin_amdgcn_sched_barrier(0);
        if (band && t < s0_n) { const int d0 = tile_tok(t) + 8 * hh - (qtok + r);
#pragma unroll
            for (int kb = 0; kb < 2; ++kb)
#pragma unroll
                for (int i = 0; i < 16; ++i) { const int d = d0 + 32 * kb + 16 * (i >> 3) + (i & 7); if (d > 128 || d < -128) st[kb][i] = -1e30f; } }
        float mx;
        { const f32x16& A = st[0]; const f32x16& B = st[1];
          float m0 = fmaxf(fmaxf(A[0], A[1]), A[2]), m1 = fmaxf(fmaxf(A[3], A[4]), A[5]), m2 = fmaxf(fmaxf(A[6], A[7]), A[8]), m3 = fmaxf(fmaxf(A[9], A[10]), A[11]);
          m0 = fmaxf(fmaxf(m0, A[12]), A[13]); m1 = fmaxf(fmaxf(m1, A[14]), A[15]); m2 = fmaxf(fmaxf(m2, B[0]), B[1]); m3 = fmaxf(fmaxf(m3, B[2]), B[3]);
          m0 = fmaxf(fmaxf(m0, B[4]), B[5]); m1 = fmaxf(fmaxf(m1, B[6]), B[7]); m2 = fmaxf(fmaxf(m2, B[8]), B[9]); m3 = fmaxf(fmaxf(m3, B[10]), B[11]);
          m0 = fmaxf(fmaxf(m0, B[12]), B[13]); m1 = fmaxf(fmaxf(m1, B[14]), B[15]); mx = fmaxf(fmaxf(m0, m1), fmaxf(m2, m3)); }
        mx = fmaxf(mx, __shfl_xor(mx, 32));
        { const bool up = mx > mrun + ATT_RS, dn = (t == 0) && (mx < mrun - ATT_RS);
          if (__builtin_amdgcn_ballot_w64(up || dn) != 0ull) {
              if (t == 0) { mrun = (up || dn) ? mx : mrun; }
              else { const float mnew = up ? mx : mrun, alpha = fexp2(mrun - mnew); mrun = mnew; lacc = lacc * alpha; ot[0] = ot[0] * alpha; ot[1] = ot[1] * alpha; } } }
        if (__builtin_amdgcn_ballot_w64(mrun != 0.f) != 0ull) { st[0] = st[0] - mrun; st[1] = st[1] - mrun; }
#pragma unroll
        for (int kb = 0; kb < 2; ++kb)
#pragma unroll
            for (int i = 0; i < 16; ++i) st[kb][i] = fexp2(st[kb][i]);
        lacc = lacc + (st[0] + st[1]);
#pragma unroll
        for (int kb = 0; kb < 2; ++kb)
#pragma unroll
            for (int s = 0; s < 2; ++s) { v4u pw; pw.x = pk2(st[kb][8 * s], st[kb][8 * s + 1]); pw.y = pk2(st[kb][8 * s + 2], st[kb][8 * s + 3]); pw.z = pk2(st[kb][8 * s + 4], st[kb][8 * s + 5]); pw.w = pk2(st[kb][8 * s + 6], st[kb][8 * s + 7]);
                const bf16x8 pf = __builtin_bit_cast(bf16x8, pw);
#pragma unroll
                for (int db = 0; db < 2; ++db) { const bf16x8 vf = *(const LAS bf16x8*)(vb_ + (32 * db + r) * VS + (32 * kb + 16 * s + 8 * hh) * 2); ot[db] = MFMA32(vf, pf, ot[db]); } }
        __builtin_amdgcn_sched_barrier(0);
        if (more) lstore((t + 1) & 1);
        __syncthreads();
    }
    float lrun = ((lacc[0] + lacc[1]) + (lacc[2] + lacc[3])) + ((lacc[4] + lacc[5]) + (lacc[6] + lacc[7])) + (((lacc[8] + lacc[9]) + (lacc[10] + lacc[11])) + ((lacc[12] + lacc[13]) + (lacc[14] + lacc[15])));
    if (has_sink && hh == 0) lrun += fexp2(sink_l2 - mrun);
    const float inv = frcp(lrun + __shfl_xor(lrun, 32));
#pragma unroll
    for (int db = 0; db < 2; ++db)
#pragma unroll
        for (int a4 = 0; a4 < 4; ++a4) { v2u w; w.x = pk2(ot[db][4 * a4] * inv, ot[db][4 * a4 + 1] * inv); w.y = pk2(ot[db][4 * a4 + 2] * inv, ot[db][4 * a4 + 3] * inv);
            *(v2u*)(outp + (size_t)r * ldo + 32 * db + 8 * a4 + 4 * hh) = w; }
}

DI void attn_phase(const Args& a, LAS unsigned char* lds, int tid, int wave, int lane) {
    unsigned char* ws = a.ws;
    const bf16* qa = (const bf16*)(ws + OFF_QA); const bf16* ka = (const bf16*)(ws + OFF_KA); const bf16* vaT = (const bf16*)(ws + OFF_VAT);
    const bf16* qb = (const bf16*)(ws + OFF_QB); const bf16* kn = (const bf16*)(ws + OFF_KN); const bf16* kr = (const bf16*)(ws + OFF_KROPE); const bf16* vbT = (const bf16*)(ws + OFF_VBT);
    bf16* oa = (bf16*)a.out; bf16* ob = oa + 512;
    const float* sink = a.in[15];
    for (int uu = blockIdx.x; uu < 1024; uu += gridDim.x) {
        const int type = uu >> 8, u0 = uu & 255, vu = (u0 & 7) * 32 + (u0 >> 3);
        if (type == 0) {
            const int b = vu >> 6, h = (vu >> 3) & 7, qblk = vu & 7; const int tok = MP + b * 2048 + qblk * 256 + 32 * wave;
            attn_unit<96>(lds, tid, lane, qb + (size_t)tok * 768 + h * 64, 768, qb + (size_t)tok * 768 + 512 + h * 32, 768, kn + h * 64, 512, kr, vbT + (size_t)(h * 64) * MALL,
                          M + b * 512, 8, MP + b * 2048, 32, false, 0, 0.f, false, ob + (size_t)tok * 1024 + h * 64, 1024);
        } else if (type == 1) {
            const int b = vu >> 6, kh = (vu >> 5) & 1, qblk = vu & 31; const int head = kh * 4 + (wave >> 1); const int tok = MP + b * 2048 + qblk * 64 + 32 * (wave & 1);
            const int lo = qblk - 2 < 0 ? 0 : qblk - 2, hi = qblk + 2 > 31 ? 31 : qblk + 2;
            attn_unit<64>(lds, tid, lane, qa + (size_t)tok * 512 + head * 64, 512, nullptr, 0, ka + kh * 64, 128, nullptr, vaT + (size_t)(kh * 64) * MALL,
                          MP + b * 2048 + lo * 64, hi - lo + 1, M + b * 512, 8, true, tok, sink[head] * LOG2E, true, oa + (size_t)tok * 1024 + head * 64, 1024);
        } else if (type == 2) {
            const int b = vu >> 3, kh = (vu >> 2) & 1, qblk = vu & 3; const int head = kh * 4 + (wave >> 1); const int tok = b * 256 + qblk * 64 + 32 * (wave & 1);
            attn_unit<64>(lds, tid, lane, qa + (size_t)tok * 512 + head * 64, 512, nullptr, 0, ka + kh * 64, 128, nullptr, vaT + (size_t)(kh * 64) * MALL,
                          b * 256, 4, 0, 0, false, 0, sink[head] * LOG2E, true, oa + (size_t)tok * 1024 + head * 64, 1024);
        } else {
            const int b = vu >> 3, h = vu & 7; const int tok = b * 256 + 32 * wave;
            attn_unit<96>(lds, tid, lane, qb + (size_t)tok * 768 + h * 64, 768, qb + (size_t)tok * 768 + 512 + h * 32, 768, kn + h * 64, 512, kr, vbT + (size_t)(h * 64) * MALL,
                          b * 256, 4, 0, 0, false, 0, 0.f, false, ob + (size_t)tok * 1024 + h * 64, 1024);
        }
    }
}

__global__ void __launch_bounds__(512, 2) mk_fwd(Args a) {
    extern __shared__ __attribute__((aligned(16))) unsigned char lds_raw[];
    LAS unsigned char* lds = (LAS unsigned char*)lds_raw;
    cg::grid_group grid = cg::this_grid();
    const int tid = threadIdx.x, lane = tid & 63, wave = __builtin_amdgcn_readfirstlane(tid >> 6);
    const int G = gridDim.x, gw = blockIdx.x * 8 + wave, NGW = G * 8, gtid = blockIdx.x * 512 + tid, NT = G * 512;
    unsigned char* ws = a.ws;
    float* mods = (float*)(ws + OFF_MODS); float* ssq_q = (float*)(ws + OFF_SSQQ); float* ssq_kv = (float*)(ws + OFF_SSQKV);
    const float2* ropeA = (const float2*)(ws + OFF_ROPEA); const float2* ropeB = (const float2*)(ws + OFF_ROPEB);
    bf16* H = (bf16*)(ws + OFF_H); bf16* ACT = (bf16*)(ws + OFF_ACT);
    float* xr = a.out;
    const int lo = a.ph_lo, hi = a.ph_hi;
#if defined(TSK)
    const unsigned long long ts_start = __builtin_amdgcn_s_memrealtime(); unsigned long long ts_k = 0;
#endif
    if (hi > 1000) grid.sync();
    volatile LAS unsigned* xst = (volatile LAS unsigned*)(lds + 131072);
    if (tid < 2) xst[tid] = 0u;
    __syncthreads();
    XcdBarrier xbar = xcd_barrier_post((unsigned*)(ws + OFF_BAR), xst);
#ifndef P6M
#define P6M 7
#endif
#ifndef PH_MASK
#define PH_MASK 0x3fff
#endif
#define IN(k) (((PH_MASK >> (k)) & 1) && lo <= (k) && (k) < hi)
#define INX(k) (IN(k) || (k) == 4 || (k) == 10)
#if defined(TSK)
#define SEAM(k) do { if (IN(k) && INX((k) + 1)) xcd_barrier(xbar); if ((k) == TSK) ts_k = __builtin_amdgcn_s_memrealtime(); } while (0)
#else
#define SEAM(k) do { if (IN(k) && INX((k) + 1)) xcd_barrier(xbar); } while (0)
#endif
    if (IN(0)) { p0_misc(a, gtid, NT); p0_ada(a, lds, tid); }
    SEAM(0);
    float* ssq1 = (float*)(ws + OFF_SSQ1); float* ssq2 = (float*)(ws + OFF_SSQ2); float* shW2 = (float*)(ws + OFF_SHW2); float* shW3 = (float*)(ws + OFF_SHW3);
    if (IN(1)) { norm_mod_phase(a.in[0], a.in[1], a.in[10], mods, 0, H, gw, NGW, lane); p0_weights(a, lds, gw, NGW, wave, lane, 0, P0_EARLY); }
    SEAM(1);
    if (IN(2)) { pg8::Gemm g{H, (const bf16*)(ws + OFF_WGU1), M, NGU, D}; pg8::StaticOrder S; S.init(M, NGU, G, (int)blockIdx.x); EpiSwiglu<false> E{ACT, nullptr, nullptr};
        pg8::gemm_phase<EpiSwiglu<false>, pg8::StaticOrder, PG8_ALIGN, PG8_SP2>(lds, g, S, E);
        { const int nwg = (M / 256) * (NGU / 256), rounds = (nwg + G - 1) / G, first_idle = nwg - (rounds - 1) * G;
          const int nidle = G - first_idle;
          if (nidle <= 0) { shw_phase((const bf16*)(ws + OFF_WIN), NINP, mods, 3, shW2, gw, NGW, lane); p0_weights(a, lds, gw, NGW, wave, lane, P0_EARLY, P0_NIT); }
          else if ((int)blockIdx.x >= first_idle) { const int gw2 = ((int)blockIdx.x - first_idle) * 8 + wave, NGW2 = nidle * 8;
              shw_phase((const bf16*)(ws + OFF_WIN), NINP, mods, 3, shW2, gw2, NGW2, lane);
              p0_weights(a, lds, gw2, NGW2, wave, lane, P0_EARLY, P0_NIT); } } }
    SEAM(2);
    if (IN(3)) { pg8::Gemm g{ACT, (const bf16*)(ws + OFF_WD1), M, D, FF}; pg8::StaticOrder S; S.init(M, D, G, (int)blockIdx.x); EpiResid<true, false, false> E{a.in[0], a.in[1], nullptr, nullptr, nullptr, mods, H, a.in[13], ssq1, 2, 0, 4, 0.5f};
        pg8::gemm_phase<EpiResid<true, false, false>, pg8::StaticOrder, PG8_ALIGN, PG8_SP2>(lds, g, S, E); }
    SEAM(3);
    if (IN(5)) { pg8::Gemm g{H, (const bf16*)(ws + OFF_WIN), M, NINP, D}; pg8::StaticOrder S; S.init(M, NINP, G, (int)blockIdx.x);
        EpiWin E{(bf16*)(ws + OFF_QA), (bf16*)(ws + OFF_KA), (bf16*)(ws + OFF_VAT), (bf16*)(ws + OFF_QLAT), (bf16*)(ws + OFF_CKV), (bf16*)(ws + OFF_GA), (bf16*)(ws + OFF_GB), (bf16*)(ws + OFF_KROPE),
                 ssq_q, ssq_kv, a.out, ropeA, ropeB, true, ssq1, shW2};
        pg8::gemm_phase<EpiWin, pg8::StaticOrder, PG8_ALIGN, PG8_SP2>(lds, g, S, E);
        { const int nwg = (M / 256) * (NINP / 256), rounds = (nwg + G - 1) / G, first_idle = nwg - (rounds - 1) * G, nidle = G - first_idle;
          if (nidle <= 0) { ctx_convert(a, gtid, NT); shw_phase((const bf16*)(ws + OFF_WGU2), NGU, mods, 6, shW3, gw, NGW, lane); }
          else if ((int)blockIdx.x >= first_idle) { ctx_convert(a, ((int)blockIdx.x - first_idle) * 512 + tid, nidle * 512);
              shw_phase((const bf16*)(ws + OFF_WGU2), NGU, mods, 6, shW3, ((int)blockIdx.x - first_idle) * 8 + wave, nidle * 8, lane); } }
#if defined(DUP5)
        xcd_barrier(xbar); E.do_ssq = false; pg8::gemm_phase<EpiWin, pg8::StaticOrder, PG8_ALIGN, PG8_SP2>(lds, g, S, E);
#endif
    }
    SEAM(5);
#if defined(DUP6)
    for (int rep6 = 0; rep6 < 2; ++rep6) { if (rep6) xcd_barrier(xbar);
#endif
    if (IN(6)) {
        int K6 = 256; asm volatile("" : "+s"(K6));
#if P6M & 1
        { pg8::Gemm g{(const bf16*)(ws + OFF_QLAT), (const bf16*)(ws + OFF_WUQ), M, 768, K6}; pg8::StaticOrder S; S.init(M, 768, G, (int)blockIdx.x); EpiQB E{(bf16*)(ws + OFF_QB), ssq_q, ropeB};
          pg8::gemm_phase<EpiQB, pg8::StaticOrder, PG8_ALIGN, PG8_SP2>(lds, g, S, E); }
#endif
#if P6M & 2
        { pg8::Gemm g{(const bf16*)(ws + OFF_CKV), (const bf16*)(ws + OFF_WK), MALL, 512, K6}; pg8::StaticOrder S; S.init(MALL, 512, G, (int)((blockIdx.x + 64) % G)); EpiKN E{(bf16*)(ws + OFF_KN), ssq_kv};
          pg8::gemm_phase<EpiKN, pg8::StaticOrder, PG8_ALIGN, PG8_SP2>(lds, g, S, E); }
#endif
#if P6M & 4
        { pg8::Gemm g{(const bf16*)(ws + OFF_WV), (const bf16*)(ws + OFF_CKV), 512, MALL, K6}; pg8::StaticOrder S; S.init(512, MALL, G, (int)((blockIdx.x + 176) % G)); EpiVT E{(bf16*)(ws + OFF_VBT), ssq_kv};
          pg8::gemm_phase<EpiVT, pg8::StaticOrder, PG8_ALIGN, PG8_SP2>(lds, g, S, E); }
#endif
        { const bf16* ckv = (const bf16*)(ws + OFF_CKV); const float* gn = a.in[17]; float* o = a.out + OUT_CKV;
          for (int row = gw; row < MP; row += NGW) { const float rs = rsq(ssq_kv[row] * (1.f / 256.f) + EPS); const v2u w = *(const v2u*)(ckv + (size_t)row * 256 + 4 * lane); const f32x4 g4 = *(const f32x4*)(gn + 4 * lane);
              __builtin_nontemporal_store((f32x4){bflo(w.x), bfhi(w.x), bflo(w.y), bfhi(w.y)} * rs * g4, (f32x4*)(o + (size_t)row * 256 + 4 * lane)); } }
    }
#if defined(DUP6)
    }
#endif
    SEAM(6);
    if (IN(7)) attn_phase(a, lds, tid, wave, lane);
#if defined(DUP7)
    xcd_barrier(xbar); attn_phase(a, lds, tid, wave, lane);
#endif
    SEAM(7);
    if (IN(8)) { pg8::Gemm g{(const bf16*)a.out, (const bf16*)(ws + OFF_WOA), M, D, D}; pg8::StaticOrder S; S.init(M, D, G, (int)blockIdx.x); EpiMergeK E{(bf16*)(ws + OFF_MM), (const bf16*)(ws + OFF_GA), (const bf16*)(ws + OFF_GB)};
        pg8::gemm_phase<EpiMergeK, pg8::StaticOrder, PG8_ALIGN, PG8_SP2>(lds, g, S, E); }
    SEAM(8);
    if (IN(9)) { pg8::Gemm g{(const bf16*)(ws + OFF_MM), (const bf16*)(ws + OFF_WOUT), M, D, D}; pg8::StaticOrder S; S.init(M, D, G, (int)blockIdx.x); EpiResid<true, true, false> E{nullptr, nullptr, H, a.in[13], nullptr, mods, H, a.in[23], ssq2, 5, 4, 7, 1.0f};
        pg8::gemm_phase<EpiResid<true, true, false>, pg8::StaticOrder, PG8_ALIGN, PG8_SP2>(lds, g, S, E); }
    SEAM(9);
    if (IN(11)) { pg8::Gemm g{H, (const bf16*)(ws + OFF_WGU2), M, NGU, D}; pg8::StaticOrder S; S.init(M, NGU, G, (int)blockIdx.x); EpiSwiglu<true> E{ACT, ssq2, shW3};
        pg8::gemm_phase<EpiSwiglu<true>, pg8::StaticOrder, PG8_ALIGN, PG8_SP2>(lds, g, S, E); }
    SEAM(11);
    if (IN(12)) { pg8::Gemm g{ACT, (const bf16*)(ws + OFF_WD2), M, D, FF}; pg8::StaticOrder S; S.init(M, D, G, (int)blockIdx.x);
        if (G == 256) { EpiFinal E{H, a.in[23], xr, mods, a.in[26], (float*)(ws + OFF_PARTQ), (unsigned*)(ws + OFF_PCNT), 8, 7, 0.5f};
            pg8::gemm_phase<EpiFinal, pg8::StaticOrder, false, PG8_SP2>(lds, g, S, E); }
        else { EpiResid<false, true, true> E{nullptr, nullptr, H, a.in[23], xr, mods, nullptr, nullptr, nullptr, 8, 7, 0, 0.5f};
            pg8::gemm_phase<EpiResid<false, true, true>, pg8::StaticOrder, PG8_ALIGN, PG8_SP2>(lds, g, S, E);
            xcd_barrier(xbar); final_norm_phase(xr, a.in[26], gw, NGW, lane); } }
#if defined(TSK)
    if (blockIdx.x == 0 && tid == 0) { const unsigned long long t_end = __builtin_amdgcn_s_memrealtime(); const unsigned long long want = 4ull * (ts_k - ts_start); while (__builtin_amdgcn_s_memrealtime() - t_end < want) __builtin_amdgcn_s_sleep(8); }
#endif
#ifdef PROBE_SCALE
    grid.sync();
    { const size_t ranges[6][2] = {{0, (size_t)MP * D}, {(size_t)MP * D, (size_t)M * D}, {OUT_K, OUT_V}, {OUT_V, OUT_CKV}, {OUT_CKV, OUT_KR}, {OUT_KR, OUT_KR + 8192 * 32}};
#pragma unroll
      for (int o = 0; o < 6; ++o) if ((PROBE_SCALE >> o) & 1) for (size_t i = ranges[o][0] + gtid; i < ranges[o][1]; i += NT) a.out[i] *= 1.01f; }
#endif
#undef IN
#undef SEAM
}

constexpr int N_PHASES = 14;
extern "C" void kernel_launch(void* const* d_in, const int* in_sizes, int n_in, void* d_out, int out_size, void* d_ws, size_t ws_size, hipStream_t stream) {
    static int grid = 0;
    if (grid == 0) {
        if (n_in != 27 || ws_size < WS_END) { fprintf(stderr, "kernel_launch: unexpected n_in %d / ws %zu\n", n_in, ws_size); grid = -1; return; }
        int dev = 0, cus = 0, per_cu = 0;
        hipGetDevice(&dev); hipDeviceGetAttribute(&cus, hipDeviceAttributeMultiprocessorCount, dev);
        if (hipFuncSetAttribute((const void*)mk_fwd, hipFuncAttributeMaxDynamicSharedMemorySize, LDS_BYTES) != hipSuccess) { fprintf(stderr, "kernel_launch: hipFuncSetAttribute failed\n"); grid = -1; return; }
        if (hipOccupancyMaxActiveBlocksPerMultiprocessor(&per_cu, (const void*)mk_fwd, 512, LDS_BYTES) != hipSuccess || per_cu < 1) { fprintf(stderr, "kernel_launch: occupancy query gave %d\n", per_cu); per_cu = 1; }
        (void)hipGetLastError();
        grid = cus * 1;
        fprintf(stderr, "kernel_launch: cus %d per_cu %d grid %d\n", cus, per_cu, grid);
    }
    if (grid < 0) return;
    (void)hipMemsetAsync(d_ws, 0, ZERO_BYTES, stream);
    Args a{};
    for (int i = 0; i < 27; ++i) a.in[i] = (const float*)d_in[i];
    a.out = (float*)d_out; a.ws = (unsigned char*)d_ws;
#if MK_N_LAUNCHES == 1
    a.ph_lo = 0; a.ph_hi = N_PHASES;
    void* args[] = {&a};
    hipError_t e = hipLaunchCooperativeKernel((const void*)mk_fwd, dim3(grid), dim3(512), args, LDS_BYTES, stream);
    if (e != hipSuccess) fprintf(stderr, "cooperative launch failed: %s (grid %d)\n", hipGetErrorString(e), grid);
#else
    for (int p = 0; p < N_PHASES; ++p) { a.ph_lo = p; a.ph_hi = p + 1; hipLaunchKernelGGL(mk_fwd, dim3(grid), dim3(512), LDS_BYTES, stream, a); }
#endif
}
```
